# Optimizing an MI355X kernel written in HIP

```python
import math
import jax, jax.numpy as jnp
from jax import lax
import numpy as np

D_MODEL = 1024
BATCH = 1
SEQ = 16384
DEPTH = 4

GRID_W = 64
CTX_LEN = 256
N_MIXERS = 4
EPS = 1e-6
NEG_INF = -1e30
CHUNK = 64

HG_HEADS = 8
HG_DK = 128
HG_DV = D_MODEL // HG_HEADS
HG_IN = 3 * HG_HEADS * HG_DK + HG_HEADS * HG_DV + D_MODEL

SSM_D_INNER = 2 * D_MODEL
SSM_HEADDIM = 64
SSM_HEADS = SSM_D_INNER // SSM_HEADDIM
SSM_GROUPS = 4
SSM_STATE = 128
SSM_CONV = 5
SSM_CONV_DIM = SSM_D_INNER + 2 * SSM_GROUPS * SSM_STATE
SSM_IN_DIM = SSM_D_INNER + SSM_CONV_DIM + 2 * SSM_HEADS

POOL_WINDOWS = (2, 4, 8, 16)
POOL_GROUP = D_MODEL // len(POOL_WINDOWS)

ATT_HEAD_DIM = 64
ATT_Q_HEADS = D_MODEL // ATT_HEAD_DIM
ATT_KV_HEADS = 4
ATT_WINDOW = 128
ATT_BLOCK = 128
ROPE_THETA = 10000.0

FFN_HIDDEN = -(-8 * D_MODEL // (3 * 256)) * 256

N_OCC = tuple((DEPTH - m + N_MIXERS - 1) // N_MIXERS for m in range(N_MIXERS))

kernel_name = "hybrid_interleaved_dit_prefix_ctx"


def rmsnorm(x, w):
    xf = x.astype(jnp.float32)
    y = xf * lax.rsqrt(jnp.mean(xf * xf, axis=-1, keepdims=True) + EPS)
    return (y * w.astype(jnp.float32)).astype(x.dtype)


def swiglu(h, w_in, w_out):
    gate, up = jnp.split(h @ w_in, 2, axis=-1)
    return (jax.nn.silu(gate) * up) @ w_out


def flip(t):
    return jnp.flip(t, axis=1)


def gla_chunk_scan(q, k, v, log_f, s0):
    f32 = jnp.float32
    b, n, h, dk = q.shape
    dv = v.shape[-1]
    nc = n // CHUNK
    qc, kc, lf = (t.astype(f32).reshape(b, nc, CHUNK, h, dk) for t in (q, k, log_f))
    vc = v.astype(f32).reshape(b, nc, CHUNK, h, dv)
    cum = jnp.cumsum(lf, axis=2)
    ref = cum[:, :, CHUNK // 2 - 1:CHUNK // 2]
    qr = qc * jnp.exp(cum - ref)
    kr = kc * jnp.exp(ref - cum)
    causal = jnp.tril(jnp.ones((CHUNK, CHUNK), bool))
    att = jnp.where(causal, jnp.einsum('bclhd,bcshd->bchls', qr, kr), 0.0)
    o_intra = jnp.einsum('bchls,bcshv->bclhv', att, vc)
    last = cum[:, :, -1:]
    ds = jnp.einsum('bcshd,bcshv->bchdv', kc * jnp.exp(last - cum), vc)
    decay = jnp.exp(last[:, :, 0])

    def step(s, inp):
        g, d = inp
        return g[..., None] * s + d, s

    s_fin, s_in = lax.scan(step, s0.astype(f32), (jnp.moveaxis(decay, 1, 0), jnp.moveaxis(ds, 1, 0)))
    s_in = jnp.moveaxis(s_in, 0, 1)
    o_inter = jnp.einsum('bclhd,bchdv->bclhv', qc * jnp.exp(cum), s_in)
    o = (o_intra + o_inter).reshape(b, n, h, dv)
    return o.astype(v.dtype), s_fin


def hgrn2_mixer(h_lat, h_ctx, w_in, lb_f, lb_b, gn_w, w_out, need_ctx):
    f32 = jnp.float32
    hk = HG_HEADS * HG_DK

    def prep(h):
        bsz, m, _ = h.shape
        q, zf, zb, v, g = jnp.split(h @ w_in, [hk, 2 * hk, 3 * hk, 3 * hk + HG_HEADS * HG_DV], axis=-1)

        def gate(z, lb):
            z32 = z.astype(f32)
            log_f = jnp.log(lb + (1.0 - lb) * jax.nn.sigmoid(z32))
            k = (1.0 - lb) * jax.nn.sigmoid(-z32)
            return k.reshape(bsz, m, HG_HEADS, HG_DK), log_f.reshape(bsz, m, HG_HEADS, HG_DK)

        kf, lff = gate(zf, lb_f)
        kb, lfb = gate(zb, lb_b)
        q = jax.nn.silu(q).reshape(bsz, m, HG_HEADS, HG_DK)
        v = v.reshape(bsz, m, HG_HEADS, HG_DV)
        return q, kf, lff, kb, lfb, v, g

    def readout(o, g):
        bsz, m = o.shape[:2]
        o = rmsnorm(o, gn_w).reshape(bsz, m, HG_HEADS * HG_DV).astype(g.dtype)
        return (o * jax.nn.silu(g)) @ w_out

    bsz = h_lat.shape[0]
    s0 = jnp.zeros((bsz, HG_HEADS, HG_DK, HG_DV), f32)
    qc, kfc, lfc, kbc, lbc, vc, gc = prep(h_ctx)
    oc_f, sc_f = gla_chunk_scan(qc, kfc, vc, lfc, s0)
    oc_b, sc_b = gla_chunk_scan(flip(qc), flip(kbc), flip(vc), flip(lbc), s0)
    ql, kfl, lfl, kbl, lbl, vl, gl = prep(h_lat)
    ol_f, _ = gla_chunk_scan(ql, kfl, vl, lfl, sc_f)
    ol_b, _ = gla_chunk_scan(flip(ql), flip(kbl), flip(vl), flip(lbl), sc_b)
    y_lat = readout(ol_f + flip(ol_b), gl)
    y_ctx = readout(oc_f + flip(oc_b), gc) if need_ctx else None
    return y_lat, y_ctx


def ssd_chunk_scan(x, dt, a, bm, cm, s0):
    f32 = jnp.float32
    b, n, h, p = x.shape
    g, ns = bm.shape[2], bm.shape[3]
    hpg = h // g
    nc = n // CHUNK
    xc = x.astype(f32).reshape(b, nc, CHUNK, g, hpg, p)
    dtc = dt.astype(f32).reshape(b, nc, CHUNK, g, hpg)
    bc = bm.astype(f32).reshape(b, nc, CHUNK, g, ns)
    cc = cm.astype(f32).reshape(b, nc, CHUNK, g, ns)
    cum = jnp.cumsum(dtc * a.reshape(g, hpg), axis=2)
    seg = cum[:, :, :, None] - cum[:, :, None]
    causal = jnp.tril(jnp.ones((CHUNK, CHUNK), bool))[:, :, None, None]
    lmat = jnp.exp(jnp.where(causal, seg, -jnp.inf))
    cb = jnp.einsum('bctgn,bcsgn->bctsg', cc, bc)
    xdt = xc * dtc[..., None]
    y_diag = jnp.einsum('bctsgh,bcsghp->bctghp', cb[..., None] * lmat, xdt)
    last = cum[:, :, -1:]
    ds = jnp.einsum('bcsgn,bcsgh,bcsghp->bcghpn', bc, jnp.exp(last - cum), xdt)
    decay = jnp.exp(last[:, :, 0])

    def step(s, inp):
        d, u = inp
        return d[..., None, None] * s + u, s

    s_fin, s_in = lax.scan(step, s0.astype(f32), (jnp.moveaxis(decay, 1, 0), jnp.moveaxis(ds, 1, 0)))
    s_in = jnp.moveaxis(s_in, 0, 1)
    y_off = jnp.einsum('bctgn,bcghpn,bctgh->bctghp', cc, s_in, jnp.exp(cum))
    y = (y_diag + y_off).reshape(b, n, h, p)
    return y.astype(x.dtype), s_fin


def centred_depthwise_conv(x, w, bias):
    width, ch = w.shape
    half = width // 2
    y = lax.conv_general_dilated(x, w[:, None, :].astype(x.dtype), window_strides=(1,),
                                 padding=[(half, width - 1 - half)],
                                 dimension_numbers=('NWC', 'WIO', 'NWC'), feature_group_count=ch)
    return y + bias


def mamba2_mixer(h_lat, h_ctx, w_in, conv_w, conv_b, dt_bias, a_log, d_skip, norm_w, w_out, need_ctx):
    f32 = jnp.float32
    gn = SSM_GROUPS * SSM_STATE
    a = -jnp.exp(a_log.astype(f32))

    def prep(h):
        bsz, m, _ = h.shape
        z, xbc, dt = jnp.split(h @ w_in, [SSM_D_INNER, SSM_D_INNER + SSM_CONV_DIM], axis=-1)
        xbc = jax.nn.silu(centred_depthwise_conv(xbc, conv_w, conv_b))
        xs, bm, cm = jnp.split(xbc, [SSM_D_INNER, SSM_D_INNER + gn], axis=-1)
        xs = xs.reshape(bsz, m, SSM_HEADS, SSM_HEADDIM)
        bm = bm.reshape(bsz, m, SSM_GROUPS, SSM_STATE)
        cm = cm.reshape(bsz, m, SSM_GROUPS, SSM_STATE)
        dt = jax.nn.softplus(dt.astype(f32).reshape(bsz, m, 2, SSM_HEADS) + dt_bias.astype(f32))
        return z, xs, bm, cm, dt

    def readout(y_f, y_b, xs, z):
        bsz, m = xs.shape[:2]
        y = (y_f + y_b + d_skip[:, None] * xs).reshape(bsz, m, SSM_D_INNER) * jax.nn.silu(z)
        y = rmsnorm(y.reshape(bsz, m, SSM_GROUPS, SSM_D_INNER // SSM_GROUPS),
                    norm_w.reshape(SSM_GROUPS, -1)).reshape(bsz, m, SSM_D_INNER)
        return y @ w_out

    bsz = h_lat.shape[0]
    s0 = jnp.zeros((bsz, SSM_GROUPS, SSM_HEADS // SSM_GROUPS, SSM_HEADDIM, SSM_STATE), f32)
    zc, xc, bc, cc, dtc = prep(h_ctx)
    yc_f, sc_f = ssd_chunk_scan(xc, dtc[:, :, 0], a[0], bc, cc, s0)
    yc_b, sc_b = ssd_chunk_scan(flip(xc), flip(dtc[:, :, 1]), a[1], flip(bc), flip(cc), s0)
    zl, xl, bl, cl, dtl = prep(h_lat)
    yl_f, _ = ssd_chunk_scan(xl, dtl[:, :, 0], a[0], bl, cl, sc_f)
    yl_b, _ = ssd_chunk_scan(flip(xl), flip(dtl[:, :, 1]), a[1], flip(bl), flip(cl), sc_b)
    y_lat = readout(yl_f, flip(yl_b), xl, zl)
    y_ctx = readout(yc_f, flip(yc_b), xc, zc) if need_ctx else None
    return y_lat, y_ctx


def pool_mixer(h, w_grp, ch_scale):
    f32 = jnp.float32
    bsz, m, _ = h.shape
    hf = h.astype(f32)
    cs = jnp.concatenate([jnp.zeros((bsz, 1, D_MODEL), f32), jnp.cumsum(hf, axis=1)], axis=1)
    t = jnp.arange(m)
    outs = []
    for gi, win in enumerate(POOL_WINDOWS):
        lo = jnp.clip(t - win // 2, 0, m)
        hi = jnp.clip(t + win - win // 2, 0, m)
        sl = slice(gi * POOL_GROUP, (gi + 1) * POOL_GROUP)
        cg = cs[:, :, sl]
        mean = (cg[:, hi] - cg[:, lo]) / (hi - lo).astype(f32)[None, :, None]
        delta = (mean - hf[:, :, sl]).astype(h.dtype)
        outs.append(delta @ w_grp[gi])
    return jnp.concatenate(outs, axis=-1) * ch_scale


def axial_rope_tables(row_ids, col_ids):
    f32 = jnp.float32
    half = ATT_HEAD_DIM // 2
    inv = ROPE_THETA ** (-jnp.arange(0, half, 2, dtype=f32) / half)

    def tab(pos):
        ang = pos.astype(f32)[:, None] * inv[None]
        ang = jnp.concatenate([ang, ang], axis=-1)
        return jnp.cos(ang), jnp.sin(ang)

    cr, sr = tab(row_ids)
    cc, sc = tab(col_ids)
    return jnp.concatenate([cr, cc], -1), jnp.concatenate([sr, sc], -1)


def rotate_half(x):
    x1, x2 = jnp.split(x, 2, axis=-1)
    return jnp.concatenate([-x2, x1], axis=-1)


def apply_axial_rope(x, cos, sin):
    xr, xc = jnp.split(x, 2, axis=-1)
    rot = jnp.concatenate([rotate_half(xr), rotate_half(xc)], axis=-1)
    return (x * cos + rot * sin).astype(x.dtype)


def softmax_with_sink(scores, sink):
    s = jnp.concatenate([scores, jnp.broadcast_to(sink, scores.shape[:-1] + (1,))], axis=-1)
    return jax.nn.softmax(s, axis=-1)[..., :-1]


def window_gqa_mixer(h_lat, h_ctx, w_qkv, sink, w_out, cos, sin, need_ctx):
    f32 = jnp.float32
    grp = ATT_Q_HEADS // ATT_KV_HEADS
    qd, kd = ATT_Q_HEADS * ATT_HEAD_DIM, ATT_KV_HEADS * ATT_HEAD_DIM
    scale = ATT_HEAD_DIM ** -0.5

    def proj(h):
        bsz, m, _ = h.shape
        q, k, v = jnp.split(h @ w_qkv, [qd, qd + kd], axis=-1)
        return (q.reshape(bsz, m, ATT_KV_HEADS, grp, ATT_HEAD_DIM),
                k.reshape(bsz, m, ATT_KV_HEADS, ATT_HEAD_DIM),
                v.reshape(bsz, m, ATT_KV_HEADS, ATT_HEAD_DIM))

    bsz, n, _ = h_lat.shape
    ql, kl, vl = proj(h_lat)
    qc, kc, vc = proj(h_ctx)
    ql = apply_axial_rope(ql, cos[:, None, None], sin[:, None, None])
    kl = apply_axial_rope(kl, cos[:, None], sin[:, None])
    sink_l = sink.astype(f32).reshape(ATT_KV_HEADS, grp)[None, :, :, None, None]

    span = ATT_BLOCK + 2 * ATT_WINDOW
    pad = ((0, 0), (ATT_WINDOW, ATT_WINDOW), (0, 0), (0, 0))
    kp = jnp.pad(kl, pad)
    vp = jnp.pad(vl, pad)
    k_rel = jnp.arange(span) - ATT_WINDOW
    band = jnp.abs(k_rel[None, :] - jnp.arange(ATT_BLOCK)[:, None]) <= ATT_WINDOW

    def block(bi):
        start = bi * ATT_BLOCK
        qb = lax.dynamic_slice_in_dim(ql, start, ATT_BLOCK, axis=1)
        kb = lax.dynamic_slice_in_dim(kp, start, span, axis=1)
        vb = lax.dynamic_slice_in_dim(vp, start, span, axis=1)
        kpos = start + k_rel
        valid = band & ((kpos >= 0) & (kpos < n))[None, :]
        s_lat = jnp.where(valid, jnp.einsum('bqkgd,bmkd->bkgqm', qb, kb).astype(f32) * scale, NEG_INF)
        s_ctx = jnp.einsum('bqkgd,bckd->bkgqc', qb, kc).astype(f32) * scale
        p = softmax_with_sink(jnp.concatenate([s_lat, s_ctx], axis=-1), sink_l).astype(vl.dtype)
        return (jnp.einsum('bkgqm,bmkd->bqkgd', p[..., :span], vb)
                + jnp.einsum('bkgqc,bckd->bqkgd', p[..., span:], vc))

    o = lax.map(block, jnp.arange(n // ATT_BLOCK))
    y_lat = jnp.moveaxis(o, 0, 1).reshape(bsz, n, D_MODEL) @ w_out
    y_ctx = None
    if need_ctx:
        m = h_ctx.shape[1]
        s = jnp.einsum('bqkgd,bckd->bkgqc', qc, kc).astype(f32) * scale
        p = softmax_with_sink(s, sink_l).astype(vc.dtype)
        y_ctx = jnp.einsum('bkgqc,bckd->bqkgd', p, vc).reshape(bsz, m, D_MODEL) @ w_out
    return y_lat, y_ctx


def setup_inputs(seed: int = 0) -> dict:
    key = jax.random.key(seed)
    ks = iter(jax.random.split(key, 40))
    f32 = jnp.float32
    D = D_MODEL
    n_a, n_b, n_c, n_d = N_OCC

    def nrm(shape, s):
        return jax.random.normal(next(ks), shape, f32) * s

    def unif(shape, lo, hi):
        return jax.random.uniform(next(ks), shape, f32, lo, hi)

    dt0 = jnp.exp(unif((n_b, 2, SSM_HEADS), math.log(1e-3), math.log(1e-1)))
    return {
        "x": nrm((BATCH, SEQ, D), 1.0),
        "c": nrm((BATCH, D), 1.0),
        "ctx": nrm((BATCH, CTX_LEN, D), 1.0),
        "c_ctx": nrm((D,), 1.0),
        "ada_w": nrm((DEPTH, D, 6 * D), 0.5 * D ** -0.5),
        "ada_b": nrm((DEPTH, 6 * D), 0.02),
        "norm_w": 1.0 + nrm((DEPTH, 2, D), 0.02),
        "ffn_w_in": nrm((DEPTH, D, 2 * FFN_HIDDEN), D ** -0.5),
        "ffn_w_out": nrm((DEPTH, FFN_HIDDEN, D), FFN_HIDDEN ** -0.5),
        "final_norm_w": 1.0 + nrm((D,), 0.02),
        "hg_w_in": nrm((n_a, D, HG_IN), D ** -0.5),
        "hg_lb": nrm((2, DEPTH + 1, HG_HEADS * HG_DK), 0.1),
        "hg_norm_w": 1.0 + nrm((n_a, HG_DV), 0.02),
        "hg_w_out": nrm((n_a, HG_HEADS * HG_DV, D), (HG_HEADS * HG_DV) ** -0.5),
        "ssm_w_in": nrm((n_b, D, SSM_IN_DIM), D ** -0.5),
        "ssm_conv_w": nrm((n_b, SSM_CONV, SSM_CONV_DIM), SSM_CONV ** -0.5),
        "ssm_conv_b": nrm((n_b, SSM_CONV_DIM), 0.02),
        "ssm_dt_bias": dt0 + jnp.log(-jnp.expm1(-dt0)),
        "ssm_a_log": jnp.log(unif((n_b, 2, SSM_HEADS), 1.0, 16.0)),
        "ssm_d": 1.0 + nrm((n_b, SSM_HEADS), 0.02),
        "ssm_norm_w": 1.0 + nrm((n_b, SSM_D_INNER), 0.02),
        "ssm_w_out": nrm((n_b, SSM_D_INNER, D), SSM_D_INNER ** -0.5),
        "pool_w": nrm((n_c, len(POOL_WINDOWS), POOL_GROUP, POOL_GROUP), POOL_GROUP ** -0.5),
        "pool_scale": 1.0 + nrm((n_c, D), 0.02),
        "att_w_qkv": nrm((n_d, D, (ATT_Q_HEADS + 2 * ATT_KV_HEADS) * ATT_HEAD_DIM), D ** -0.5),
        "att_sink": nrm((n_d, ATT_Q_HEADS), 0.5),
        "att_w_out": nrm((n_d, D, D), D ** -0.5),
    }


def reference(x, c, ctx, c_ctx, ada_w, ada_b, norm_w, ffn_w_in, ffn_w_out, final_norm_w,
              hg_w_in, hg_lb, hg_norm_w, hg_w_out,
              ssm_w_in, ssm_conv_w, ssm_conv_b, ssm_dt_bias, ssm_a_log, ssm_d, ssm_norm_w, ssm_w_out,
              pool_w, pool_scale, att_w_qkv, att_sink, att_w_out):
    f32 = jnp.float32
    bsz, n, _ = x.shape
    rows = n // GRID_W
    row_ids = jnp.repeat(jnp.arange(rows), GRID_W)
    col_ids = jnp.tile(jnp.arange(GRID_W), rows)
    cos, sin = axial_rope_tables(row_ids, col_ids)

    lb_tab = jnp.cumsum(jax.nn.softmax(hg_lb.astype(f32), axis=1), axis=1)

    silu_c = jax.nn.silu(c)
    silu_cc = jax.nn.silu(c_ctx)[None]
    x_lat, x_ctx = x, ctx
    for i in range(DEPTH):
        kind, j = i % N_MIXERS, i // N_MIXERS
        need_ctx = i < DEPTH - 1
        mod_l = jnp.split((silu_c @ ada_w[i] + ada_b[i])[:, None], 6, axis=-1)
        mod_c = jnp.split((silu_cc @ ada_w[i] + ada_b[i])[:, None], 6, axis=-1)
        sh_l, sc_l, g_l, sh2_l, sc2_l, g2_l = mod_l
        sh_c, sc_c, g_c, sh2_c, sc2_c, g2_c = mod_c

        h_lat = rmsnorm(x_lat, norm_w[i, 0]) * (1 + sc_l) + sh_l
        h_ctx = rmsnorm(x_ctx, norm_w[i, 0]) * (1 + sc_c) + sh_c if (need_ctx or kind != 2) else None

        if kind == 0:
            y_lat, y_ctx = hgrn2_mixer(h_lat, h_ctx, hg_w_in[j], lb_tab[0, i], lb_tab[1, i],
                                       hg_norm_w[j], hg_w_out[j], need_ctx)
        elif kind == 1:
            y_lat, y_ctx = mamba2_mixer(h_lat, h_ctx, ssm_w_in[j], ssm_conv_w[j], ssm_conv_b[j],
                                        ssm_dt_bias[j], ssm_a_log[j], ssm_d[j], ssm_norm_w[j],
                                        ssm_w_out[j], need_ctx)
        elif kind == 2:
            y_lat = pool_mixer(h_lat, pool_w[j], pool_scale[j])
            y_ctx = pool_mixer(h_ctx, pool_w[j], pool_scale[j]) if need_ctx else None
        else:
            y_lat, y_ctx = window_gqa_mixer(h_lat, h_ctx, att_w_qkv[j], att_sink[j], att_w_out[j],
                                            cos, sin, need_ctx)

        x_lat = x_lat + g_l * y_lat
        x_lat = x_lat + g2_l * swiglu(rmsnorm(x_lat, norm_w[i, 1]) * (1 + sc2_l) + sh2_l,
                                      ffn_w_in[i], ffn_w_out[i])
        if need_ctx:
            x_ctx = x_ctx + g_c * y_ctx
            x_ctx = x_ctx + g2_c * swiglu(rmsnorm(x_ctx, norm_w[i, 1]) * (1 + sc2_c) + sh2_c,
                                          ffn_w_in[i], ffn_w_out[i])
    return rmsnorm(x_lat, final_norm_w)
```

```cpp
#include <hip/hip_runtime.h>
#include <hip/hip_cooperative_groups.h>
#include <cstdio>
#include <cstdint>
namespace cg = cooperative_groups;

#ifndef MK_ONE_LAUNCH
#define MK_ONE_LAUNCH 1
#endif
#ifndef NAIVE_HG
#define NAIVE_HG 0
#endif
#ifndef NAIVE_SSM
#define NAIVE_SSM 0
#endif
#ifndef NAIVE_ATT
#define NAIVE_ATT 0
#endif

#define LAS __attribute__((address_space(3)))
typedef unsigned short bf16_t;
typedef short bf16x8 __attribute__((ext_vector_type(8)));
typedef float f32x4 __attribute__((ext_vector_type(4)));
typedef float f32x2 __attribute__((ext_vector_type(2)));
typedef unsigned u32x4 __attribute__((ext_vector_type(4)));
typedef unsigned u32x2 __attribute__((ext_vector_type(2)));

constexpr int D = 1024, NLAT = 16384, NCTX = 256, MALL = NLAT + NCTX, DEPTH = 4;
constexpr int FH = 2816, FH2 = 5632;
constexpr int HG_N = 5120;
constexpr int SSM_N = 5184, SSM_NP = 5376;
constexpr int SSM_DI = 2048, SSM_CD = 3072;
constexpr int ATT_N = 1536, QK_LD = 1536;
constexpr int PLD = 5120;
constexpr float EPS = 1e-6f;
constexpr int NWAVES = 8, NTHR = 512;
constexpr int LDS_BYTES = 147456, MISC_OFF = LDS_BYTES - 512;

constexpr size_t al256(size_t x) { return (x + 255) & ~(size_t)255; }
constexpr size_t WS_CTL = 0, CTL_BYTES = 65536;
constexpr size_t WS_MODS = WS_CTL + CTL_BYTES;
constexpr size_t WS_CS = WS_MODS + (size_t)4 * 2 * 6144 * 4;
constexpr size_t WS_GATE = WS_CS + (size_t)4 * 2 * 2 * 1024 * 4;
constexpr size_t WS_BIAS1 = WS_GATE + (size_t)4 * 2 * 2 * 1024 * 4;
constexpr size_t WS_BIAS3 = WS_BIAS1 + (size_t)4 * 2 * FH2 * 4;
constexpr size_t WS_LB = WS_BIAS3 + (size_t)4 * 2 * FH2 * 4;
constexpr size_t WS_ROPE = WS_LB + 2 * 1024 * 4;
constexpr size_t WS_SLOTS = WS_ROPE + 2 * 256 * 16 * 4;
constexpr size_t WS_XCTX = WS_SLOTS + (size_t)MALL * 16 * 4;
constexpr size_t WS_DT = WS_XCTX + (size_t)NCTX * D * 4;
constexpr size_t WS_W_HGIN = al256(WS_DT + (size_t)MALL * 64 * 4);
constexpr size_t WS_W_HGOUT = WS_W_HGIN + (size_t)HG_N * D * 2;
constexpr size_t WS_W_SSMIN = WS_W_HGOUT + (size_t)D * D * 2;
constexpr size_t WS_W_SSMOUT = WS_W_SSMIN + (size_t)SSM_NP * D * 2;
constexpr size_t WS_W_POOL = WS_W_SSMOUT + (size_t)D * SSM_DI * 2;
constexpr size_t WS_W_QKV = WS_W_POOL + (size_t)4 * 256 * 256 * 2;
constexpr size_t WS_W_ATTOUT = WS_W_QKV + (size_t)ATT_N * D * 2;
constexpr size_t WS_W_FFNIN = WS_W_ATTOUT + (size_t)D * D * 2;
constexpr size_t WS_W_FFNOUT = WS_W_FFNIN + (size_t)4 * FH2 * D * 2;
constexpr size_t WS_XSA = WS_W_FFNOUT + (size_t)4 * D * FH * 2;
constexpr size_t WS_P = WS_XSA + (size_t)MALL * D * 2;
constexpr size_t P_BYTES = (size_t)MALL * PLD * 2;
constexpr size_t WS_XSB = WS_P + (size_t)96 * 1024 * 1024;
constexpr size_t WS_ST = WS_P + P_BYTES;
constexpr size_t ST_BYTES = (size_t)2 * 5 * 260 * 128 * 128 * 2;
constexpr size_t WS_END = WS_ST + ST_BYTES;
static_assert(WS_END <= (size_t)402653184, "workspace map exceeds 4 x largest input");
static_assert((size_t)MALL * FH * 2 <= (size_t)96 * 1024 * 1024 && WS_XSB + (size_t)MALL * D * 2 <= WS_ST, "H / XS_B overlay inside P");

__device__ __forceinline__ float bf2f(bf16_t b) { return __uint_as_float(((unsigned)b) << 16); }
__device__ __forceinline__ unsigned f2bf(float f) { unsigned u = __float_as_uint(f); return (u + 0x7fffu + ((u >> 16) & 1u)) >> 16; }
__device__ __forceinline__ unsigned pk2(float lo, float hi) { return f2bf(lo) | (f2bf(hi) << 16); }
typedef __bf16 bf16v2_t __attribute__((ext_vector_type(2)));
__device__ __forceinline__ unsigned cvt_pk_bf16(float lo, float hi) { const f32x2 f = {lo, hi}; return __builtin_bit_cast(unsigned, __builtin_convertvector(f, bf16v2_t)); }
__device__ __forceinline__ float sigmoidf_(float x) { return __builtin_amdgcn_rcpf(1.0f + __expf(-x)); }
__device__ __forceinline__ float siluf_(float x) { return x * sigmoidf_(x); }
__device__ __forceinline__ float lo_bf(unsigned w) { return __uint_as_float(w << 16); }
__device__ __forceinline__ float hi_bf(unsigned w) { return __uint_as_float(w & 0xffff0000u); }
__device__ __forceinline__ float wave_sum(float v) {
#pragma unroll
    for (int o = 1; o < 64; o <<= 1) v += __shfl_xor(v, o);
    return v;
}

#define XB_TMO      128
#define XB_XCNT(j)  (256  + 64 * (j))
#define XB_XSUB(j)  (1280 + 64 * (j))
#define XB_XGEN(j)  (2304 + 64 * (j))
#define XB_TOP      3328
#define XB_TOPGEN   3392
#define XCD_BAR_WORDS 3456
#define XB_SPIN_CAP (1u << 22)
__device__ __forceinline__ unsigned xb_ld(unsigned* p)              { return __hip_atomic_load(p, __ATOMIC_RELAXED, __HIP_MEMORY_SCOPE_AGENT); }
__device__ __forceinline__ unsigned xb_add(unsigned* p, unsigned v) { return __hip_atomic_fetch_add(p, v, __ATOMIC_RELAXED, __HIP_MEMORY_SCOPE_AGENT); }
__device__ __forceinline__ unsigned xb_xcc_id() { return (unsigned)__builtin_amdgcn_s_getreg((3 << 11) | 20) & 0xFu; }
#define XB_SPIN(cond, bar) do { unsigned _sp = 0; while (cond) { __builtin_amdgcn_s_sleep(1); \
    if ((++_sp & 255u) == 0u) { if (xb_ld(&(bar)[XB_TMO])) break; if (_sp > XB_SPIN_CAP) { atomicAdd(&(bar)[XB_TMO], 1u); break; } } } } while (0)
struct XcdBarrier { unsigned* bar; unsigned x; volatile LAS unsigned* st; };
__device__ __forceinline__ XcdBarrier xcd_barrier_post(unsigned* bar, volatile LAS unsigned* st) {
    XcdBarrier b; b.bar = bar; b.x = xb_xcc_id(); b.st = st;
    if (threadIdx.x == 0) (void)xb_add(&bar[XB_XCNT(b.x)], 1u);
    return b;
}
__device__ __forceinline__ void xcd_barrier_complete(unsigned* bar, unsigned x, unsigned& nloc, unsigned& nx) {
    const unsigned G = gridDim.x * gridDim.y * gridDim.z;
    unsigned sum, cnt, mine, sp = 0u;
    for (;;) {
        sum = 0u; cnt = 0u; mine = 0u;
#pragma unroll
        for (unsigned j = 0; j < 16; ++j) { const unsigned c = xb_ld(&bar[XB_XCNT(j)]); sum += c; cnt += (c > 0u) ? 1u : 0u; mine = (j == x) ? c : mine; }
        if (sum == G) break;
        __builtin_amdgcn_s_sleep(1);
        if ((++sp & 255u) == 0u) { if (xb_ld(&bar[XB_TMO])) break; if (sp > XB_SPIN_CAP) { atomicAdd(&bar[XB_TMO], 1u); break; } }
    }
    nloc = mine > 0u ? mine : 1u; nx = cnt > 0u ? cnt : 1u;
}
__device__ __forceinline__ void xcd_barrier(const XcdBarrier& b) {
    asm volatile("s_waitcnt vmcnt(0)" ::: "memory");
    __syncthreads();
    if (threadIdx.x == 0) {
        unsigned* bar = b.bar;
        __builtin_amdgcn_s_waitcnt(0);
        unsigned nloc = b.st[0], nx = b.st[1];
        if (nloc == 0u) { xcd_barrier_complete(bar, b.x, nloc, nx); b.st[0] = nloc; b.st[1] = nx; }
        const unsigned old = xb_add(&bar[XB_XSUB(b.x)], 1u);
        const unsigned gen = old / nloc;
        if (old + 1u == (gen + 1u) * nloc) {
            __builtin_amdgcn_fence(__ATOMIC_RELEASE, "agent");
            asm volatile("s_waitcnt vmcnt(0)" ::: "memory");
            const unsigned og = xb_add(&bar[XB_TOP], 1u);
            const unsigned tg = og / nx;
            if (og + 1u == (tg + 1u) * nx) xb_add(&bar[XB_TOPGEN], 1u);
            else XB_SPIN(xb_ld(&bar[XB_TOPGEN]) == tg, bar);
            __builtin_amdgcn_fence(__ATOMIC_ACQUIRE, "agent");
            xb_add(&bar[XB_XGEN(b.x)], 1u);
            asm volatile("s_waitcnt vmcnt(0)" ::: "memory");
        } else {
            XB_SPIN(xb_ld(&bar[XB_XGEN(b.x)]) == gen, bar);
            __builtin_amdgcn_fence(__ATOMIC_ACQUIRE, "agent");
            asm volatile("s_waitcnt vmcnt(0)" ::: "memory");
        }
    }
    __syncthreads();
}

namespace pg8 {
constexpr int BM = 256, BK = 64, HALF = 128, HTB = HALF * BK * 2, STAGE_BYTES = 8 * HTB, NXCD = 8, WGM = 8;
__host__ __device__ __forceinline__ int lds_byte(int r, int c) { const int st = (r >> 4) * 2 + (c >> 5), rr = r & 15, cc = c & 31, ob = rr * 64 + cc * 2; return st * 1024 + (ob ^ (((ob >> 9) & 1) << 5)); }
__host__ __device__ __forceinline__ void stage_rc(int b, int& R, int& C) { const int st = b / 1024, sb = b % 1024, swz = sb ^ (((sb >> 9) & 1) << 5); R = (st >> 1) * 16 + swz / 64; C = (st & 1) * 32 + (swz % 64) / 2; }
__host__ __device__ __forceinline__ int perm32(int rho) { const int n = rho >> 4, i = rho & 15; return 8 * (i >> 2) + 4 * n + (i & 3); }
struct Unit { int pm, pn; };
struct Gemm { const bf16_t* A; const bf16_t* Bt; int lda, ldb, K, a_pn_step; };
struct StaticOrder {
    int nM, nN, nwg, G, c;
    __device__ void init(int nM_, int nN_, int G_, int c_) { nM = nM_; nN = nN_; nwg = nM * nN; G = G_; c = c_; }
    __device__ bool next(int i, Unit& u) const {
        const long L = (long)i * G + c; if (L >= nwg) return false;
        int wgid = (int)L; { const int q = nwg / NXCD, r = nwg % NXCD, xcd = wgid % NXCD, off = wgid / NXCD; wgid = (xcd < r ? xcd * (q + 1) : r * (q + 1) + (xcd - r) * q) + off; }
        const int nig = WGM * nN, gid = wgid / nig, fm = gid * WGM, gsz = (nM - fm) < WGM ? (nM - fm) : WGM;
        u.pm = fm + ((wgid % nig) % gsz); u.pn = (wgid % nig) / gsz; return true;
    }
};

template <class Epi, bool ALIGN_EPI = true, bool SP2 = true>
__device__ __forceinline__ void gemm_phase(LAS unsigned char* lds, const Gemm g, const StaticOrder& S, const Epi& E) {
    const int tid = threadIdx.x, wid = __builtin_amdgcn_readfirstlane(tid >> 6), lane = tid & 63, wr = wid >> 2, wc = wid & 3, fr = lane & 15, fq = lane >> 4;
    const int nt = g.K / BK;
    unsigned voffA[2], voffB[2];
#pragma unroll
    for (int i = 0; i < 2; ++i) { int R, C; stage_rc(tid * 16 + i * 8192, R, C); const int Rb = Epi::PERM ? ((R & ~31) + perm32(R & 31)) : R;
        voffA[i] = (unsigned)(R * g.lda + C) * 2u; voffB[i] = (unsigned)(Rb * g.ldb + C) * 2u; }
    const size_t kstep = (size_t)(BK * 2);
    const size_t hstepA = (size_t)HALF * g.lda * 2, hstepB = (size_t)HALF * g.ldb * 2;
    const unsigned ldsw = (unsigned)wid * 1024u;
    const int aoff = lds_byte(wr * 64 + fr, fq * 8), boff = lds_byte(wc * 32 + fr, fq * 8);
#define PG8_SA(b, h) (((b) * 2 + (h)) * HTB)
#define PG8_SB(b, h) ((4 + (b) * 2 + (h)) * HTB)
#define PG8_STAGE(bufoff, gbase, voff) do { _Pragma("unroll") for (int _i = 0; _i < 2; ++_i) \
        __builtin_amdgcn_global_load_lds((const unsigned*)((const char*)(gbase) + (voff)[_i]), (LAS unsigned*)(lds + (bufoff) + ldsw + _i * 8192), 16, 0, 0); } while (0)
#define PG8_LDA(dst, b, h) do { _Pragma("unroll") for (int m = 0; m < 4; ++m) _Pragma("unroll") for (int k = 0; k < 2; ++k) dst[m][k] = *(const LAS bf16x8*)(lds + PG8_SA(b, h) + aoff + m * 2048 + k * 1024); } while (0)
#define PG8_LDB(dst, b, h) do { _Pragma("unroll") for (int n = 0; n < 2; ++n) _Pragma("unroll") for (int k = 0; k < 2; ++k) dst[n][k] = *(const LAS bf16x8*)(lds + PG8_SB(b, h) + boff + n * 2048 + k * 1024); } while (0)
#define PG8_MMA(ai, bj, At, Bt) do { __builtin_amdgcn_s_setprio(1); _Pragma("unroll") for (int m = 0; m < 4; ++m) _Pragma("unroll") for (int n = 0; n < 2; ++n) _Pragma("unroll") for (int k = 0; k < 2; ++k) \
        acc[ai][bj][m][n] = __builtin_amdgcn_mfma_f32_16x16x32_bf16(Bt[n][k], At[m][k], acc[ai][bj][m][n], 0, 0, 0); __builtin_amdgcn_s_setprio(0); } while (0)
#define PG8_WAIT_V(n) asm volatile("s_waitcnt vmcnt(" #n ")" ::: "memory")
#define PG8_WAIT_L(n) asm volatile("s_waitcnt lgkmcnt(" #n ")" ::: "memory")
#define PG8_BAR __builtin_amdgcn_s_barrier()
#define PG8_SCHED __builtin_amdgcn_sched_barrier(0)
    Unit cur, nxt; int ui = 0;
    if (!S.next(0, cur)) return;
    f32x4 acc[2][2][4][2];
#pragma unroll
    for (int a = 0; a < 2; ++a)
#pragma unroll
        for (int b = 0; b < 2; ++b)
#pragma unroll
            for (int m = 0; m < 4; ++m)
#pragma unroll
                for (int n = 0; n < 2; ++n) acc[a][b][m][n] = (f32x4){0.f, 0.f, 0.f, 0.f};
    bf16x8 At[4][2], B0[2][2], B1[2][2];
    const char* cA = (const char*)g.A + ((size_t)cur.pm * BM * g.lda + (size_t)cur.pn * g.a_pn_step) * 2; const char* cB = (const char*)g.Bt + (size_t)cur.pn * BM * g.ldb * 2;
    if constexpr (SP2) {
        PG8_STAGE(PG8_SB(0, 0), cB, voffB); PG8_STAGE(PG8_SB(0, 1), cB + hstepB, voffB); PG8_STAGE(PG8_SA(0, 0), cA, voffA); PG8_STAGE(PG8_SA(0, 1), cA + hstepA, voffA);
        if (wr == 1) PG8_BAR;
        PG8_WAIT_V(2); PG8_BAR;
        PG8_STAGE(PG8_SB(1, 0), cB + kstep, voffB); PG8_STAGE(PG8_SA(1, 0), cA + kstep, voffA); PG8_STAGE(PG8_SB(1, 1), cB + hstepB + kstep, voffB);
        PG8_WAIT_V(6); PG8_BAR;
    } else {
        PG8_STAGE(PG8_SB(0, 0), cB, voffB); PG8_STAGE(PG8_SA(0, 0), cA, voffA); PG8_STAGE(PG8_SB(0, 1), cB + hstepB, voffB); PG8_STAGE(PG8_SA(0, 1), cA + hstepA, voffA);
        if (wr == 1) PG8_BAR;
        PG8_WAIT_V(4); PG8_BAR;
        PG8_STAGE(PG8_SB(1, 0), cB + kstep, voffB); PG8_STAGE(PG8_SA(1, 0), cA + kstep, voffA); PG8_STAGE(PG8_SB(1, 1), cB + hstepB + kstep, voffB);
        PG8_WAIT_V(6); PG8_BAR;
    }
    for (;;) {
        const bool has_next = S.next(ui + 1, nxt);
        const char* nA = has_next ? (const char*)g.A + ((size_t)nxt.pm * BM * g.lda + (size_t)nxt.pn * g.a_pn_step) * 2 : cA; const char* nB = has_next ? (const char*)g.Bt + (size_t)nxt.pn * BM * g.ldb * 2 : cB;
        for (int t = 0; t < nt; t += 2) {
            const bool last = (t == nt - 2);
            const char* a1 = cA + (size_t)(t + 1) * kstep;
            const char* a2 = last ? nA : cA + (size_t)(t + 2) * kstep; const char* b2 = last ? nB : cB + (size_t)(t + 2) * kstep;
            const char* a3 = a2 + kstep; const char* b3 = b2 + kstep;
            if constexpr (SP2) {
            PG8_LDB(B0, 0, 0); PG8_LDB(B1, 0, 1); PG8_SCHED; PG8_LDA(At, 0, 0); PG8_STAGE(PG8_SA(1, 1), a1 + hstepA, voffA);
            PG8_WAIT_V(8); PG8_WAIT_L(0); PG8_BAR; PG8_MMA(0, 0, At, B0); PG8_MMA(0, 1, At, B1); PG8_BAR; PG8_SCHED;
            PG8_LDA(At, 0, 1); PG8_STAGE(PG8_SB(0, 0), b2, voffB); PG8_STAGE(PG8_SB(0, 1), b2 + hstepB, voffB); PG8_STAGE(PG8_SA(0, 0), a2, voffA);
            PG8_WAIT_V(8); PG8_WAIT_L(0); PG8_BAR; PG8_MMA(1, 0, At, B0); PG8_MMA(1, 1, At, B1); PG8_BAR; PG8_SCHED;
            PG8_LDB(B0, 1, 0); PG8_LDB(B1, 1, 1); PG8_SCHED; PG8_LDA(At, 1, 0); PG8_STAGE(PG8_SA(0, 1), a2 + hstepA, voffA);
            PG8_WAIT_V(8); PG8_WAIT_L(0); PG8_BAR; PG8_MMA(0, 0, At, B0); PG8_MMA(0, 1, At, B1); PG8_BAR; PG8_SCHED;
            PG8_LDA(At, 1, 1); PG8_STAGE(PG8_SB(1, 0), b3, voffB); PG8_STAGE(PG8_SB(1, 1), b3 + hstepB, voffB); PG8_STAGE(PG8_SA(1, 0), a3, voffA);
            PG8_WAIT_V(8); PG8_WAIT_L(0); PG8_BAR; PG8_MMA(1, 0, At, B0); PG8_MMA(1, 1, At, B1); PG8_BAR; PG8_SCHED;
            } else {
            PG8_LDB(B0, 0, 0); PG8_SCHED; PG8_LDA(At, 0, 0); PG8_STAGE(PG8_SA(1, 1), a1 + hstepA, voffA);
            PG8_WAIT_L(8); PG8_BAR; PG8_WAIT_L(0); PG8_MMA(0, 0, At, B0); PG8_BAR; PG8_SCHED;
            PG8_LDB(B1, 0, 1); PG8_STAGE(PG8_SB(0, 0), b2, voffB);
            PG8_BAR; PG8_WAIT_L(0); PG8_MMA(0, 1, At, B1); PG8_BAR;
            PG8_LDA(At, 0, 1); PG8_STAGE(PG8_SA(0, 0), a2, voffA);
            PG8_BAR; PG8_WAIT_L(0); PG8_MMA(1, 0, At, B0); PG8_BAR; PG8_SCHED;
            PG8_STAGE(PG8_SB(0, 1), b2 + hstepB, voffB);
            PG8_WAIT_V(6); PG8_BAR; PG8_MMA(1, 1, At, B1); PG8_BAR;
            PG8_LDB(B0, 1, 0); PG8_SCHED; PG8_LDA(At, 1, 0); PG8_STAGE(PG8_SA(0, 1), a2 + hstepA, voffA);
            PG8_WAIT_L(8); PG8_BAR; PG8_WAIT_L(0); PG8_MMA(0, 0, At, B0); PG8_BAR; PG8_SCHED;
            PG8_LDB(B1, 1, 1); PG8_STAGE(PG8_SB(1, 0), b3, voffB);
            PG8_BAR; PG8_WAIT_L(0); PG8_MMA(0, 1, At, B1); PG8_BAR;
            PG8_LDA(At, 1, 1); PG8_STAGE(PG8_SA(1, 0), a3, voffA);
            PG8_BAR; PG8_WAIT_L(0); PG8_MMA(1, 0, At, B0); PG8_BAR; PG8_SCHED;
            PG8_STAGE(PG8_SB(1, 1), b3 + hstepB, voffB);
            PG8_WAIT_V(6); PG8_BAR; PG8_MMA(1, 1, At, B1); PG8_BAR;
            }
        }
        if constexpr (ALIGN_EPI) { if (wr == 0) PG8_BAR; }
        E(acc, cur, wr, wc, fr, fq);
        if (!has_next) break;
#pragma unroll
        for (int a = 0; a < 2; ++a)
#pragma unroll
            for (int b = 0; b < 2; ++b)
#pragma unroll
                for (int m = 0; m < 4; ++m)
#pragma unroll
                    for (int n = 0; n < 2; ++n) acc[a][b][m][n] = (f32x4){0.f, 0.f, 0.f, 0.f};
        cur = nxt; cA = nA; cB = nB; ++ui;
        if constexpr (ALIGN_EPI) { if (wr == 1) PG8_BAR; }
    }
    PG8_WAIT_V(0);
    if constexpr (!ALIGN_EPI) { if (wr == 0) PG8_BAR; }
    PG8_BAR;
#undef PG8_SA
#undef PG8_SB
#undef PG8_STAGE
#undef PG8_LDA
#undef PG8_LDB
#undef PG8_MMA
#undef PG8_WAIT_V
#undef PG8_WAIT_L
#undef PG8_BAR
#undef PG8_SCHED
}
}
using pg8::Unit; using pg8::Gemm; using pg8::StaticOrder; using pg8::HALF; using pg8::BM;

__device__ __forceinline__ void load_rstd(const float* slots, int row0, int fq, float (&rs)[2][4]) {
#pragma unroll
    for (int ai = 0; ai < 2; ++ai)
#pragma unroll
        for (int m = 0; m < 4; ++m) {
            const f32x4 s = *(const f32x4*)(slots + (size_t)(row0 + ai * HALF + m * 16) * 16 + 4 * fq);
            float t = (s.x + s.y) + (s.z + s.w); t += __shfl_xor(t, 16); t += __shfl_xor(t, 32);
            rs[ai][m] = rsqrtf(t * (1.0f / 1024.0f) + EPS);
        }
}
template <int MODE> struct EpiG1 {
    static constexpr bool PERM = true;
    const float* slots; const float* bias; int bias_ld;
    bf16_t* O; float* DT;
    __device__ __forceinline__ void operator()(const f32x4 (&acc)[2][2][4][2], const Unit& u, int wr, int wc, int fr, int fq) const {
        const int row0 = u.pm * BM + wr * 64 + fr; const int var = (u.pm >= 64) ? 1 : 0;
        float rs[2][4]; load_rstd(slots, row0, fq, rs);
        const int cl = wc * 32 + 8 * fq;
        const float* bp = bias + (size_t)var * bias_ld + u.pn * BM + cl;
        f32x4 bv[2][2];
#pragma unroll
        for (int bj = 0; bj < 2; ++bj)
#pragma unroll
            for (int n = 0; n < 2; ++n) bv[bj][n] = *(const f32x4*)(bp + bj * HALF + 4 * n);
#pragma unroll
        for (int ai = 0; ai < 2; ++ai)
#pragma unroll
            for (int m = 0; m < 4; ++m) {
                const int row = row0 + ai * HALF + m * 16; const float r = rs[ai][m];
                if constexpr (MODE == 3) {
                    f32x4 g0 = acc[ai][0][m][0] * r + bv[0][0], g1 = acc[ai][0][m][1] * r + bv[0][1];
                    f32x4 u0 = acc[ai][1][m][0] * r + bv[1][0], u1 = acc[ai][1][m][1] * r + bv[1][1];
                    u32x4 w;
                    w.x = cvt_pk_bf16(siluf_(g0[0]) * u0[0], siluf_(g0[1]) * u0[1]); w.y = cvt_pk_bf16(siluf_(g0[2]) * u0[2], siluf_(g0[3]) * u0[3]);
                    w.z = cvt_pk_bf16(siluf_(g1[0]) * u1[0], siluf_(g1[1]) * u1[1]); w.w = cvt_pk_bf16(siluf_(g1[2]) * u1[2], siluf_(g1[3]) * u1[3]);
                    *(u32x4*)(O + (size_t)row * FH + u.pn * HALF + cl) = w;
                } else {
#pragma unroll
                    for (int bj = 0; bj < 2; ++bj) {
                        f32x4 v0 = acc[ai][bj][m][0] * r + bv[bj][0], v1 = acc[ai][bj][m][1] * r + bv[bj][1];
                        const int col = u.pn * BM + bj * HALF + cl;
                        if constexpr (MODE == 0) {
                            if (u.pn < 4 || u.pn >= 16) {
#pragma unroll
                                for (int j = 0; j < 4; ++j) { v0[j] = siluf_(v0[j]); v1[j] = siluf_(v1[j]); } }
                            u32x4 w; w.x = cvt_pk_bf16(v0[0], v0[1]); w.y = cvt_pk_bf16(v0[2], v0[3]); w.z = cvt_pk_bf16(v1[0], v1[1]); w.w = cvt_pk_bf16(v1[2], v1[3]);
                            *(u32x4*)(O + (size_t)row * PLD + col) = w;
                        } else if constexpr (MODE == 1) {
                            if (u.pn < 20) {
                                u32x4 w; w.x = cvt_pk_bf16(v0[0], v0[1]); w.y = cvt_pk_bf16(v0[2], v0[3]); w.z = cvt_pk_bf16(v1[0], v1[1]); w.w = cvt_pk_bf16(v1[2], v1[3]);
                                *(u32x4*)(O + (size_t)row * PLD + col) = w;
                            } else if (bj == 0 && wc < 2) {
                                float* dp = DT + (size_t)row * 64 + cl; *(f32x4*)dp = v0; *(f32x4*)(dp + 4) = v1;
                            }
                        }
                    }
                }
            }
    }
};
struct EpiQKV {
    static constexpr bool PERM = true;
    const float* slots; const float* bias; int bias_ld; bf16_t* O; const float* rope;
    __device__ __forceinline__ void operator()(const f32x4 (&acc)[2][2][4][2], const Unit& u, int wr, int wc, int fr, int fq) const {
        const int row0 = u.pm * BM + wr * 64 + fr; const int var = (u.pm >= 64) ? 1 : 0;
        float rs[2][4]; load_rstd(slots, row0, fq, rs);
        const int cl = wc * 32 + 8 * fq;
        const float* bp = bias + (size_t)var * bias_ld + u.pn * BM + cl;
        f32x4 bv[2][2];
#pragma unroll
        for (int bj = 0; bj < 2; ++bj)
#pragma unroll
            for (int n = 0; n < 2; ++n) bv[bj][n] = *(const f32x4*)(bp + bj * HALF + 4 * n);
        const float qs = (u.pn < 4) ? 0.125f : 1.0f; const float sg = (fq < 2) ? -1.f : 1.f; const bool do_rope = (var == 0) && (u.pn < 5);
        bf16_t* op = O + (size_t)row0 * QK_LD + u.pn * BM + cl;
#pragma unroll
        for (int ai = 0; ai < 2; ++ai)
#pragma unroll
            for (int m = 0; m < 4; ++m) { const int row = row0 + ai * HALF + m * 16; const float r = rs[ai][m];
                f32x4 c0 = {1.f, 1.f, 1.f, 1.f}, c1 = c0, s0 = {0.f, 0.f, 0.f, 0.f}, s1 = s0;
                if (do_rope) { const int pos = (wc & 1) ? (row & 63) : (row >> 6); const float* cp = rope + pos * 16 + 8 * (fq & 1);
                    c0 = *(const f32x4*)cp; c1 = *(const f32x4*)(cp + 4); s0 = *(const f32x4*)(cp + 4096) * sg; s1 = *(const f32x4*)(cp + 4100) * sg; }
#pragma unroll
                for (int bj = 0; bj < 2; ++bj) { f32x4 v0 = acc[ai][bj][m][0] * r + bv[bj][0], v1 = acc[ai][bj][m][1] * r + bv[bj][1];
                    f32x4 p0, p1;
#pragma unroll
                    for (int j = 0; j < 4; ++j) { p0[j] = __shfl_xor(v0[j], 32); p1[j] = __shfl_xor(v1[j], 32); }
                    v0 = (v0 * c0 + p0 * s0) * qs; v1 = (v1 * c1 + p1 * s1) * qs;
                    u32x4 w; w.x = cvt_pk_bf16(v0[0], v0[1]); w.y = cvt_pk_bf16(v0[2], v0[3]); w.z = cvt_pk_bf16(v1[0], v1[1]); w.w = cvt_pk_bf16(v1[2], v1[3]);
                    *(u32x4*)(op + (size_t)(ai * HALF + m * 16) * QK_LD + bj * HALF) = w; }
                asm volatile("" ::: "memory"); }
    }
};
struct EpiResid {
    static constexpr bool PERM = false;
    const float* base_lat; const float* base_ctx; float* out_lat; float* out_ctx;
    const float* gate; const float* csn; bf16_t* xs; float* slots;
    __device__ __forceinline__ void operator()(const f32x4 (&acc)[2][2][4][2], const Unit& u, int wr, int wc, int fr, int fq) const {
        const int var = (u.pm >= 64) ? 1 : 0;
        const int row0 = u.pm * BM + wr * 64 + fr, col0 = u.pn * BM + wc * 32 + 4 * fq;
        const float* base = var ? base_ctx - (size_t)NLAT * D : base_lat; float* out = var ? out_ctx - (size_t)NLAT * D : out_lat;
        f32x4 gv[2][2], cv[2][2];
#pragma unroll
        for (int bj = 0; bj < 2; ++bj)
#pragma unroll
            for (int n = 0; n < 2; ++n) { gv[bj][n] = *(const f32x4*)(gate + var * D + col0 + bj * HALF + n * 16);
                cv[bj][n] = csn ? *(const f32x4*)(csn + var * D + col0 + bj * HALF + n * 16) : (f32x4){0.f, 0.f, 0.f, 0.f}; }
#pragma unroll
        for (int ai = 0; ai < 2; ++ai)
#pragma unroll
            for (int m = 0; m < 4; ++m) {
                const int row = row0 + ai * HALF + m * 16; const size_t off = (size_t)row * D + col0; float ss = 0.f;
#pragma unroll
                for (int bj = 0; bj < 2; ++bj)
#pragma unroll
                    for (int n = 0; n < 2; ++n) {
                        const f32x4 b = *(const f32x4*)(base + off + bj * HALF + n * 16);
                        const f32x4 x = b + gv[bj][n] * acc[ai][bj][m][n];
                        *(f32x4*)(out + off + bj * HALF + n * 16) = x;
                        ss += (x[0] * x[0] + x[1] * x[1]) + (x[2] * x[2] + x[3] * x[3]);
                        if (csn) { const f32x4 y = x * cv[bj][n]; u32x2 w; w.x = cvt_pk_bf16(y[0], y[1]); w.y = cvt_pk_bf16(y[2], y[3]); *(u32x2*)(xs + off + bj * HALF + n * 16) = w; }
                    }
                ss += __shfl_xor(ss, 16); ss += __shfl_xor(ss, 32);
                if (fq == 0) slots[(size_t)row * 16 + u.pn * 4 + wc] = ss;
            }
    }
};

struct Args { const float* in[27]; float* out; unsigned char* ws; int ph_lo, ph_hi; };
struct Frame {
    LAS unsigned char* lds; int tid, lane, wave, G, bid;
    const float* const* in; float* out; unsigned char* ws;
};
#define WSF(off) ((float*)(F.ws + (off)))
#define WSB(off) ((bf16_t*)(F.ws + (off)))

__device__ __forceinline__ void transpose_item(const float* W, int K, int Nsrc, bf16_t* WT, int dst_row0, int src_col0, int kb, LAS float* scr, int lane) {
    const int k0 = 64 * kb;
    if (src_col0 >= 0) {
#pragma unroll 8
        for (int i = 0; i < 32; ++i) { const int kk = 2 * i + (lane >> 5); scr[kk * 33 + (lane & 31)] = W[(size_t)(k0 + kk) * Nsrc + src_col0 + (lane & 31)]; }
    } else {
#pragma unroll 8
        for (int i = 0; i < 32; ++i) { const int kk = 2 * i + (lane >> 5); scr[kk * 33 + (lane & 31)] = 0.f; }
    }
    asm volatile("s_waitcnt lgkmcnt(0)" ::: "memory");
    const int c = lane & 7;
#pragma unroll
    for (int j = 0; j < 4; ++j) { const int n = (lane >> 3) + 8 * j; const LAS float* s = scr + (8 * c) * 33 + n;
        u32x4 o; o.x = pk2(s[0 * 33], s[1 * 33]); o.y = pk2(s[2 * 33], s[3 * 33]); o.z = pk2(s[4 * 33], s[5 * 33]); o.w = pk2(s[6 * 33], s[7 * 33]);
        *(u32x4*)(WT + (size_t)(dst_row0 + n) * K + k0 + 8 * c) = o; }
    asm volatile("s_waitcnt lgkmcnt(0)" ::: "memory");
}
struct ConvJob { int in_idx; size_t src_off; int K, Nsrc, Ndst, mode; size_t dst; };
__device__ __forceinline__ void phase_p0a(Frame& F) {
    {
        LAS float* sv = (LAS float*)F.lds;
        LAS float* red = sv + 2048;
        for (int i = F.tid; i < 2048; i += NTHR) { const float x = (i < 1024) ? F.in[1][i] : F.in[3][i - 1024]; sv[i] = siluf_(x); }
        __syncthreads();
        for (int task = F.bid; task < 256; task += F.G) {
            const int layer = task >> 6, cg_ = task & 63, krow = F.tid >> 5, c4 = F.tid & 31;
            f32x4 aL = {0.f, 0.f, 0.f, 0.f}, aC = {0.f, 0.f, 0.f, 0.f};
            if (c4 < 24) {
                const float* wp = F.in[4] + (size_t)layer * 1024 * 6144 + cg_ * 96 + c4 * 4;
#pragma unroll 8
                for (int j = 0; j < 64; ++j) { const int k = krow + 16 * j; const f32x4 w = *(const f32x4*)(wp + (size_t)k * 6144); aL += w * sv[k]; aC += w * sv[1024 + k]; }
                LAS float* r = red + (krow * 24 + c4) * 8;
                r[0] = aL[0]; r[1] = aL[1]; r[2] = aL[2]; r[3] = aL[3]; r[4] = aC[0]; r[5] = aC[1]; r[6] = aC[2]; r[7] = aC[3];
            }
            __syncthreads();
            if (F.tid < 192) { const int var = F.tid / 96, cc = F.tid % 96; float s = 0.f;
#pragma unroll
                for (int kr = 0; kr < 16; ++kr) s += red[(kr * 24 + (cc >> 2)) * 8 + var * 4 + (cc & 3)];
                const int n = cg_ * 96 + cc; WSF(WS_MODS)[((size_t)layer * 2 + var) * 6144 + n] = s + F.in[5][layer * 6144 + n]; }
            __syncthreads();
        }
    }
    {
        const int gt = F.bid * NTHR + F.tid, GT = F.G * NTHR;
        for (int i = gt; i < 2048; i += GT) {
            const int dir = i >> 10, d = i & 1023; float v[5], mx = -1e30f;
#pragma unroll
            for (int j = 0; j < 5; ++j) { v[j] = F.in[11][(dir * 5 + j) * 1024 + d]; mx = fmaxf(mx, v[j]); }
            float s = 0.f;
#pragma unroll
            for (int j = 0; j < 5; ++j) { v[j] = __expf(v[j] - mx); s += v[j]; }
            WSF(WS_LB)[i] = v[0] / s;
        }
        for (int i = gt; i < 4096; i += GT) {
            const int pos = i >> 4, f = i & 15;
            const float inv = powf(10000.0f, -(float)(2 * f) / 32.0f); const float ang = (float)pos * inv;
            const double rev = (double)ang * 0.15915494309189533577; const float fr_ = (float)(rev - floor(rev));
            WSF(WS_ROPE)[i] = __builtin_amdgcn_cosf(fr_); WSF(WS_ROPE)[4096 + i] = __builtin_amdgcn_sinf(fr_);
        }
    }
    {
        LAS float* scr = (LAS float*)(F.lds + F.wave * 8704);
        const int gw = F.bid * NWAVES + F.wave, NGW = F.G * NWAVES;
        constexpr int NJ = 19;
        const ConvJob jobs[NJ] = {
            {10, 0, 1024, HG_N, HG_N, 0, WS_W_HGIN}, {13, 0, 1024, 1024, 1024, 0, WS_W_HGOUT},
            {14, 0, 1024, SSM_N, SSM_NP, 0, WS_W_SSMIN}, {21, 0, 2048, 1024, 1024, 0, WS_W_SSMOUT},
            {22, 0, 256, 256, 256, 0, WS_W_POOL}, {22, 65536, 256, 256, 256, 0, WS_W_POOL + 131072}, {22, 131072, 256, 256, 256, 0, WS_W_POOL + 262144}, {22, 196608, 256, 256, 256, 0, WS_W_POOL + 393216},
            {24, 0, 1024, ATT_N, ATT_N, 0, WS_W_QKV}, {26, 0, 1024, 1024, 1024, 0, WS_W_ATTOUT},
            {7, 0, 1024, FH2, FH2, 1, WS_W_FFNIN}, {7, (size_t)1024 * FH2, 1024, FH2, FH2, 1, WS_W_FFNIN + (size_t)FH2 * 1024 * 2},
            {7, (size_t)2 * 1024 * FH2, 1024, FH2, FH2, 1, WS_W_FFNIN + (size_t)2 * FH2 * 1024 * 2}, {7, (size_t)3 * 1024 * FH2, 1024, FH2, FH2, 1, WS_W_FFNIN + (size_t)3 * FH2 * 1024 * 2},
            {8, 0, FH, 1024, 1024, 0, WS_W_FFNOUT}, {8, (size_t)FH * 1024, FH, 1024, 1024, 0, WS_W_FFNOUT + (size_t)1024 * FH * 2},
            {8, (size_t)2 * FH * 1024, FH, 1024, 1024, 0, WS_W_FFNOUT + (size_t)2 * 1024 * FH * 2}, {8, (size_t)3 * FH * 1024, FH, 1024, 1024, 0, WS_W_FFNOUT + (size_t)3 * 1024 * FH * 2},
            {0, 0, 0, 0, 0, 0, 0}};
        int total = 0;
#pragma unroll
        for (int j = 0; j < NJ - 1; ++j) total += (jobs[j].Ndst / 32) * (jobs[j].K / 64);
        for (int it = gw; it < total; it += NGW) {
            int r = it, j = 0;
#pragma unroll
            for (int jj = 0; jj < NJ - 1; ++jj) { const int n = (jobs[jj].Ndst / 32) * (jobs[jj].K / 64); if (j == jj && r >= n) { r -= n; j = jj + 1; } }
            int in_idx = 0, K = 0, Nsrc = 0, Ndst = 0, mode = 0; size_t so = 0, dst = 0;
#pragma unroll
            for (int jj = 0; jj < NJ - 1; ++jj) if (j == jj) { in_idx = jobs[jj].in_idx; so = jobs[jj].src_off; K = jobs[jj].K; Nsrc = jobs[jj].Nsrc; Ndst = jobs[jj].Ndst; mode = jobs[jj].mode; dst = jobs[jj].dst; }
            const int nblk = Ndst / 32, kb = r / nblk, nb = r % nblk; const int drow = nb * 32;
            int scol;
            if (mode == 1) { const int pn = drow >> 8, w = drow & 255; scol = (w < 128) ? (pn * 128 + w) : (FH + pn * 128 + (w - 128)); }
            else scol = (drow < Nsrc) ? drow : -1;
            transpose_item(F.in[in_idx] + so, K, Nsrc, WSB(dst), drow, scol, kb, scr, F.lane);
        }
    }
}

__device__ __forceinline__ void phase_p0b(Frame& F) {
    const int gt = F.bid * NTHR + F.tid, GT = F.G * NTHR;
    const float* mods = WSF(WS_MODS);
    for (int i = gt; i < 4 * 2 * 2 * 1024; i += GT) {
        const int k = i & 1023, var = (i >> 10) & 1, nrm = (i >> 11) & 1, layer = i >> 12;
        const float sc = mods[((size_t)layer * 2 + var) * 6144 + (nrm ? 4 : 1) * 1024 + k];
        WSF(WS_CS)[i] = F.in[6][(layer * 2 + nrm) * 1024 + k] * (1.0f + sc);
        float g = mods[((size_t)layer * 2 + var) * 6144 + (nrm ? 5 : 2) * 1024 + k];
        if (layer == 2 && nrm == 0) g *= F.in[23][k];
        WSF(WS_GATE)[i] = g;
    }
    const int gw = F.bid * NWAVES + F.wave, NGW = F.G * NWAVES;
    {
        constexpr int R0 = HG_N, R1 = SSM_NP, R3 = ATT_N, RF = 4 * FH2, RT = R0 + R1 + R3 + RF;
        for (int it = gw; it < RT; it += NGW) {
            int r = it, layer, which, n; const bf16_t* wt;
            if (r < R0) { layer = 0; which = 0; n = r; wt = WSB(WS_W_HGIN) + (size_t)n * D; }
            else if ((r -= R0) < R1) { layer = 1; which = 0; n = r; wt = WSB(WS_W_SSMIN) + (size_t)n * D; }
            else if ((r -= R1) < R3) { layer = 3; which = 0; n = r; wt = WSB(WS_W_QKV) + (size_t)n * D; }
            else { r -= R3; layer = r / FH2; which = 1; n = r % FH2; wt = WSB(WS_W_FFNIN) + ((size_t)layer * FH2 + n) * D; }
            float aL = 0.f, aC = 0.f;
#pragma unroll
            for (int h = 0; h < 2; ++h) {
                const int k0 = h * 512 + F.lane * 8; const u32x4 w = *(const u32x4*)(wt + k0);
                const float* sL = mods + ((size_t)layer * 2 + 0) * 6144 + (which ? 3 : 0) * 1024 + k0; const float* sC = sL + 6144;
                const f32x4 l0 = *(const f32x4*)sL, l1 = *(const f32x4*)(sL + 4), c0 = *(const f32x4*)sC, c1 = *(const f32x4*)(sC + 4);
                const float w0 = lo_bf(w.x), w1 = hi_bf(w.x), w2 = lo_bf(w.y), w3 = hi_bf(w.y), w4 = lo_bf(w.z), w5 = hi_bf(w.z), w6 = lo_bf(w.w), w7 = hi_bf(w.w);
                aL += w0 * l0[0] + w1 * l0[1] + w2 * l0[2] + w3 * l0[3] + w4 * l1[0] + w5 * l1[1] + w6 * l1[2] + w7 * l1[3];
                aC += w0 * c0[0] + w1 * c0[1] + w2 * c0[2] + w3 * c0[3] + w4 * c1[0] + w5 * c1[1] + w6 * c1[2] + w7 * c1[3];
            }
            aL = wave_sum(aL); aC = wave_sum(aC);
            if (F.lane == 0) { float* bp = WSF(which ? WS_BIAS3 : WS_BIAS1) + (size_t)layer * 2 * FH2 + n; bp[0] = aL; bp[FH2] = aC; }
        }
    }
    for (int row = gw; row < MALL; row += NGW) {
        const int var = row >= NLAT; const float* xr = var ? F.in[2] + (size_t)(row - NLAT) * D : F.in[0] + (size_t)row * D;
        float ss = 0.f;
#pragma unroll
        for (int j = 0; j < 4; ++j) {
            const int k = j * 256 + F.lane * 4; const f32x4 x = *(const f32x4*)(xr + k);
            const f32x4 nw = *(const f32x4*)(F.in[6] + k); const f32x4 sc = *(const f32x4*)(mods + (size_t)var * 6144 + 1024 + k);
            ss += (x[0] * x[0] + x[1] * x[1]) + (x[2] * x[2] + x[3] * x[3]);
            const f32x4 y = x * (nw * (sc + 1.0f)); u32x2 w; w.x = pk2(y[0], y[1]); w.y = pk2(y[2], y[3]);
            *(u32x2*)(WSB(WS_XSA) + (size_t)row * D + k) = w;
        }
        ss = wave_sum(ss);
        if (F.lane < 16) WSF(WS_SLOTS)[(size_t)row * 16 + F.lane] = (F.lane == 0) ? ss : 0.f;
    }
}

__device__ __forceinline__ int scan_row(int p, int dir) {
    if (p < NCTX) return NLAT + (dir ? NCTX - 1 - p : p);
    const int q = p - NCTX; return dir ? NLAT - 1 - q : q;
}
struct NArgs { const float* in[27]; unsigned char* ws; };
#define NWSF(off) ((float*)(a.ws + (off)))
#define NWSB(off) ((bf16_t*)(a.ws + (off)))
__global__ void __launch_bounds__(128) naive_hg_scan_k(NArgs a) {
    __shared__ float sh[384];
    const bf16_t* P = NWSB(WS_P); bf16_t* OX = NWSB(WS_ST); const int tid = threadIdx.x;
    const int job = blockIdx.x, dir = job >> 3, h = job & 7;
    float S[128];
#pragma unroll
    for (int d = 0; d < 128; ++d) S[d] = 0.f;
    const float lb = NWSF(WS_LB)[dir * 1024 + h * 128 + tid];
    for (int p = 0; p < MALL; ++p) {
        const int row = scan_row(p, dir); const bf16_t* pr = P + (size_t)row * PLD;
        const float z = bf2f(pr[1024 + dir * 1024 + h * 128 + tid]); const float sg = 1.0f / (1.0f + expf(-z));
        sh[tid] = lb + (1.f - lb) * sg; sh[128 + tid] = (1.f - lb) * (1.f - sg); sh[256 + tid] = bf2f(pr[h * 128 + tid]);
        __syncthreads();
        const float v = bf2f(pr[3072 + h * 128 + tid]); float o = 0.f;
#pragma unroll
        for (int d = 0; d < 128; ++d) { S[d] = sh[d] * S[d] + sh[128 + d] * v; o += S[d] * sh[256 + d]; }
        OX[((size_t)dir * MALL + row) * D + h * 128 + tid] = (bf16_t)f2bf(o);
        __syncthreads();
    }
}
__global__ void __launch_bounds__(256) naive_hg_readout_k(NArgs a) {
    const bf16_t* P = NWSB(WS_P); const bf16_t* OX = NWSB(WS_ST); bf16_t* O = NWSB(WS_XSA);
    const int lane = threadIdx.x & 63, gw = blockIdx.x * 4 + (threadIdx.x >> 6), NGW = gridDim.x * 4;
    for (int it = gw; it < MALL * 8; it += NGW) {
        const int row = it >> 3, h = it & 7; const int c = h * 128 + lane * 2;
        const unsigned x = *(const unsigned*)(OX + (size_t)row * D + c), y = *(const unsigned*)(OX + ((size_t)MALL + row) * D + c);
        const float o0 = lo_bf(x) + lo_bf(y), o1 = hi_bf(x) + hi_bf(y);
        const float ss = wave_sum(o0 * o0 + o1 * o1); const float r = rsqrtf(ss * (1.0f / 128.0f) + EPS);
        const unsigned gg = *(const unsigned*)(P + (size_t)row * PLD + 4096 + c);
        const float w0 = a.in[12][lane * 2], w1 = a.in[12][lane * 2 + 1];
        *(unsigned*)(O + (size_t)row * D + c) = pk2(o0 * r * w0 * lo_bf(gg), o1 * r * w1 * hi_bf(gg));
    }
}
__global__ void __launch_bounds__(384) naive_ssm_scan_k(NArgs a) {
    __shared__ float sh[384];
    const bf16_t* P = NWSB(WS_P); bf16_t* YB = NWSB(WS_ST); const int tid = threadIdx.x;
    const int h = blockIdx.x, g = h >> 3;
    int ch = 0; if (tid < 64) ch = h * 64 + tid; else if (tid < 192) ch = 2048 + g * 128 + (tid - 64); else if (tid < 320) ch = 2560 + g * 128 + (tid - 192);
    float cw[5] = {0.f, 0.f, 0.f, 0.f, 0.f}, cb = 0.f;
    if (tid < 320) {
#pragma unroll
        for (int j = 0; j < 5; ++j) cw[j] = a.in[15][j * SSM_CD + ch];
        cb = a.in[16][ch]; }
    for (int dir = 1; dir >= 0; --dir) {
        const float A = -expf(a.in[18][dir * 32 + h]), dtb = a.in[17][dir * 32 + h], Dk = a.in[19][h];
        float S[128];
#pragma unroll
        for (int n = 0; n < 128; ++n) S[n] = 0.f;
        for (int p = 0; p < MALL; ++p) {
            const int row = scan_row(p, dir);
            const int s0 = (row >= NLAT) ? NLAT : 0, s1 = (row >= NLAT) ? MALL : NLAT;
            if (tid < 320) {
                float acc = cb;
#pragma unroll
                for (int j = 0; j < 5; ++j) { const int rr = row + j - 2; if (rr >= s0 && rr < s1) acc += cw[j] * bf2f(P[(size_t)rr * PLD + 2048 + ch]); }
                sh[tid] = acc / (1.0f + expf(-acc));
            } else if (tid == 320) {
                const float x = NWSF(WS_DT)[(size_t)row * 64 + dir * 32 + h] + dtb; const float dt = (x > 20.f) ? x : log1pf(expf(x));
                sh[320] = dt; sh[321] = expf(dt * A);
            }
            __syncthreads();
            if (tid < 64) {
                const float xp = sh[tid], dt = sh[320], da = sh[321], dx = dt * xp; float y = 0.f;
#pragma unroll
                for (int n = 0; n < 128; ++n) { S[n] = da * S[n] + dx * sh[64 + n]; y += S[n] * sh[192 + n]; }
                bf16_t* yp = YB + (size_t)row * SSM_DI + h * 64 + tid;
                if (dir == 1) *yp = (bf16_t)f2bf(y); else *yp = (bf16_t)f2bf(y + bf2f(*yp) + Dk * xp);
            }
            __syncthreads();
        }
    }
}
__global__ void __launch_bounds__(256) naive_ssm_readout_k(NArgs a) {
    bf16_t* P = NWSB(WS_P); const bf16_t* YB = NWSB(WS_ST);
    const int lane = threadIdx.x & 63, gw = blockIdx.x * 4 + (threadIdx.x >> 6), NGW = gridDim.x * 4;
    for (int it = gw; it < MALL * 4; it += NGW) {
        const int row = it >> 2, g = it & 3; const int c = g * 512 + lane * 8;
        const u32x4 yv = *(const u32x4*)(YB + (size_t)row * SSM_DI + c), zv = *(const u32x4*)(P + (size_t)row * PLD + c);
        float y[8]; const unsigned yw[4] = {yv.x, yv.y, yv.z, yv.w}, zw[4] = {zv.x, zv.y, zv.z, zv.w}; float ss = 0.f;
#pragma unroll
        for (int j = 0; j < 4; ++j) { const float z0 = lo_bf(zw[j]), z1 = hi_bf(zw[j]);
            y[2 * j] = lo_bf(yw[j]) * (z0 / (1.0f + expf(-z0))); y[2 * j + 1] = hi_bf(yw[j]) * (z1 / (1.0f + expf(-z1))); ss += y[2 * j] * y[2 * j] + y[2 * j + 1] * y[2 * j + 1]; }
        ss = wave_sum(ss); const float r = rsqrtf(ss * (1.0f / 512.0f) + EPS);
        const float* nw = a.in[20] + c; u32x4 o;
        o.x = pk2(y[0] * r * nw[0], y[1] * r * nw[1]); o.y = pk2(y[2] * r * nw[2], y[3] * r * nw[3]); o.z = pk2(y[4] * r * nw[4], y[5] * r * nw[5]); o.w = pk2(y[6] * r * nw[6], y[7] * r * nw[7]);
        *(u32x4*)(P + (size_t)row * PLD + c) = o;
    }
}
__global__ void __launch_bounds__(256) naive_attention_k(NArgs a) {
    const bf16_t* QK = NWSB(WS_P); bf16_t* O = NWSB(WS_XSA);
    const int gt = blockIdx.x * 256 + threadIdx.x, GT = gridDim.x * 256;
    for (int it = gt; it < NLAT * 16; it += GT) {
        const int t = it >> 4, qh = it & 15, kvh = qh >> 2;
        float q[64], acc[64];
#pragma unroll
        for (int d = 0; d < 64; d += 2) { const unsigned w = *(const unsigned*)(QK + (size_t)t * QK_LD + qh * 64 + d); q[d] = lo_bf(w); q[d + 1] = hi_bf(w); acc[d] = 0.f; acc[d + 1] = 0.f; }
        float m = a.in[25][qh], l = 1.0f;
        const int lo = (t - 128 < 0) ? 0 : t - 128, hi = (t + 128 > NLAT - 1) ? NLAT - 1 : t + 128;
        const int nk = (hi - lo + 1) + NCTX;
        for (int i = 0; i < nk; ++i) {
            const int s = (i <= hi - lo) ? lo + i : NLAT + (i - (hi - lo + 1));
            const bf16_t* kp = QK + (size_t)s * QK_LD + 1024 + kvh * 64; float sc = 0.f;
#pragma unroll
            for (int d = 0; d < 64; d += 2) { const unsigned w = *(const unsigned*)(kp + d); sc += q[d] * lo_bf(w) + q[d + 1] * hi_bf(w); }
            const float mn = fmaxf(m, sc), al = expf(m - mn), pe = expf(sc - mn);
            l = l * al + pe; m = mn;
            const bf16_t* vp = kp + 256;
#pragma unroll
            for (int d = 0; d < 64; d += 2) { const unsigned w = *(const unsigned*)(vp + d); acc[d] = acc[d] * al + pe * lo_bf(w); acc[d + 1] = acc[d + 1] * al + pe * hi_bf(w); }
        }
        const float il = 1.0f / l;
#pragma unroll
        for (int d = 0; d < 64; d += 2) *(unsigned*)(O + (size_t)t * D + qh * 64 + d) = pk2(acc[d] * il, acc[d + 1] * il);
    }
}


typedef float f32x16 __attribute__((ext_vector_type(16)));
#define MFMA32(a, b, c) __builtin_amdgcn_mfma_f32_32x32x16_bf16((a), (b), (c), 0, 0, 0)
__device__ __forceinline__ int tc_row0(int tc) { return tc < 256 ? tc * 64 : NLAT + (tc - 256) * 64; }
__device__ __forceinline__ int tc_pf(int tc) { return tc < 256 ? 4 + tc : tc - 256; }
__device__ __forceinline__ int tc_pb(int tc) { return tc < 256 ? 4 + 255 - tc : 3 - (tc - 256); }
__device__ __forceinline__ bf16_t* hg_state(const Frame& F, int dir, int h, int p) {
    return (h < 5) ? (bf16_t*)(F.ws + WS_ST) + ((size_t)(dir * 5 + h) * 260 + p) * 16384 : (bf16_t*)F.out + ((size_t)(dir * 3 + (h - 5)) * 260 + p) * 16384;
}
constexpr int HG_VT = 0, HG_QR = 18432, HG_KR = 53248, HG_QI = 88064, HG_ATT = 122880, HG_SEG = 140288, HG_RED = 144384;
constexpr int HG_PITCH = 272, HG_VPITCH = 144;
static_assert(HG_RED + 1024 <= MISC_OFF, "HGRN LDS map");
struct HgPrep { float k0[16], k1[16], c0[16], c1[16], off0, off1, tot0, tot1, ref0, ref1; };
__device__ __forceinline__ void hg_prep(const Frame& F, const bf16_t* P, int row0, int h, int dir, int seg, int cp, HgPrep& R) {
    const float lb0 = WSF(WS_LB)[dir * 1024 + h * 128 + 2 * cp], lb1 = WSF(WS_LB)[dir * 1024 + h * 128 + 2 * cp + 1];
    unsigned zw[16];
#pragma unroll
    for (int i = 0; i < 16; ++i) { const int si = seg * 16 + i, tok = dir ? 63 - si : si; zw[i] = *(const unsigned*)(P + (size_t)(row0 + tok) * PLD + 1024 + dir * 1024 + h * 128 + 2 * cp); }
    float a0 = 0.f, a1 = 0.f;
#pragma unroll
    for (int i = 0; i < 16; ++i) {
        const float s0 = sigmoidf_(lo_bf(zw[i])), s1 = sigmoidf_(hi_bf(zw[i]));
        a0 += __logf(lb0 + (1.f - lb0) * s0); a1 += __logf(lb1 + (1.f - lb1) * s1);
        R.c0[i] = a0; R.c1[i] = a1; R.k0[i] = (1.f - lb0) * (1.f - s0); R.k1[i] = (1.f - lb1) * (1.f - s1);
    }
    LAS float* sg = (LAS float*)(F.lds + HG_SEG) + (dir * 4) * 128 + 2 * cp;
    sg[seg * 128] = a0; sg[seg * 128 + 1] = a1;
    __syncthreads();
    float o0 = 0.f, o1 = 0.f, t0 = 0.f, t1 = 0.f;
#pragma unroll
    for (int s_ = 0; s_ < 4; ++s_) { const float x0 = sg[s_ * 128], x1 = sg[s_ * 128 + 1]; if (s_ < seg) { o0 += x0; o1 += x1; } t0 += x0; t1 += x1; }
    R.off0 = o0; R.off1 = o1; R.tot0 = t0; R.tot1 = t1; R.ref0 = sg[0] + sg[128]; R.ref1 = sg[1] + sg[129];
}
__device__ __forceinline__ void hg_stage_vt(const Frame& F, const bf16_t* P, int row0, int h, int seg, int cp) {
    unsigned vw[16];
#pragma unroll
    for (int i = 0; i < 16; ++i) vw[i] = *(const unsigned*)(P + (size_t)(row0 + seg * 16 + i) * PLD + 3072 + h * 128 + 2 * cp);
    u32x4 a, b, c, d;
    a.x = (vw[0] & 0xffffu) | (vw[1] << 16); a.y = (vw[2] & 0xffffu) | (vw[3] << 16); a.z = (vw[4] & 0xffffu) | (vw[5] << 16); a.w = (vw[6] & 0xffffu) | (vw[7] << 16);
    b.x = (vw[8] & 0xffffu) | (vw[9] << 16); b.y = (vw[10] & 0xffffu) | (vw[11] << 16); b.z = (vw[12] & 0xffffu) | (vw[13] << 16); b.w = (vw[14] & 0xffffu) | (vw[15] << 16);
    c.x = (vw[0] >> 16) | (vw[1] & 0xffff0000u); c.y = (vw[2] >> 16) | (vw[3] & 0xffff0000u); c.z = (vw[4] >> 16) | (vw[5] & 0xffff0000u); c.w = (vw[6] >> 16) | (vw[7] & 0xffff0000u);
    d.x = (vw[8] >> 16) | (vw[9] & 0xffff0000u); d.y = (vw[10] >> 16) | (vw[11] & 0xffff0000u); d.z = (vw[12] >> 16) | (vw[13] & 0xffff0000u); d.w = (vw[14] >> 16) | (vw[15] & 0xffff0000u);
    LAS unsigned char* r0 = F.lds + HG_VT + (2 * cp) * HG_VPITCH + seg * 32;
    *(LAS u32x4*)r0 = a; *(LAS u32x4*)(r0 + 16) = b; *(LAS u32x4*)(r0 + HG_VPITCH) = c; *(LAS u32x4*)(r0 + HG_VPITCH + 16) = d;
}
__device__ __forceinline__ void phase_hg_a(Frame& F) {
    const bf16_t* P = WSB(WS_P);
    const int dir = F.wave >> 2, seg = F.wave & 3, cp = F.lane, r = F.lane & 31, hf = F.lane >> 5;
    constexpr int HG_KD = HG_QR;
    for (int u = F.bid; u < 260 * 8; u += F.G) {
        const int tc = u >> 3, h = u & 7, row0 = tc_row0(tc), p = dir ? tc_pb(tc) : tc_pf(tc);
        __syncthreads();
        HgPrep R; hg_prep(F, P, row0, h, dir, seg, cp, R);
        if (dir == 0) hg_stage_vt(F, P, row0, h, seg, cp);
        {
            float e0[16], e1[16];
#pragma unroll
            for (int i = 0; i < 16; ++i) { e0[i] = R.k0[i] * __expf(R.tot0 - R.off0 - R.c0[i]); e1[i] = R.k1[i] * __expf(R.tot1 - R.off1 - R.c1[i]); }
            u32x4 a, b, c, d;
            if (dir == 0) {
                a.x = pk2(e0[0], e0[1]); a.y = pk2(e0[2], e0[3]); a.z = pk2(e0[4], e0[5]); a.w = pk2(e0[6], e0[7]); b.x = pk2(e0[8], e0[9]); b.y = pk2(e0[10], e0[11]); b.z = pk2(e0[12], e0[13]); b.w = pk2(e0[14], e0[15]);
                c.x = pk2(e1[0], e1[1]); c.y = pk2(e1[2], e1[3]); c.z = pk2(e1[4], e1[5]); c.w = pk2(e1[6], e1[7]); d.x = pk2(e1[8], e1[9]); d.y = pk2(e1[10], e1[11]); d.z = pk2(e1[12], e1[13]); d.w = pk2(e1[14], e1[15]);
            } else {
                a.x = pk2(e0[15], e0[14]); a.y = pk2(e0[13], e0[12]); a.z = pk2(e0[11], e0[10]); a.w = pk2(e0[9], e0[8]); b.x = pk2(e0[7], e0[6]); b.y = pk2(e0[5], e0[4]); b.z = pk2(e0[3], e0[2]); b.w = pk2(e0[1], e0[0]);
                c.x = pk2(e1[15], e1[14]); c.y = pk2(e1[13], e1[12]); c.z = pk2(e1[11], e1[10]); c.w = pk2(e1[9], e1[8]); d.x = pk2(e1[7], e1[6]); d.y = pk2(e1[5], e1[4]); d.z = pk2(e1[3], e1[2]); d.w = pk2(e1[1], e1[0]);
            }
            const int tok_lo = dir ? 48 - 16 * seg : 16 * seg;
            LAS unsigned char* r0 = F.lds + HG_KD + (dir * 128 + 2 * cp) * HG_VPITCH + tok_lo * 2;
            *(LAS u32x4*)r0 = a; *(LAS u32x4*)(r0 + 16) = b; *(LAS u32x4*)(r0 + HG_VPITCH) = c; *(LAS u32x4*)(r0 + HG_VPITCH + 16) = d;
            if (seg == 0) { float* dp = WSF(WS_DT) + ((size_t)(dir * 8 + h) * 260 + p) * 128 + 2 * cp; dp[0] = __expf(R.tot0); dp[1] = __expf(R.tot1); }
        }
        __syncthreads();
        f32x16 acc[4];
#pragma unroll
        for (int j = 0; j < 4; ++j)
#pragma unroll
            for (int i = 0; i < 16; ++i) acc[j][i] = 0.f;
#pragma unroll
        for (int ks = 0; ks < 4; ++ks) {
            const bf16x8 a = *(const LAS bf16x8*)(F.lds + HG_KD + (dir * 128 + seg * 32 + r) * HG_VPITCH + (ks * 16 + hf * 8) * 2);
#pragma unroll
            for (int j = 0; j < 4; ++j) { const bf16x8 b = *(const LAS bf16x8*)(F.lds + HG_VT + (j * 32 + r) * HG_VPITCH + (ks * 16 + hf * 8) * 2); acc[j] = MFMA32(a, b, acc[j]); }
        }
        bf16_t* st = hg_state(F, dir, h, p);
#pragma unroll
        for (int j = 0; j < 4; ++j)
#pragma unroll
            for (int g = 0; g < 4; ++g) { u32x2 w; w.x = cvt_pk_bf16(acc[j][4 * g], acc[j][4 * g + 1]); w.y = cvt_pk_bf16(acc[j][4 * g + 2], acc[j][4 * g + 3]);
                *(u32x2*)(st + (size_t)(j * 32 + r) * 128 + seg * 32 + 8 * g + 4 * hf) = w; }
    }
}
__device__ __forceinline__ void phase_hg_b(Frame& F) {
    for (int idx = F.bid * NTHR + F.tid; idx < 2 * 8 * 8192; idx += F.G * NTHR) {
        const int e2 = idx & 8191, h = (idx >> 13) & 7, dir = idx >> 16, dv = e2 >> 6, dk = (e2 & 63) * 2;
        unsigned* sp = (unsigned*)(hg_state(F, dir, h, 0) + dv * 128 + dk);
        const f32x2* dp = (const f32x2*)(WSF(WS_DT) + ((size_t)(dir * 8 + h) * 260) * 128 + dk);
        float s0 = 0.f, s1 = 0.f;
        for (int p = 0; p < 260; p += 4) {
            unsigned x[4]; f32x2 d[4];
#pragma unroll
            for (int j = 0; j < 4; ++j) { x[j] = sp[(size_t)(p + j) * 8192]; d[j] = dp[(size_t)(p + j) * 64]; }
#pragma unroll
            for (int j = 0; j < 4; ++j) { sp[(size_t)(p + j) * 8192] = pk2(s0, s1); s0 = d[j].x * s0 + lo_bf(x[j]); s1 = d[j].y * s1 + hi_bf(x[j]); }
        }
    }
}
__device__ __forceinline__ void phase_hg_c(Frame& F) {
    const bf16_t* P = WSB(WS_P); bf16_t* O = WSB(WS_XSA);
    const int dir = F.wave >> 2, seg = F.wave & 3, cp = F.lane, r = F.lane & 31, hf = F.lane >> 5;
    for (int u = F.bid; u < 260 * 8; u += F.G) {
        const int tc = u >> 3, h = u & 7, row0 = tc_row0(tc);
        const int tb2 = F.wave >> 2, jb = F.wave & 3;
        bf16x8 sf[16];
        {
            const bf16_t* s0p = hg_state(F, 0, h, tc_pf(tc)) + (size_t)(jb * 32 + r) * 128 + hf * 8;
            const bf16_t* s1p = hg_state(F, 1, h, tc_pb(tc)) + (size_t)(jb * 32 + r) * 128 + hf * 8;
#pragma unroll
            for (int ks = 0; ks < 8; ++ks) { sf[ks] = *(const bf16x8*)(s0p + ks * 16); sf[8 + ks] = *(const bf16x8*)(s1p + ks * 16); }
        }
        __syncthreads();
        HgPrep R; hg_prep(F, P, row0, h, dir, seg, cp, R);
        if (dir == 0) hg_stage_vt(F, P, row0, h, seg, cp);
        {
#pragma unroll
            for (int i = 0; i < 16; ++i) {
                const int si = seg * 16 + i, tok = dir ? 63 - si : si;
                const unsigned qw = *(const unsigned*)(P + (size_t)(row0 + tok) * PLD + h * 128 + 2 * cp);
                const float q0 = lo_bf(qw), q1 = hi_bf(qw);
                const float cu0 = R.off0 + R.c0[i], cu1 = R.off1 + R.c1[i], a0 = cu0 - R.ref0, a1 = cu1 - R.ref1;
                const int lo = (dir * 64 + tok) * HG_PITCH + 4 * cp;
                *(LAS unsigned*)(F.lds + HG_QR + lo) = pk2(q0 * __expf(a0), q1 * __expf(a1));
                *(LAS unsigned*)(F.lds + HG_KR + lo) = pk2(R.k0[i] * __expf(-a0), R.k1[i] * __expf(-a1));
                *(LAS unsigned*)(F.lds + HG_QI + lo) = pk2(q0 * __expf(cu0), q1 * __expf(cu1));
            }
        }
        __syncthreads();
        {
            const int tb = (F.wave >> 1) & 1, sb = F.wave & 1;
            f32x16 acc;
#pragma unroll
            for (int i = 0; i < 16; ++i) acc[i] = 0.f;
#pragma unroll
            for (int ks = 0; ks < 8; ++ks) {
                const bf16x8 a = *(const LAS bf16x8*)(F.lds + HG_KR + (dir * 64 + sb * 32 + r) * HG_PITCH + (ks * 16 + hf * 8) * 2);
                const bf16x8 b = *(const LAS bf16x8*)(F.lds + HG_QR + (dir * 64 + tb * 32 + r) * HG_PITCH + (ks * 16 + hf * 8) * 2);
                acc = MFMA32(a, b, acc);
            }
            const int t = tb * 32 + r;
#pragma unroll
            for (int g = 0; g < 4; ++g) {
                const int s0 = sb * 32 + 8 * g + 4 * hf; float v[4];
#pragma unroll
                for (int j = 0; j < 4; ++j) { const int s_ = s0 + j; const bool keep = dir ? (s_ >= t) : (s_ <= t); v[j] = keep ? acc[4 * g + j] : 0.f; }
                u32x2 w; w.x = pk2(v[0], v[1]); w.y = pk2(v[2], v[3]);
                *(LAS u32x2*)(F.lds + HG_ATT + t * HG_PITCH + (dir * 64 + s0) * 2) = w;
            }
        }
        __syncthreads();
        f32x16 o;
#pragma unroll
        for (int i = 0; i < 16; ++i) o[i] = 0.f;
#pragma unroll
        for (int ks = 0; ks < 8; ++ks) {
            const bf16x8 a = *(const LAS bf16x8*)(F.lds + HG_VT + (jb * 32 + r) * HG_VPITCH + ((ks & 3) * 16 + hf * 8) * 2);
            const bf16x8 b = *(const LAS bf16x8*)(F.lds + HG_ATT + (tb2 * 32 + r) * HG_PITCH + (ks * 16 + hf * 8) * 2);
            o = MFMA32(a, b, o);
        }
#pragma unroll
        for (int ks = 0; ks < 16; ++ks) {
            const bf16x8 b = *(const LAS bf16x8*)(F.lds + HG_QI + ((ks >> 3) * 64 + tb2 * 32 + r) * HG_PITCH + ((ks & 7) * 16 + hf * 8) * 2);
            o = MFMA32(sf[ks], b, o);
        }
        float ss = 0.f;
#pragma unroll
        for (int i = 0; i < 16; ++i) ss += o[i] * o[i];
        ss += __shfl_xor(ss, 32);
        LAS float* red = (LAS float*)(F.lds + HG_RED);
        if (hf == 0) red[(tb2 * 4 + jb) * 32 + r] = ss;
        __syncthreads();
        const float tot = red[(tb2 * 4 + 0) * 32 + r] + red[(tb2 * 4 + 1) * 32 + r] + red[(tb2 * 4 + 2) * 32 + r] + red[(tb2 * 4 + 3) * 32 + r];
        const float rn = rsqrtf(tot * (1.0f / 128.0f) + EPS);
        const int row = row0 + tb2 * 32 + r;
#pragma unroll
        for (int g = 0; g < 4; ++g) {
            const int dv = jb * 32 + 8 * g + 4 * hf;
            const u32x2 gw = *(const u32x2*)(P + (size_t)row * PLD + 4096 + h * 128 + dv);
            const f32x4 nw = *(const f32x4*)(F.in[12] + dv);
            u32x2 w; w.x = pk2(o[4 * g] * rn * nw[0] * lo_bf(gw.x), o[4 * g + 1] * rn * nw[1] * hi_bf(gw.x));
            w.y = pk2(o[4 * g + 2] * rn * nw[2] * lo_bf(gw.y), o[4 * g + 3] * rn * nw[3] * hi_bf(gw.y));
            *(u32x2*)(O + (size_t)row * D + h * 128 + dv) = w;
        }
    }
}


constexpr int AT_K = 0, AT_V = 2 * 9216, AT_PITCH = 144;
__device__ __forceinline__ void phase_att(Frame& F) {
    const bf16_t* QKV = WSB(WS_P); bf16_t* O = WSB(WS_XSA);
    const int r = F.lane & 31, hf = F.lane >> 5, g = F.wave >> 1, th = F.wave & 1;
    const int kkey = F.tid >> 3, kc = F.tid & 7, vkey = F.tid & 63, vdg = F.tid >> 6;
    for (int u = F.bid; u < 1024; u += F.G) {
        const int kvh = u & 3, t0 = (u >> 2) * 64, qh = kvh * 4 + g, t = t0 + 32 * th + r;
        bf16x8 qf[4];
#pragma unroll
        for (int ks = 0; ks < 4; ++ks) qf[ks] = *(const bf16x8*)(QKV + (size_t)t * QK_LD + qh * 64 + ks * 16 + hf * 8);
        int jfirst = 0, jlast = 4;
        if (t0 - 128 < 0) jfirst = (128 - t0) >> 6;
        if (t0 + 191 >= NLAT) jlast = 4 - ((t0 + 192 - NLAT) >> 6);
        const int ntl = jlast - jfirst + 1, nt = ntl + 4;
        const bf16_t* kbase = QKV + 1024 + kvh * 64;
        u32x4 kreg, vreg;
#define AT_LOAD(it) do { const int s0_ = ((it) < ntl) ? (t0 - 128 + 64 * (jfirst + (it))) : (NLAT + 64 * ((it) - ntl)); \
            kreg = *(const u32x4*)(kbase + (size_t)(s0_ + kkey) * QK_LD + 8 * kc); vreg = *(const u32x4*)(kbase + (size_t)(s0_ + vkey) * QK_LD + 256 + 8 * vdg); } while (0)
#define AT_WRITE(b) do { *(LAS u32x4*)(F.lds + AT_K + (b) * 9216 + kkey * AT_PITCH + 16 * kc) = kreg; \
            LAS unsigned short* vp_ = (LAS unsigned short*)(F.lds + AT_V + (b) * 9216 + (8 * vdg) * AT_PITCH + vkey * 2); \
            vp_[0] = (unsigned short)(vreg.x & 0xffffu); vp_[AT_PITCH / 2] = (unsigned short)(vreg.x >> 16); vp_[2 * (AT_PITCH / 2)] = (unsigned short)(vreg.y & 0xffffu); vp_[3 * (AT_PITCH / 2)] = (unsigned short)(vreg.y >> 16); \
            vp_[4 * (AT_PITCH / 2)] = (unsigned short)(vreg.z & 0xffffu); vp_[5 * (AT_PITCH / 2)] = (unsigned short)(vreg.z >> 16); vp_[6 * (AT_PITCH / 2)] = (unsigned short)(vreg.w & 0xffffu); vp_[7 * (AT_PITCH / 2)] = (unsigned short)(vreg.w >> 16); } while (0)
        AT_LOAD(0); AT_WRITE(0);
        __syncthreads();
        float m = F.in[25][qh], l = 1.0f;
        f32x16 o0, o1;
#pragma unroll
        for (int i = 0; i < 16; ++i) { o0[i] = 0.f; o1[i] = 0.f; }
        for (int it = 0; it < nt; ++it) {
            const int b = it & 1;
            if (it + 1 < nt) AT_LOAD(it + 1);
            f32x16 x0, x1;
#pragma unroll
            for (int i = 0; i < 16; ++i) { x0[i] = 0.f; x1[i] = 0.f; }
#pragma unroll
            for (int ks = 0; ks < 4; ++ks) {
                const bf16x8 a0 = *(const LAS bf16x8*)(F.lds + AT_K + b * 9216 + r * AT_PITCH + (ks * 16 + hf * 8) * 2);
                const bf16x8 a1 = *(const LAS bf16x8*)(F.lds + AT_K + b * 9216 + (32 + r) * AT_PITCH + (ks * 16 + hf * 8) * 2);
                x0 = MFMA32(a0, qf[ks], x0); x1 = MFMA32(a1, qf[ks], x1);
            }
            if (it < ntl) { const int j = jfirst + it;
                if (j == 0 || j == 4) { const int s0 = t0 - 128 + 64 * j;
#pragma unroll
                    for (int i = 0; i < 16; ++i) { const int sk = s0 + (i & 3) + 8 * (i >> 2) + 4 * hf; const int d0 = sk - t, d1 = sk + 32 - t;
                        if (d0 < -128 || d0 > 128) x0[i] = -1e30f; if (d1 < -128 || d1 > 128) x1[i] = -1e30f; } } }
            float mx = x0[0];
#pragma unroll
            for (int i = 0; i < 16; ++i) { mx = fmaxf(mx, x0[i]); mx = fmaxf(mx, x1[i]); }
            mx = fmaxf(mx, __shfl_xor(mx, 32));
            const float mn = fmaxf(m, mx), al = __expf(m - mn); m = mn;
            float ls = 0.f;
#pragma unroll
            for (int i = 0; i < 16; ++i) { x0[i] = __expf(x0[i] - mn); x1[i] = __expf(x1[i] - mn); ls += x0[i] + x1[i]; }
            ls += __shfl_xor(ls, 32);
            l = l * al + ls;
#pragma unroll
            for (int i = 0; i < 16; ++i) { o0[i] *= al; o1[i] *= al; }
#pragma unroll
            for (int kt = 0; kt < 2; ++kt)
#pragma unroll
                for (int s_ = 0; s_ < 2; ++s_) {
                    u32x4 pw;
                    if (kt == 0) { pw.x = cvt_pk_bf16(x0[8 * s_], x0[8 * s_ + 1]); pw.y = cvt_pk_bf16(x0[8 * s_ + 2], x0[8 * s_ + 3]); pw.z = cvt_pk_bf16(x0[8 * s_ + 4], x0[8 * s_ + 5]); pw.w = cvt_pk_bf16(x0[8 * s_ + 6], x0[8 * s_ + 7]); }
                    else { pw.x = cvt_pk_bf16(x1[8 * s_], x1[8 * s_ + 1]); pw.y = cvt_pk_bf16(x1[8 * s_ + 2], x1[8 * s_ + 3]); pw.z = cvt_pk_bf16(x1[8 * s_ + 4], x1[8 * s_ + 5]); pw.w = cvt_pk_bf16(x1[8 * s_ + 6], x1[8 * s_ + 7]); }
                    const bf16x8 pb = __builtin_bit_cast(bf16x8, pw);
                    const int koff = (kt * 32 + 16 * s_ + 4 * hf) * 2;
                    const LAS unsigned char* v0p = F.lds + AT_V + b * 9216 + r * AT_PITCH + koff; const LAS unsigned char* v1p = v0p + 32 * AT_PITCH;
                    u32x4 a0w, a1w; const u32x2 a00 = *(const LAS u32x2*)v0p, a01 = *(const LAS u32x2*)(v0p + 16), a10 = *(const LAS u32x2*)v1p, a11 = *(const LAS u32x2*)(v1p + 16);
                    a0w.x = a00.x; a0w.y = a00.y; a0w.z = a01.x; a0w.w = a01.y; a1w.x = a10.x; a1w.y = a10.y; a1w.z = a11.x; a1w.w = a11.y;
                    o0 = MFMA32(__builtin_bit_cast(bf16x8, a0w), pb, o0); o1 = MFMA32(__builtin_bit_cast(bf16x8, a1w), pb, o1);
                }
            if (it + 1 < nt) AT_WRITE(b ^ 1);
            __syncthreads();
        }
        const float il = 1.0f / l;
#pragma unroll
        for (int g4 = 0; g4 < 4; ++g4) {
            const int d = 8 * g4 + 4 * hf;
            u32x2 w0, w1; w0.x = cvt_pk_bf16(o0[4 * g4] * il, o0[4 * g4 + 1] * il); w0.y = cvt_pk_bf16(o0[4 * g4 + 2] * il, o0[4 * g4 + 3] * il);
            w1.x = cvt_pk_bf16(o1[4 * g4] * il, o1[4 * g4 + 1] * il); w1.y = cvt_pk_bf16(o1[4 * g4 + 2] * il, o1[4 * g4 + 3] * il);
            *(u32x2*)(O + (size_t)t * D + qh * 64 + d) = w0; *(u32x2*)(O + (size_t)t * D + qh * 64 + 32 + d) = w1;
        }
#undef AT_LOAD
#undef AT_WRITE
    }
}


constexpr size_t WS_SDEC = WS_CTL + 32768;
__device__ __forceinline__ bf16_t* ssm_state(const Frame& F, int dir, int h, int p) { return (bf16_t*)(F.ws + WS_ST) + ((size_t)(dir * 32 + h) * 65 + p) * 8192; }
constexpr int SS_PT = 528;
constexpr int SA_BT = 0, SA_XW = 128 * SS_PT, SA_SC = SA_XW + 2 * 64 * SS_PT;
constexpr int SC_BM = 0, SC_XT = 256 * 272, SC_SC = SC_XT + 64 * SS_PT;
static_assert(SA_SC + 4096 <= MISC_OFF && SC_SC + 4096 <= MISC_OFF, "Mamba LDS map");
__device__ __forceinline__ float wave_incl_scan(float v, int lane) {
#pragma unroll
    for (int o = 1; o < 64; o <<= 1) { const float t = __shfl_up(v, o); if (lane >= o) v += t; }
    return v;
}
__device__ __forceinline__ void ssm_scalars(const Frame& F, LAS float* SC, int r0, int h) {
    if (F.wave < 2) {
        const int dir = F.wave; const float A = -__expf(F.in[18][dir * 32 + h]), dtb = F.in[17][dir * 32 + h];
        float dt[4], c[4], run = 0.f;
#pragma unroll
        for (int j = 0; j < 4; ++j) { const int i = dir ? 255 - (4 * F.lane + j) : 4 * F.lane + j;
            const float x = WSF(WS_DT)[(size_t)(r0 + i) * 64 + dir * 32 + h] + dtb; dt[j] = (x > 20.f) ? x : log1pf(__expf(x)); run += dt[j] * A; c[j] = run; }
        const float off = wave_incl_scan(run, F.lane) - run;
#pragma unroll
        for (int j = 0; j < 4; ++j) { const int i = dir ? 255 - (4 * F.lane + j) : 4 * F.lane + j; SC[dir * 256 + i] = dt[j]; SC[512 + dir * 256 + i] = off + c[j]; }
    }
    __syncthreads();
}
__device__ __forceinline__ unsigned ld_raw(const bf16_t* colp, int rr, int s_lo, int s_hi) { const int rc = rr < s_lo ? s_lo : (rr >= s_hi ? s_hi - 1 : rr); const unsigned v = *(const unsigned*)(colp + (size_t)rc * PLD); return (rc == rr) ? v : 0u; }
#define SSM_CONV_SEG(colp, ch, r0, seg, s_lo, s_hi, EMIT) do { \
    float cw0_[5], cw1_[5]; _Pragma("unroll") for (int j_ = 0; j_ < 5; ++j_) { cw0_[j_] = F.in[15][j_ * SSM_CD + (ch)]; cw1_[j_] = F.in[15][j_ * SSM_CD + (ch) + 1]; } \
    const float cb0_ = F.in[16][(ch)], cb1_ = F.in[16][(ch) + 1]; \
    const int rb_ = (r0) + (seg) * 64; unsigned w0_ = ld_raw(colp, rb_ - 2, s_lo, s_hi), w1_ = ld_raw(colp, rb_ - 1, s_lo, s_hi), w2_ = ld_raw(colp, rb_, s_lo, s_hi), w3_ = ld_raw(colp, rb_ + 1, s_lo, s_hi); \
    for (int g8_ = 0; g8_ < 8; ++g8_) { float o0_[8], o1_[8]; \
        _Pragma("unroll") for (int j_ = 0; j_ < 8; ++j_) { const unsigned w4_ = ld_raw(colp, rb_ + g8_ * 8 + j_ + 2, s_lo, s_hi); \
            const float a0_ = cb0_ + cw0_[0] * lo_bf(w0_) + cw0_[1] * lo_bf(w1_) + cw0_[2] * lo_bf(w2_) + cw0_[3] * lo_bf(w3_) + cw0_[4] * lo_bf(w4_); \
            const float a1_ = cb1_ + cw1_[0] * hi_bf(w0_) + cw1_[1] * hi_bf(w1_) + cw1_[2] * hi_bf(w2_) + cw1_[3] * hi_bf(w3_) + cw1_[4] * hi_bf(w4_); \
            o0_[j_] = siluf_(a0_); o1_[j_] = siluf_(a1_); w0_ = w1_; w1_ = w2_; w2_ = w3_; w3_ = w4_; } \
        EMIT((seg) * 64 + g8_ * 8, o0_, o1_); } } while (0)
__device__ __forceinline__ u32x4 pack8(const float (&v)[8]) { u32x4 w; w.x = cvt_pk_bf16(v[0], v[1]); w.y = cvt_pk_bf16(v[2], v[3]); w.z = cvt_pk_bf16(v[4], v[5]); w.w = cvt_pk_bf16(v[6], v[7]); return w; }
__device__ __forceinline__ void run_geom(int ru, int& r0, int& s_lo, int& s_hi, int& pf, int& pb) {
    if (ru < 64) { r0 = ru * 256; s_lo = 0; s_hi = NLAT; pf = 1 + ru; pb = 1 + (63 - ru); } else { r0 = NLAT; s_lo = NLAT; s_hi = MALL; pf = 0; pb = 0; }
}
__device__ __forceinline__ void phase_ssm_a(Frame& F) {
    const bf16_t* P = WSB(WS_P); LAS float* SC = (LAS float*)(F.lds + SA_SC);
    const int r = F.lane & 31, hf = F.lane >> 5;
    for (int u = F.bid; u < 65 * 32 + 65 * 4; u += F.G) {
        if (u >= 65 * 32) {
            const int v = u - 65 * 32, ru = v >> 2, g = v & 3; int r0, s_lo, s_hi, pf, pb; run_geom(ru, r0, s_lo, s_hi, pf, pb);
            const int seg = F.tid >> 7, cp = F.tid & 127; const int ch = (cp < 64) ? 2048 + g * 128 + 2 * cp : 2560 + g * 128 + 2 * (cp - 64);
            const bf16_t* colp = P + 2048 + ch; bf16_t* bc = WSB(WS_XSA) + (size_t)r0 * 1024 + g * 256 + 2 * cp;
#define EMIT_BC(i0, o0, o1) do { _Pragma("unroll") for (int j = 0; j < 8; ++j) *(unsigned*)(bc + (size_t)((i0) + j) * 1024) = cvt_pk_bf16(o0[j], o1[j]); } while (0)
            SSM_CONV_SEG(colp, ch, r0, seg, s_lo, s_hi, EMIT_BC);
#undef EMIT_BC
            continue;
        }
        const int ru = u >> 5, h = u & 31, g = h >> 3; int r0, s_lo, s_hi, pf, pb; run_geom(ru, r0, s_lo, s_hi, pf, pb);
        __syncthreads();
        ssm_scalars(F, SC, r0, h);
        const float lastf = SC[512 + 255], lastb = SC[768];
        if (F.tid < 384) {
            const int seg = F.tid / 96, cp = F.tid % 96;
            if (cp < 32) {
                const int ch = h * 64 + 2 * cp; const bf16_t* colp = P + 2048 + ch;
#define EMIT_XW(i0, o0, o1) do { float f0[8], f1[8], b0[8], b1[8]; _Pragma("unroll") for (int j = 0; j < 8; ++j) { const int i = (i0) + j; \
                    const float wf = SC[i] * __expf(lastf - SC[512 + i]), wb = SC[256 + i] * __expf(lastb - SC[768 + i]); f0[j] = o0[j] * wf; f1[j] = o1[j] * wf; b0[j] = o0[j] * wb; b1[j] = o1[j] * wb; } \
                    LAS unsigned char* xp = F.lds + SA_XW + (2 * cp) * SS_PT + (i0) * 2; *(LAS u32x4*)xp = pack8(f0); *(LAS u32x4*)(xp + SS_PT) = pack8(f1); \
                    *(LAS u32x4*)(xp + 64 * SS_PT) = pack8(b0); *(LAS u32x4*)(xp + 65 * SS_PT) = pack8(b1); } while (0)
                SSM_CONV_SEG(colp, ch, r0, seg, s_lo, s_hi, EMIT_XW);
#undef EMIT_XW
            } else {
                const int n = 2 * (cp - 32), ch = 2048 + g * 128 + n; const bf16_t* colp = P + 2048 + ch;
#define EMIT_BT(i0, o0, o1) do { LAS unsigned char* bp = F.lds + SA_BT + n * SS_PT + (i0) * 2; *(LAS u32x4*)bp = pack8(o0); *(LAS u32x4*)(bp + SS_PT) = pack8(o1); } while (0)
                SSM_CONV_SEG(colp, ch, r0, seg, s_lo, s_hi, EMIT_BT);
#undef EMIT_BT
            }
        }
        if (F.tid == 0) { WSF(WS_SDEC)[(0 * 32 + h) * 65 + pf] = __expf(lastf); WSF(WS_SDEC)[(1 * 32 + h) * 65 + pb] = __expf(lastb); }
        __syncthreads();
        const int dir = F.wave >> 2, pt = (F.wave >> 1) & 1, nt0 = 2 * (F.wave & 1);
        f32x16 acc0, acc1;
#pragma unroll
        for (int i = 0; i < 16; ++i) { acc0[i] = 0.f; acc1[i] = 0.f; }
#pragma unroll 4
        for (int ks = 0; ks < 16; ++ks) {
            const bf16x8 b = *(const LAS bf16x8*)(F.lds + SA_XW + (dir * 64 + pt * 32 + r) * SS_PT + (ks * 16 + hf * 8) * 2);
            const bf16x8 a0 = *(const LAS bf16x8*)(F.lds + SA_BT + (nt0 * 32 + r) * SS_PT + (ks * 16 + hf * 8) * 2);
            const bf16x8 a1 = *(const LAS bf16x8*)(F.lds + SA_BT + ((nt0 + 1) * 32 + r) * SS_PT + (ks * 16 + hf * 8) * 2);
            acc0 = MFMA32(a0, b, acc0); acc1 = MFMA32(a1, b, acc1);
        }
        bf16_t* st = ssm_state(F, dir, h, dir ? pb : pf) + (size_t)(pt * 32 + r) * 128;
#pragma unroll
        for (int g4 = 0; g4 < 4; ++g4) { u32x2 w0, w1; w0.x = cvt_pk_bf16(acc0[4 * g4], acc0[4 * g4 + 1]); w0.y = cvt_pk_bf16(acc0[4 * g4 + 2], acc0[4 * g4 + 3]);
            w1.x = cvt_pk_bf16(acc1[4 * g4], acc1[4 * g4 + 1]); w1.y = cvt_pk_bf16(acc1[4 * g4 + 2], acc1[4 * g4 + 3]);
            *(u32x2*)(st + nt0 * 32 + 8 * g4 + 4 * hf) = w0; *(u32x2*)(st + (nt0 + 1) * 32 + 8 * g4 + 4 * hf) = w1; }
    }
}
__device__ __forceinline__ void phase_ssm_b(Frame& F) {
    for (int idx = F.bid * NTHR + F.tid; idx < 2 * 32 * 4096; idx += F.G * NTHR) {
        const int e2 = idx & 4095, hh = idx >> 12;
        unsigned* sp = (unsigned*)((bf16_t*)(F.ws + WS_ST) + (size_t)hh * 65 * 8192) + e2;
        const float* dp = WSF(WS_SDEC) + hh * 65;
        float s0 = 0.f, s1 = 0.f;
        for (int p = 0; p < 65; p += 5) {
            unsigned x[5]; float d[5];
#pragma unroll
            for (int j = 0; j < 5; ++j) { x[j] = sp[(size_t)(p + j) * 4096]; d[j] = dp[p + j]; }
#pragma unroll
            for (int j = 0; j < 5; ++j) { sp[(size_t)(p + j) * 4096] = cvt_pk_bf16(s0, s1); s0 = d[j] * s0 + lo_bf(x[j]); s1 = d[j] * s1 + hi_bf(x[j]); }
        }
    }
}
__device__ __forceinline__ void phase_ssm_c(Frame& F) {
    bf16_t* P = WSB(WS_P); LAS float* SC = (LAS float*)(F.lds + SC_SC); const bf16_t* BC = WSB(WS_XSA);
    const int r = F.lane & 31, hf = F.lane >> 5, w = F.wave;
    for (int u = F.bid; u < 65 * 32; u += F.G) {
        const int ru = u >> 5, h = u & 31, g = h >> 3; int r0, s_lo, s_hi, pf, pb; run_geom(ru, r0, s_lo, s_hi, pf, pb);
        __syncthreads();
        ssm_scalars(F, SC, r0, h);
        const int ti = 32 * w + r, trow = r0 + ti;
        bf16x8 cf[8];
#pragma unroll
        for (int ks = 0; ks < 8; ++ks) cf[ks] = *(const bf16x8*)(BC + (size_t)trow * 1024 + g * 256 + 128 + ks * 16 + hf * 8);
#pragma unroll
        for (int k = 0; k < 8; ++k) { const int idx = F.tid + 512 * k, row = idx >> 4, c16 = idx & 15;
            *(LAS u32x4*)(F.lds + SC_BM + row * 272 + c16 * 16) = *(const u32x4*)(BC + (size_t)(r0 + row) * 1024 + g * 256 + c16 * 8); }
        if (F.tid < 128) {
            const int seg = F.tid >> 5, cp = F.tid & 31;
            const int ch = h * 64 + 2 * cp; const bf16_t* colp = P + 2048 + ch;
#define EMIT_XT(i0, o0, o1) do { LAS unsigned char* xp = F.lds + SC_XT + (2 * cp) * SS_PT + (i0) * 2; *(LAS u32x4*)xp = pack8(o0); *(LAS u32x4*)(xp + SS_PT) = pack8(o1); } while (0)
            SSM_CONV_SEG(colp, ch, r0, seg, s_lo, s_hi, EMIT_XT);
#undef EMIT_XT
        }
        __syncthreads();
        const float cft = SC[512 + ti], cbt = SC[768 + ti];
        f32x16 y0, y1;
#pragma unroll
        for (int i = 0; i < 16; ++i) { y0[i] = 0.f; y1[i] = 0.f; }
#pragma unroll 1
        for (int sb = 0; sb < 8; ++sb) {
            f32x16 x;
#pragma unroll
            for (int i = 0; i < 16; ++i) x[i] = 0.f;
#pragma unroll
            for (int ks = 0; ks < 8; ++ks) { const bf16x8 a = *(const LAS bf16x8*)(F.lds + SC_BM + (sb * 32 + r) * 272 + (ks * 16 + hf * 8) * 2); x = MFMA32(a, cf[ks], x); }
#pragma unroll
            for (int g4 = 0; g4 < 4; ++g4) {
                const int sl = sb * 32 + 8 * g4 + 4 * hf;
                const f32x4 dtf = *(const LAS f32x4*)(SC + sl), dtb = *(const LAS f32x4*)(SC + 256 + sl), cfs = *(const LAS f32x4*)(SC + 512 + sl), cbs = *(const LAS f32x4*)(SC + 768 + sl);
#pragma unroll
                for (int j = 0; j < 4; ++j) { const int s_ = sl + j; float m = 0.f;
                    if (s_ <= ti) m += __expf(cft - cfs[j]) * dtf[j];
                    if (s_ >= ti) m += __expf(cbt - cbs[j]) * dtb[j];
                    x[4 * g4 + j] *= m; }
            }
#pragma unroll
            for (int s2 = 0; s2 < 2; ++s2) {
                u32x4 pw; pw.x = cvt_pk_bf16(x[8 * s2], x[8 * s2 + 1]); pw.y = cvt_pk_bf16(x[8 * s2 + 2], x[8 * s2 + 3]); pw.z = cvt_pk_bf16(x[8 * s2 + 4], x[8 * s2 + 5]); pw.w = cvt_pk_bf16(x[8 * s2 + 6], x[8 * s2 + 7]);
                const bf16x8 pb_ = __builtin_bit_cast(bf16x8, pw);
                const LAS unsigned char* a0p = F.lds + SC_XT + r * SS_PT + (sb * 32 + 16 * s2 + 4 * hf) * 2; const LAS unsigned char* a1p = a0p + 32 * SS_PT;
                const u32x2 a00 = *(const LAS u32x2*)a0p, a01 = *(const LAS u32x2*)(a0p + 16), a10 = *(const LAS u32x2*)a1p, a11 = *(const LAS u32x2*)(a1p + 16);
                u32x4 a0w, a1w; a0w.x = a00.x; a0w.y = a00.y; a0w.z = a01.x; a0w.w = a01.y; a1w.x = a10.x; a1w.y = a10.y; a1w.z = a11.x; a1w.w = a11.y;
                y0 = MFMA32(__builtin_bit_cast(bf16x8, a0w), pb_, y0); y1 = MFMA32(__builtin_bit_cast(bf16x8, a1w), pb_, y1);
            }
        }
#pragma unroll
        for (int dir = 0; dir < 2; ++dir) {
            const float e = __expf(dir ? cbt : cft);
            const bf16_t* sp = ssm_state(F, dir, h, dir ? pb : pf) + (size_t)r * 128 + hf * 8;
#pragma unroll
            for (int pt = 0; pt < 2; ++pt) {
                f32x16 yd;
#pragma unroll
                for (int i = 0; i < 16; ++i) yd[i] = 0.f;
#pragma unroll
                for (int kh = 0; kh < 2; ++kh) {
                    bf16x8 sa[4];
#pragma unroll
                    for (int ks = 0; ks < 4; ++ks) sa[ks] = *(const bf16x8*)(sp + (size_t)pt * 32 * 128 + (kh * 4 + ks) * 16);
#pragma unroll
                    for (int ks = 0; ks < 4; ++ks) yd = MFMA32(sa[ks], cf[kh * 4 + ks], yd);
                    asm volatile("" ::: "memory");
                }
                if (pt == 0) {
#pragma unroll
                    for (int i = 0; i < 16; ++i) y0[i] += e * yd[i];
                } else {
#pragma unroll
                    for (int i = 0; i < 16; ++i) y1[i] += e * yd[i];
                }
            }
        }
        const float Dk = F.in[19][h];
        bf16_t* zp = P + (size_t)trow * PLD + h * 64;
#pragma unroll
        for (int g4 = 0; g4 < 4; ++g4) {
            const int p0 = 8 * g4 + 4 * hf;
            const u32x2 z0 = *(const u32x2*)(zp + p0), z1 = *(const u32x2*)(zp + 32 + p0);
            float xa[4], xb[4];
#pragma unroll
            for (int j = 0; j < 4; ++j) { xa[j] = bf2f(*(const LAS unsigned short*)(F.lds + SC_XT + (p0 + j) * SS_PT + ti * 2)); xb[j] = bf2f(*(const LAS unsigned short*)(F.lds + SC_XT + (32 + p0 + j) * SS_PT + ti * 2)); }
            u32x2 o0, o1;
            o0.x = cvt_pk_bf16((y0[4 * g4] + Dk * xa[0]) * siluf_(lo_bf(z0.x)), (y0[4 * g4 + 1] + Dk * xa[1]) * siluf_(hi_bf(z0.x)));
            o0.y = cvt_pk_bf16((y0[4 * g4 + 2] + Dk * xa[2]) * siluf_(lo_bf(z0.y)), (y0[4 * g4 + 3] + Dk * xa[3]) * siluf_(hi_bf(z0.y)));
            o1.x = cvt_pk_bf16((y1[4 * g4] + Dk * xb[0]) * siluf_(lo_bf(z1.x)), (y1[4 * g4 + 1] + Dk * xb[1]) * siluf_(hi_bf(z1.x)));
            o1.y = cvt_pk_bf16((y1[4 * g4 + 2] + Dk * xb[2]) * siluf_(lo_bf(z1.y)), (y1[4 * g4 + 3] + Dk * xb[3]) * siluf_(hi_bf(z1.y)));
            *(u32x2*)(zp + p0) = o0; *(u32x2*)(zp + 32 + p0) = o1;
        }
    }
}
__device__ __forceinline__ void phase_ssm_d(Frame& F) {
    bf16_t* P = WSB(WS_P);
    const int gw = F.bid * NWAVES + F.wave, NGW = F.G * NWAVES;
    for (int it = gw; it < MALL * 4; it += NGW) {
        const int row = it >> 2, g = it & 3; const int c = g * 512 + F.lane * 8;
        const u32x4 yv = *(const u32x4*)(P + (size_t)row * PLD + c);
        float y[8] = {lo_bf(yv.x), hi_bf(yv.x), lo_bf(yv.y), hi_bf(yv.y), lo_bf(yv.z), hi_bf(yv.z), lo_bf(yv.w), hi_bf(yv.w)}; float ss = 0.f;
#pragma unroll
        for (int j = 0; j < 8; ++j) ss += y[j] * y[j];
        ss = wave_sum(ss); const float rn = rsqrtf(ss * (1.0f / 512.0f) + EPS);
        const f32x4 n0 = *(const f32x4*)(F.in[20] + c), n1 = *(const f32x4*)(F.in[20] + c + 4);
        u32x4 o; o.x = cvt_pk_bf16(y[0] * rn * n0[0], y[1] * rn * n0[1]); o.y = cvt_pk_bf16(y[2] * rn * n0[2], y[3] * rn * n0[3]); o.z = cvt_pk_bf16(y[4] * rn * n1[0], y[5] * rn * n1[1]); o.w = cvt_pk_bf16(y[6] * rn * n1[2], y[7] * rn * n1[3]);
        *(u32x4*)(P + (size_t)row * PLD + c) = o;
    }
}

__device__ __forceinline__ void phase_pool_delta(Frame& F) {
    LAS float* rsd = (LAS float*)F.lds;
    const bf16_t* XS = WSB(WS_XSA); bf16_t* DL = WSB(WS_P);
    for (int u = F.bid; u < MALL / 64; u += F.G) {
        const int r0 = u * 64, s0 = (r0 >= NLAT) ? NLAT : 0, s1 = (r0 >= NLAT) ? MALL : NLAT;
        __syncthreads();
        if (F.tid < 80) { const int r = r0 - 8 + F.tid; float v = 0.f;
            if (r >= s0 && r < s1) { const float* sp = WSF(WS_SLOTS) + (size_t)r * 16; float t = 0.f;
#pragma unroll
                for (int j = 0; j < 16; ++j) t += sp[j];
                v = rsqrtf(t * (1.0f / 1024.0f) + EPS); }
            rsd[F.tid] = v; }
        __syncthreads();
        const int c = F.tid * 2, gi = F.tid >> 7, win = 2 << gi, hb = win >> 1;
        for (int t = r0; t < r0 + 64; ++t) {
            int lo = t - hb, hi = t + win - hb; lo = lo < s0 ? s0 : lo; hi = hi > s1 ? s1 : hi;
            float a0 = 0.f, a1 = 0.f;
            for (int r = lo; r < hi; ++r) { const unsigned w = *(const unsigned*)(XS + (size_t)r * D + c); const float rr = rsd[r - r0 + 8]; a0 += rr * lo_bf(w); a1 += rr * hi_bf(w); }
            const float inv = 1.0f / (float)(hi - lo);
            const unsigned w = *(const unsigned*)(XS + (size_t)t * D + c); const float rr = rsd[t - r0 + 8];
            *(unsigned*)(DL + (size_t)t * D + c) = pk2(a0 * inv - rr * lo_bf(w), a1 * inv - rr * hi_bf(w));
        }
    }
}
__device__ __forceinline__ void phase_final(Frame& F) {
    const int gw = F.bid * NWAVES + F.wave, NGW = F.G * NWAVES;
    for (int row = gw; row < NLAT; row += NGW) {
        float t = (F.lane < 16) ? WSF(WS_SLOTS)[(size_t)row * 16 + F.lane] : 0.f; t = wave_sum(t);
        const float r = rsqrtf(t * (1.0f / 1024.0f) + EPS);
        float* xr = F.out + (size_t)row * D;
#pragma unroll
        for (int j = 0; j < 4; ++j) { const int k = j * 256 + F.lane * 4; f32x4 x = *(const f32x4*)(xr + k); const f32x4 w = *(const f32x4*)(F.in[9] + k); *(f32x4*)(xr + k) = x * r * w; }
    }
}

enum { PH_P0A = 0, PH_P0B, PH_L0_G1, PH_L0_MA, PH_L0_MB, PH_L0_MC, PH_L0_G2, PH_L0_G3, PH_L0_G4,
       PH_L1_G1, PH_L1_MA, PH_L1_MB, PH_L1_MC, PH_L1_MD, PH_L1_G2, PH_L1_G3, PH_L1_G4,
       PH_L2_DELTA, PH_L2_G2, PH_L2_G3, PH_L2_G4,
       PH_L3_G1, PH_L3_ATT, PH_L3_G2, PH_L3_G3, PH_L3_G4, PH_FINAL, NPHASE };
__global__ void __launch_bounds__(NTHR, 2) fwd_kernel(Args args) {
    extern __shared__ __attribute__((aligned(16))) unsigned char lds_raw[];
    Frame F; F.lds = (LAS unsigned char*)lds_raw; F.tid = threadIdx.x; F.lane = F.tid & 63; F.wave = __builtin_amdgcn_readfirstlane(F.tid >> 6);
    F.G = gridDim.x; F.bid = blockIdx.x; F.in = args.in; F.out = args.out; F.ws = args.ws;
    volatile LAS unsigned* MISC = (volatile LAS unsigned*)(F.lds + MISC_OFF);
    for (int u = F.tid; u < 128; u += NTHR) ((LAS unsigned*)(F.lds + MISC_OFF))[u] = 0u;
    __syncthreads();
    const int lo = args.ph_lo, hi = args.ph_hi;
#if MK_ONE_LAUNCH
    XcdBarrier bar = xcd_barrier_post((unsigned*)(F.ws + WS_CTL), MISC + 8);
    bool first_sync = true;
#define SEAM() do { if (first_sync) { cg::this_grid().sync(); first_sync = false; } else xcd_barrier(bar); } while (0)
#else
    (void)MISC;
#define SEAM() do { } while (0)
#endif
#define IN(k) (lo <= (k) && (k) < hi)
#ifndef PHASE_MASK
#define PHASE_MASK 0xFFFFFFFFull
#endif
#define PH(k, ...) do { if constexpr (((PHASE_MASK) >> (k)) & 1ull) { if (IN(k)) { __VA_ARGS__; if (IN((k) + 1)) SEAM(); } } } while (0)
#define PH_EMPTY(k) do { } while (0)
    LAS unsigned char* ring = F.lds;
    const int c_ = F.bid;
#define RUN_G1(k, epi, Wt, nN) PH(k, { Gemm g{WSB(WS_XSA), Wt, D, D, D, 0}; StaticOrder S; S.init(65, nN, F.G, c_); pg8::gemm_phase(ring, g, S, epi); })
#define RUN_G2(k, layer, Aptr, lda_, K_, Wt_, apn_, ldb_, nMr_, blat_, bctx_) PH(k, { \
        EpiResid e{blat_, bctx_, F.out, WSF(WS_XCTX), WSF(WS_GATE) + ((size_t)(layer) * 2 + 0) * 2 * 1024, WSF(WS_CS) + ((size_t)(layer) * 2 + 1) * 2 * 1024, WSB(WS_XSB), WSF(WS_SLOTS)}; \
        Gemm g{Aptr, Wt_, lda_, ldb_, K_, apn_}; StaticOrder S; S.init(nMr_, 4, F.G, c_); pg8::gemm_phase(ring, g, S, e); })
#define RUN_G3(k, layer, nMr_) PH(k, { \
        EpiG1<3> e{WSF(WS_SLOTS), WSF(WS_BIAS3) + (size_t)(layer) * 2 * FH2, FH2, WSB(WS_P), nullptr}; \
        Gemm g{WSB(WS_XSB), WSB(WS_W_FFNIN) + (size_t)(layer) * FH2 * D, D, D, D, 0}; StaticOrder S; S.init(nMr_, FH2 / 256, F.G, c_); pg8::gemm_phase(ring, g, S, e); })
#define RUN_G4(k, layer, nMr_) PH(k, { \
        EpiResid e{F.out, WSF(WS_XCTX), F.out, WSF(WS_XCTX), WSF(WS_GATE) + ((size_t)(layer) * 2 + 1) * 2 * 1024, ((layer) < 3) ? WSF(WS_CS) + ((size_t)((layer) + 1) * 2 + 0) * 2 * 1024 : (const float*)nullptr, WSB(WS_XSA), WSF(WS_SLOTS)}; \
        Gemm g{WSB(WS_P), WSB(WS_W_FFNOUT) + (size_t)(layer) * D * FH, FH, FH, FH, 0}; StaticOrder S; S.init(nMr_, 4, F.G, c_); pg8::gemm_phase(ring, g, S, e); })

    PH(PH_P0A, phase_p0a(F));
    PH(PH_P0B, phase_p0b(F));
    { EpiG1<0> e{WSF(WS_SLOTS), WSF(WS_BIAS1), FH2, WSB(WS_P), nullptr}; RUN_G1(PH_L0_G1, e, WSB(WS_W_HGIN), HG_N / 256); }
#if !NAIVE_HG
    PH(PH_L0_MA, phase_hg_a(F));
    PH(PH_L0_MB, phase_hg_b(F));
    PH(PH_L0_MC, phase_hg_c(F));
#endif
    RUN_G2(PH_L0_G2, 0, WSB(WS_XSA), D, D, WSB(WS_W_HGOUT), 0, D, 65, F.in[0], F.in[2]);
    RUN_G3(PH_L0_G3, 0, 65);
    RUN_G4(PH_L0_G4, 0, 65);
    { EpiG1<1> e{WSF(WS_SLOTS), WSF(WS_BIAS1) + (size_t)1 * 2 * FH2, FH2, WSB(WS_P), WSF(WS_DT)}; RUN_G1(PH_L1_G1, e, WSB(WS_W_SSMIN), SSM_NP / 256); }
#if !NAIVE_SSM
    PH(PH_L1_MA, phase_ssm_a(F));
    PH(PH_L1_MB, phase_ssm_b(F));
    PH(PH_L1_MC, phase_ssm_c(F));
    PH(PH_L1_MD, phase_ssm_d(F));
#endif
    RUN_G2(PH_L1_G2, 1, WSB(WS_P), PLD, SSM_DI, WSB(WS_W_SSMOUT), 0, SSM_DI, 65, F.out, WSF(WS_XCTX));
    RUN_G3(PH_L1_G3, 1, 65);
    RUN_G4(PH_L1_G4, 1, 65);
    PH(PH_L2_DELTA, phase_pool_delta(F));
    RUN_G2(PH_L2_G2, 2, WSB(WS_P), D, 256, WSB(WS_W_POOL), 256, 256, 65, F.out, WSF(WS_XCTX));
    RUN_G3(PH_L2_G3, 2, 65);
    RUN_G4(PH_L2_G4, 2, 65);
    { EpiQKV e{WSF(WS_SLOTS), WSF(WS_BIAS1) + (size_t)3 * 2 * FH2, FH2, WSB(WS_P), WSF(WS_ROPE)}; RUN_G1(PH_L3_G1, e, WSB(WS_W_QKV), ATT_N / 256); }
#if !NAIVE_ATT
    PH(PH_L3_ATT, phase_att(F));
#endif
    RUN_G2(PH_L3_G2, 3, WSB(WS_XSA), D, D, WSB(WS_W_ATTOUT), 0, D, 64, F.out, WSF(WS_XCTX));
    RUN_G3(PH_L3_G3, 3, 64);
    RUN_G4(PH_L3_G4, 3, 64);
    PH(PH_FINAL, phase_final(F));
#undef IN
#undef PH
#undef SEAM
}

extern "C" void kernel_launch(void* const* d_in, const int* in_sizes, int n_in, void* d_out, int out_size, void* d_ws, size_t ws_size, hipStream_t stream) {
    static int grid = 0;
    if (grid == 0) {
        if (n_in != 27 || out_size != NLAT * D || ws_size < WS_END) { fprintf(stderr, "kernel_launch: unexpected shapes (n_in %d out %d ws %zu need %zu)\n", n_in, out_size, ws_size, (size_t)WS_END); grid = -1; return; }
        int dev = 0, cus = 0, per_cu = 0;
        hipGetDevice(&dev); hipDeviceGetAttribute(&cus, hipDeviceAttributeMultiprocessorCount, dev);
        if (hipFuncSetAttribute((const void*)fwd_kernel, hipFuncAttributeMaxDynamicSharedMemorySize, LDS_BYTES) != hipSuccess) { fprintf(stderr, "hipFuncSetAttribute failed\n"); grid = -1; return; }
        hipOccupancyMaxActiveBlocksPerMultiprocessor(&per_cu, (const void*)fwd_kernel, NTHR, LDS_BYTES);
        (void)hipGetLastError();
        if (per_cu < 1) { fprintf(stderr, "occupancy query says %d\n", per_cu); grid = -1; return; }
        grid = cus;
    }
    if (grid < 0) return;
    hipMemsetAsync((char*)d_ws + WS_CTL, 0, CTL_BYTES, stream);
    Args a{};
    for (int i = 0; i < 27; ++i) a.in[i] = (const float*)d_in[i];
    a.out = (float*)d_out; a.ws = (unsigned char*)d_ws;
#if MK_ONE_LAUNCH
    a.ph_lo = 0; a.ph_hi = NPHASE;
    void* kargs[] = {&a};
    hipError_t e = hipLaunchCooperativeKernel((const void*)fwd_kernel, dim3(grid), dim3(NTHR), kargs, LDS_BYTES, stream);
    if (e != hipSuccess) fprintf(stderr, "cooperative launch failed: %s\n", hipGetErrorString(e));
#else
    NArgs na{}; for (int i = 0; i < 27; ++i) na.in[i] = (const float*)d_in[i]; na.ws = (unsigned char*)d_ws;
    for (int p = 0; p < NPHASE; ++p) {
        if (p == PH_L0_MA && NAIVE_HG) { hipLaunchKernelGGL(naive_hg_scan_k, dim3(16), dim3(128), 0, stream, na); continue; }
        if (p == PH_L0_MC && NAIVE_HG) { hipLaunchKernelGGL(naive_hg_readout_k, dim3(1024), dim3(256), 0, stream, na); continue; }
        if (p == PH_L1_MA && NAIVE_SSM) { hipLaunchKernelGGL(naive_ssm_scan_k, dim3(32), dim3(384), 0, stream, na); continue; }
        if (p == PH_L1_MC && NAIVE_SSM) { hipLaunchKernelGGL(naive_ssm_readout_k, dim3(1024), dim3(256), 0, stream, na); continue; }
        if (p == PH_L3_ATT && NAIVE_ATT) { hipLaunchKernelGGL(naive_attention_k, dim3(1024), dim3(256), 0, stream, na); continue; }
        if ((p == PH_L0_MB && NAIVE_HG) || ((p == PH_L1_MB || p == PH_L1_MD) && NAIVE_SSM)) continue;
        a.ph_lo = p; a.ph_hi = p + 1; hipLaunchKernelGGL(fwd_kernel, dim3(grid), dim3(NTHR), LDS_BYTES, stream, a);
    }
#endif
}
```

```cpp
#include <hip/hip_runtime.h>
#include <hip/hip_cooperative_groups.h>
#include <cstdio>
#include <cstdint>
namespace cg = cooperative_groups;

#ifndef MK_ONE_LAUNCH
#define MK_ONE_LAUNCH 1
#endif
#ifndef NAIVE_HG
#define NAIVE_HG 0
#endif
#ifndef NAIVE_SSM
#define NAIVE_SSM 0
#endif
#ifndef NAIVE_ATT
#define NAIVE_ATT 0
#endif

#define LAS __attribute__((address_space(3)))
typedef unsigned short bf16_t;
typedef short bf16x8 __attribute__((ext_vector_type(8)));
typedef float f32x4 __attribute__((ext_vector_type(4)));
typedef float f32x2 __attribute__((ext_vector_type(2)));
typedef unsigned u32x4 __attribute__((ext_vector_type(4)));
typedef unsigned u32x2 __attribute__((ext_vector_type(2)));

constexpr int D = 1024, NLAT = 16384, NCTX = 256, MALL = NLAT + NCTX, DEPTH = 4;
constexpr int FH = 2816, FH2 = 5632;
constexpr int HG_N = 5120;
constexpr int SSM_N = 5184, SSM_NP = 5376;
constexpr int SSM_DI = 2048, SSM_CD = 3072;
constexpr int ATT_N = 1536, QK_LD = 1536;
constexpr int PLD = 5120;
constexpr float EPS = 1e-6f;
constexpr int NWAVES = 8, NTHR = 512;
constexpr int LDS_BYTES = 147456, MISC_OFF = LDS_BYTES - 512;

constexpr size_t al256(size_t x) { return (x + 255) & ~(size_t)255; }
constexpr size_t WS_CTL = 0, CTL_BYTES = 65536;
constexpr size_t WS_MODS = WS_CTL + CTL_BYTES;
constexpr size_t WS_CS = WS_MODS + (size_t)4 * 2 * 6144 * 4;
constexpr size_t WS_GATE = WS_CS + (size_t)4 * 2 * 2 * 1024 * 4;
constexpr size_t WS_BIAS1 = WS_GATE + (size_t)4 * 2 * 2 * 1024 * 4;
constexpr size_t WS_BIAS3 = WS_BIAS1 + (size_t)4 * 2 * FH2 * 4;
constexpr size_t WS_LB = WS_BIAS3 + (size_t)4 * 2 * FH2 * 4;
constexpr size_t WS_ROPE = WS_LB + 2 * 1024 * 4;
constexpr size_t WS_SLOTS = WS_ROPE + 2 * 256 * 16 * 4;
constexpr size_t WS_XCTX = WS_SLOTS + (size_t)MALL * 16 * 4;
constexpr size_t WS_DT = WS_XCTX + (size_t)NCTX * D * 4;
constexpr size_t WS_W_HGIN = al256(WS_DT + (size_t)MALL * 64 * 4);
constexpr size_t WS_W_HGOUT = WS_W_HGIN + (size_t)HG_N * D * 2;
constexpr size_t WS_W_SSMIN = WS_W_HGOUT + (size_t)D * D * 2;
constexpr size_t WS_W_SSMOUT = WS_W_SSMIN + (size_t)SSM_NP * D * 2;
constexpr size_t WS_W_POOL = WS_W_SSMOUT + (size_t)D * SSM_DI * 2;
constexpr size_t WS_W_QKV = WS_W_POOL + (size_t)4 * 256 * 256 * 2;
constexpr size_t WS_W_ATTOUT = WS_W_QKV + (size_t)ATT_N * D * 2;
constexpr size_t WS_W_FFNIN = WS_W_ATTOUT + (size_t)D * D * 2;
constexpr size_t WS_W_FFNOUT = WS_W_FFNIN + (size_t)4 * FH2 * D * 2;
constexpr size_t WS_XSA = WS_W_FFNOUT + (size_t)4 * D * FH * 2;
constexpr size_t WS_P = WS_XSA + (size_t)MALL * D * 2;
constexpr size_t P_BYTES = (size_t)MALL * PLD * 2;
constexpr size_t WS_XSB = WS_P + (size_t)96 * 1024 * 1024;
constexpr size_t WS_ST = WS_P + P_BYTES;
constexpr size_t ST_BYTES = (size_t)2 * 5 * 260 * 128 * 128 * 2;
constexpr size_t WS_HALO = WS_ST + (size_t)72 * 1024 * 1024;
constexpr size_t WS_END = WS_ST + ST_BYTES;
static_assert(WS_HALO + (size_t)260 * 4 * 3072 * 2 <= WS_END && (size_t)2 * 32 * 65 * 8192 * 2 <= (size_t)72 * 1024 * 1024, "halo buffer");
static_assert(WS_END <= (size_t)402653184, "workspace map exceeds 4 x largest input");
static_assert((size_t)MALL * FH * 2 <= (size_t)96 * 1024 * 1024 && WS_XSB + (size_t)MALL * D * 2 <= WS_ST, "H / XS_B overlay inside P");

__device__ __forceinline__ float bf2f(bf16_t b) { return __uint_as_float(((unsigned)b) << 16); }
__device__ __forceinline__ unsigned f2bf(float f) { unsigned u = __float_as_uint(f); return (u + 0x7fffu + ((u >> 16) & 1u)) >> 16; }
__device__ __forceinline__ unsigned pk2(float lo, float hi) { return f2bf(lo) | (f2bf(hi) << 16); }
typedef __bf16 bf16v2_t __attribute__((ext_vector_type(2)));
__device__ __forceinline__ unsigned cvt_pk_bf16(float lo, float hi) { const f32x2 f = {lo, hi}; return __builtin_bit_cast(unsigned, __builtin_convertvector(f, bf16v2_t)); }
__device__ __forceinline__ float sigmoidf_(float x) { return __builtin_amdgcn_rcpf(1.0f + __expf(-x)); }
__device__ __forceinline__ float siluf_(float x) { return x * sigmoidf_(x); }
__device__ __forceinline__ float lo_bf(unsigned w) { return __uint_as_float(w << 16); }
__device__ __forceinline__ float hi_bf(unsigned w) { return __uint_as_float(w & 0xffff0000u); }
__device__ __forceinline__ float wave_sum(float v) {
#pragma unroll
    for (int o = 1; o < 64; o <<= 1) v += __shfl_xor(v, o);
    return v;
}

#define XB_TMO      128
#define XB_XCNT(j)  (256  + 64 * (j))
#define XB_XSUB(j)  (1280 + 64 * (j))
#define XB_XGEN(j)  (2304 + 64 * (j))
#define XB_TOP      3328
#define XB_TOPGEN   3392
#define XCD_BAR_WORDS 3456
#define XB_SPIN_CAP (1u << 22)
__device__ __forceinline__ unsigned xb_ld(unsigned* p)              { return __hip_atomic_load(p, __ATOMIC_RELAXED, __HIP_MEMORY_SCOPE_AGENT); }
__device__ __forceinline__ unsigned xb_add(unsigned* p, unsigned v) { return __hip_atomic_fetch_add(p, v, __ATOMIC_RELAXED, __HIP_MEMORY_SCOPE_AGENT); }
__device__ __forceinline__ unsigned xb_xcc_id() { return (unsigned)__builtin_amdgcn_s_getreg((3 << 11) | 20) & 0xFu; }
#define XB_SPIN(cond, bar) do { unsigned _sp = 0; while (cond) { __builtin_amdgcn_s_sleep(1); \
    if ((++_sp & 255u) == 0u) { if (xb_ld(&(bar)[XB_TMO])) break; if (_sp > XB_SPIN_CAP) { atomicAdd(&(bar)[XB_TMO], 1u); break; } } } } while (0)
struct XcdBarrier { unsigned* bar; unsigned x; volatile LAS unsigned* st; };
__device__ __forceinline__ XcdBarrier xcd_barrier_post(unsigned* bar, volatile LAS unsigned* st) {
    XcdBarrier b; b.bar = bar; b.x = xb_xcc_id(); b.st = st;
    if (threadIdx.x == 0) (void)xb_add(&bar[XB_XCNT(b.x)], 1u);
    return b;
}
__device__ __forceinline__ void xcd_barrier_complete(unsigned* bar, unsigned x, unsigned& nloc, unsigned& nx) {
    const unsigned G = gridDim.x * gridDim.y * gridDim.z;
    unsigned sum, cnt, mine, sp = 0u;
    for (;;) {
        sum = 0u; cnt = 0u; mine = 0u;
#pragma unroll
        for (unsigned j = 0; j < 16; ++j) { const unsigned c = xb_ld(&bar[XB_XCNT(j)]); sum += c; cnt += (c > 0u) ? 1u : 0u; mine = (j == x) ? c : mine; }
        if (sum == G) break;
        __builtin_amdgcn_s_sleep(1);
        if ((++sp & 255u) == 0u) { if (xb_ld(&bar[XB_TMO])) break; if (sp > XB_SPIN_CAP) { atomicAdd(&bar[XB_TMO], 1u); break; } }
    }
    nloc = mine > 0u ? mine : 1u; nx = cnt > 0u ? cnt : 1u;
}
__device__ __forceinline__ void xcd_barrier(const XcdBarrier& b) {
    asm volatile("s_waitcnt vmcnt(0)" ::: "memory");
    __syncthreads();
    if (threadIdx.x == 0) {
        unsigned* bar = b.bar;
        __builtin_amdgcn_s_waitcnt(0);
        unsigned nloc = b.st[0], nx = b.st[1];
        if (nloc == 0u) { xcd_barrier_complete(bar, b.x, nloc, nx); b.st[0] = nloc; b.st[1] = nx; }
        const unsigned old = xb_add(&bar[XB_XSUB(b.x)], 1u);
        const unsigned gen = old / nloc;
        if (old + 1u == (gen + 1u) * nloc) {
            __builtin_amdgcn_fence(__ATOMIC_RELEASE, "agent");
            asm volatile("s_waitcnt vmcnt(0)" ::: "memory");
            const unsigned og = xb_add(&bar[XB_TOP], 1u);
            const unsigned tg = og / nx;
            if (og + 1u == (tg + 1u) * nx) xb_add(&bar[XB_TOPGEN], 1u);
            else XB_SPIN(xb_ld(&bar[XB_TOPGEN]) == tg, bar);
            __builtin_amdgcn_fence(__ATOMIC_ACQUIRE, "agent");
            xb_add(&bar[XB_XGEN(b.x)], 1u);
            asm volatile("s_waitcnt vmcnt(0)" ::: "memory");
        } else {
            XB_SPIN(xb_ld(&bar[XB_XGEN(b.x)]) == gen, bar);
            __builtin_amdgcn_fence(__ATOMIC_ACQUIRE, "agent");
            asm volatile("s_waitcnt vmcnt(0)" ::: "memory");
        }
    }
    __syncthreads();
}

namespace pg8 {
constexpr int BM = 256, BK = 64, HALF = 128, HTB = HALF * BK * 2, STAGE_BYTES = 8 * HTB, NXCD = 8, WGM = 8;
__host__ __device__ __forceinline__ int lds_byte(int r, int c) { const int st = (r >> 4) * 2 + (c >> 5), rr = r & 15, cc = c & 31, ob = rr * 64 + cc * 2; return st * 1024 + (ob ^ (((ob >> 9) & 1) << 5)); }
__host__ __device__ __forceinline__ void stage_rc(int b, int& R, int& C) { const int st = b / 1024, sb = b % 1024, swz = sb ^ (((sb >> 9) & 1) << 5); R = (st >> 1) * 16 + swz / 64; C = (st & 1) * 32 + (swz % 64) / 2; }
__host__ __device__ __forceinline__ int perm32(int rho) { const int n = rho >> 4, i = rho & 15; return 8 * (i >> 2) + 4 * n + (i & 3); }
struct Unit { int pm, pn; };
struct Gemm { const bf16_t* A; const bf16_t* Bt; int lda, ldb, K, a_pn_step; };
struct StaticOrder {
    int nM, nN, nwg, G, c;
    __device__ void init(int nM_, int nN_, int G_, int c_) { nM = nM_; nN = nN_; nwg = nM * nN; G = G_; c = c_; }
    __device__ bool next(int i, Unit& u) const {
        const long L = (long)i * G + c; if (L >= nwg) return false;
        int wgid = (int)L; { const int q = nwg / NXCD, r = nwg % NXCD, xcd = wgid % NXCD, off = wgid / NXCD; wgid = (xcd < r ? xcd * (q + 1) : r * (q + 1) + (xcd - r) * q) + off; }
        const int nig = WGM * nN, gid = wgid / nig, fm = gid * WGM, gsz = (nM - fm) < WGM ? (nM - fm) : WGM;
        u.pm = fm + ((wgid % nig) % gsz); u.pn = (wgid % nig) / gsz; return true;
    }
};

template <class Epi, bool ALIGN_EPI = true, bool SP2 = true>
__device__ __forceinline__ void gemm_phase(LAS unsigned char* lds, const Gemm g, const StaticOrder& S, const Epi& E) {
    const int tid = threadIdx.x, wid = __builtin_amdgcn_readfirstlane(tid >> 6), lane = tid & 63, wr = wid >> 2, wc = wid & 3, fr = lane & 15, fq = lane >> 4;
    const int nt = g.K / BK;
    unsigned voffA[2], voffB[2];
#pragma unroll
    for (int i = 0; i < 2; ++i) { int R, C; stage_rc(tid * 16 + i * 8192, R, C); const int Rb = Epi::PERM ? ((R & ~31) + perm32(R & 31)) : R;
        voffA[i] = (unsigned)(R * g.lda + C) * 2u; voffB[i] = (unsigned)(Rb * g.ldb + C) * 2u; }
    const size_t kstep = (size_t)(BK * 2);
    const size_t hstepA = (size_t)HALF * g.lda * 2, hstepB = (size_t)HALF * g.ldb * 2;
    const unsigned ldsw = (unsigned)wid * 1024u;
    const int aoff = lds_byte(wr * 64 + fr, fq * 8), boff = lds_byte(wc * 32 + fr, fq * 8);
#define PG8_SA(b, h) (((b) * 2 + (h)) * HTB)
#define PG8_SB(b, h) ((4 + (b) * 2 + (h)) * HTB)
#define PG8_STAGE(bufoff, gbase, voff) do { _Pragma("unroll") for (int _i = 0; _i < 2; ++_i) \
        __builtin_amdgcn_global_load_lds((const unsigned*)((const char*)(gbase) + (voff)[_i]), (LAS unsigned*)(lds + (bufoff) + ldsw + _i * 8192), 16, 0, 0); } while (0)
#define PG8_LDA(dst, b, h) do { _Pragma("unroll") for (int m = 0; m < 4; ++m) _Pragma("unroll") for (int k = 0; k < 2; ++k) dst[m][k] = *(const LAS bf16x8*)(lds + PG8_SA(b, h) + aoff + m * 2048 + k * 1024); } while (0)
#define PG8_LDB(dst, b, h) do { _Pragma("unroll") for (int n = 0; n < 2; ++n) _Pragma("unroll") for (int k = 0; k < 2; ++k) dst[n][k] = *(const LAS bf16x8*)(lds + PG8_SB(b, h) + boff + n * 2048 + k * 1024); } while (0)
#define PG8_MMA(ai, bj, At, Bt) do { __builtin_amdgcn_s_setprio(1); _Pragma("unroll") for (int m = 0; m < 4; ++m) _Pragma("unroll") for (int n = 0; n < 2; ++n) _Pragma("unroll") for (int k = 0; k < 2; ++k) \
        acc[ai][bj][m][n] = __builtin_amdgcn_mfma_f32_16x16x32_bf16(Bt[n][k], At[m][k], acc[ai][bj][m][n], 0, 0, 0); __builtin_amdgcn_s_setprio(0); } while (0)
#define PG8_WAIT_V(n) asm volatile("s_waitcnt vmcnt(" #n ")" ::: "memory")
#define PG8_WAIT_L(n) asm volatile("s_waitcnt lgkmcnt(" #n ")" ::: "memory")
#define PG8_BAR __builtin_amdgcn_s_barrier()
#define PG8_SCHED __builtin_amdgcn_sched_barrier(0)
    Unit cur, nxt; int ui = 0;
    if (!S.next(0, cur)) return;
    f32x4 acc[2][2][4][2];
#pragma unroll
    for (int a = 0; a < 2; ++a)
#pragma unroll
        for (int b = 0; b < 2; ++b)
#pragma unroll
            for (int m = 0; m < 4; ++m)
#pragma unroll
                for (int n = 0; n < 2; ++n) acc[a][b][m][n] = (f32x4){0.f, 0.f, 0.f, 0.f};
    bf16x8 At[4][2], B0[2][2], B1[2][2];
    const char* cA = (const char*)g.A + ((size_t)cur.pm * BM * g.lda + (size_t)cur.pn * g.a_pn_step) * 2; const char* cB = (const char*)g.Bt + (size_t)cur.pn * BM * g.ldb * 2;
    if constexpr (SP2) {
        PG8_STAGE(PG8_SB(0, 0), cB, voffB); PG8_STAGE(PG8_SB(0, 1), cB + hstepB, voffB); PG8_STAGE(PG8_SA(0, 0), cA, voffA); PG8_STAGE(PG8_SA(0, 1), cA + hstepA, voffA);
        if (wr == 1) PG8_BAR;
        PG8_WAIT_V(2); PG8_BAR;
        PG8_STAGE(PG8_SB(1, 0), cB + kstep, voffB); PG8_STAGE(PG8_SA(1, 0), cA + kstep, voffA); PG8_STAGE(PG8_SB(1, 1), cB + hstepB + kstep, voffB);
        PG8_WAIT_V(6); PG8_BAR;
    } else {
        PG8_STAGE(PG8_SB(0, 0), cB, voffB); PG8_STAGE(PG8_SA(0, 0), cA, voffA); PG8_STAGE(PG8_SB(0, 1), cB + hstepB, voffB); PG8_STAGE(PG8_SA(0, 1), cA + hstepA, voffA);
        if (wr == 1) PG8_BAR;
        PG8_WAIT_V(4); PG8_BAR;
        PG8_STAGE(PG8_SB(1, 0), cB + kstep, voffB); PG8_STAGE(PG8_SA(1, 0), cA + kstep, voffA); PG8_STAGE(PG8_SB(1, 1), cB + hstepB + kstep, voffB);
        PG8_WAIT_V(6); PG8_BAR;
    }
    for (;;) {
        const bool has_next = S.next(ui + 1, nxt);
        const char* nA = has_next ? (const char*)g.A + ((size_t)nxt.pm * BM * g.lda + (size_t)nxt.pn * g.a_pn_step) * 2 : cA; const char* nB = has_next ? (const char*)g.Bt + (size_t)nxt.pn * BM * g.ldb * 2 : cB;
        for (int t = 0; t < nt; t += 2) {
            const bool last = (t == nt - 2);
            const char* a1 = cA + (size_t)(t + 1) * kstep;
            const char* a2 = last ? nA : cA + (size_t)(t + 2) * kstep; const char* b2 = last ? nB : cB + (size_t)(t + 2) * kstep;
            const char* a3 = a2 + kstep; const char* b3 = b2 + kstep;
            if constexpr (SP2) {
            PG8_LDB(B0, 0, 0); PG8_LDB(B1, 0, 1); PG8_SCHED; PG8_LDA(At, 0, 0); PG8_STAGE(PG8_SA(1, 1), a1 + hstepA, voffA);
            PG8_WAIT_V(8); PG8_WAIT_L(0); PG8_BAR; PG8_MMA(0, 0, At, B0); PG8_MMA(0, 1, At, B1); PG8_BAR; PG8_SCHED;
            PG8_LDA(At, 0, 1); PG8_STAGE(PG8_SB(0, 0), b2, voffB); PG8_STAGE(PG8_SB(0, 1), b2 + hstepB, voffB); PG8_STAGE(PG8_SA(0, 0), a2, voffA);
            PG8_WAIT_V(8); PG8_WAIT_L(0); PG8_BAR; PG8_MMA(1, 0, At, B0); PG8_MMA(1, 1, At, B1); PG8_BAR; PG8_SCHED;
            PG8_LDB(B0, 1, 0); PG8_LDB(B1, 1, 1); PG8_SCHED; PG8_LDA(At, 1, 0); PG8_STAGE(PG8_SA(0, 1), a2 + hstepA, voffA);
            PG8_WAIT_V(8); PG8_WAIT_L(0); PG8_BAR; PG8_MMA(0, 0, At, B0); PG8_MMA(0, 1, At, B1); PG8_BAR; PG8_SCHED;
            PG8_LDA(At, 1, 1); PG8_STAGE(PG8_SB(1, 0), b3, voffB); PG8_STAGE(PG8_SB(1, 1), b3 + hstepB, voffB); PG8_STAGE(PG8_SA(1, 0), a3, voffA);
            PG8_WAIT_V(8); PG8_WAIT_L(0); PG8_BAR; PG8_MMA(1, 0, At, B0); PG8_MMA(1, 1, At, B1); PG8_BAR; PG8_SCHED;
            } else {
            PG8_LDB(B0, 0, 0); PG8_SCHED; PG8_LDA(At, 0, 0); PG8_STAGE(PG8_SA(1, 1), a1 + hstepA, voffA);
            PG8_WAIT_L(8); PG8_BAR; PG8_WAIT_L(0); PG8_MMA(0, 0, At, B0); PG8_BAR; PG8_SCHED;
            PG8_LDB(B1, 0, 1); PG8_STAGE(PG8_SB(0, 0), b2, voffB);
            PG8_BAR; PG8_WAIT_L(0); PG8_MMA(0, 1, At, B1); PG8_BAR;
            PG8_LDA(At, 0, 1); PG8_STAGE(PG8_SA(0, 0), a2, voffA);
            PG8_BAR; PG8_WAIT_L(0); PG8_MMA(1, 0, At, B0); PG8_BAR; PG8_SCHED;
            PG8_STAGE(PG8_SB(0, 1), b2 + hstepB, voffB);
            PG8_WAIT_V(6); PG8_BAR; PG8_MMA(1, 1, At, B1); PG8_BAR;
            PG8_LDB(B0, 1, 0); PG8_SCHED; PG8_LDA(At, 1, 0); PG8_STAGE(PG8_SA(0, 1), a2 + hstepA, voffA);
            PG8_WAIT_L(8); PG8_BAR; PG8_WAIT_L(0); PG8_MMA(0, 0, At, B0); PG8_BAR; PG8_SCHED;
            PG8_LDB(B1, 1, 1); PG8_STAGE(PG8_SB(1, 0), b3, voffB);
            PG8_BAR; PG8_WAIT_L(0); PG8_MMA(0, 1, At, B1); PG8_BAR;
            PG8_LDA(At, 1, 1); PG8_STAGE(PG8_SA(1, 0), a3, voffA);
            PG8_BAR; PG8_WAIT_L(0); PG8_MMA(1, 0, At, B0); PG8_BAR; PG8_SCHED;
            PG8_STAGE(PG8_SB(1, 1), b3 + hstepB, voffB);
            PG8_WAIT_V(6); PG8_BAR; PG8_MMA(1, 1, At, B1); PG8_BAR;
            }
        }
        if constexpr (ALIGN_EPI) { if (wr == 0) PG8_BAR; }
        E(acc, cur, wr, wc, fr, fq);
        if (!has_next) break;
#pragma unroll
        for (int a = 0; a < 2; ++a)
#pragma unroll
            for (int b = 0; b < 2; ++b)
#pragma unroll
                for (int m = 0; m < 4; ++m)
#pragma unroll
                    for (int n = 0; n < 2; ++n) acc[a][b][m][n] = (f32x4){0.f, 0.f, 0.f, 0.f};
        cur = nxt; cA = nA; cB = nB; ++ui;
        if constexpr (ALIGN_EPI) { if (wr == 1) PG8_BAR; }
    }
    PG8_WAIT_V(0);
    if constexpr (!ALIGN_EPI) { if (wr == 0) PG8_BAR; }
    PG8_BAR;
#undef PG8_SA
#undef PG8_SB
#undef PG8_STAGE
#undef PG8_LDA
#undef PG8_LDB
#undef PG8_MMA
#undef PG8_WAIT_V
#undef PG8_WAIT_L
#undef PG8_BAR
#undef PG8_SCHED
}
}
using pg8::Unit; using pg8::Gemm; using pg8::StaticOrder; using pg8::HALF; using pg8::BM;

__device__ __forceinline__ void load_rstd(const float* slots, int row0, int fq, float (&rs)[2][4]) {
#pragma unroll
    for (int ai = 0; ai < 2; ++ai)
#pragma unroll
        for (int m = 0; m < 4; ++m) {
            const f32x4 s = *(const f32x4*)(slots + (size_t)(row0 + ai * HALF + m * 16) * 16 + 4 * fq);
            float t = (s.x + s.y) + (s.z + s.w); t += __shfl_xor(t, 16); t += __shfl_xor(t, 32);
            rs[ai][m] = rsqrtf(t * (1.0f / 1024.0f) + EPS);
        }
}
template <int MODE> struct EpiG1 {
    static constexpr bool PERM = true;
    const float* slots; const float* bias; int bias_ld;
    bf16_t* O; float* DT; bf16_t* HALO;
    __device__ __forceinline__ void operator()(const f32x4 (&acc)[2][2][4][2], const Unit& u, int wr, int wc, int fr, int fq) const {
        const int row0 = u.pm * BM + wr * 64 + fr; const int var = (u.pm >= 64) ? 1 : 0;
        float rs[2][4]; load_rstd(slots, row0, fq, rs);
        const int cl = wc * 32 + 8 * fq;
        const float* bp = bias + (size_t)var * bias_ld + u.pn * BM + cl;
        f32x4 bv[2][2];
#pragma unroll
        for (int bj = 0; bj < 2; ++bj)
#pragma unroll
            for (int n = 0; n < 2; ++n) bv[bj][n] = *(const f32x4*)(bp + bj * HALF + 4 * n);
#pragma unroll
        for (int ai = 0; ai < 2; ++ai)
#pragma unroll
            for (int m = 0; m < 4; ++m) {
                const int row = row0 + ai * HALF + m * 16; const float r = rs[ai][m];
                if constexpr (MODE == 3) {
                    f32x4 g0 = acc[ai][0][m][0] * r + bv[0][0], g1 = acc[ai][0][m][1] * r + bv[0][1];
                    f32x4 u0 = acc[ai][1][m][0] * r + bv[1][0], u1 = acc[ai][1][m][1] * r + bv[1][1];
                    u32x4 w;
                    w.x = cvt_pk_bf16(siluf_(g0[0]) * u0[0], siluf_(g0[1]) * u0[1]); w.y = cvt_pk_bf16(siluf_(g0[2]) * u0[2], siluf_(g0[3]) * u0[3]);
                    w.z = cvt_pk_bf16(siluf_(g1[0]) * u1[0], siluf_(g1[1]) * u1[1]); w.w = cvt_pk_bf16(siluf_(g1[2]) * u1[2], siluf_(g1[3]) * u1[3]);
                    *(u32x4*)(O + (size_t)row * FH + u.pn * HALF + cl) = w;
                } else {
#pragma unroll
                    for (int bj = 0; bj < 2; ++bj) {
                        f32x4 v0 = acc[ai][bj][m][0] * r + bv[bj][0], v1 = acc[ai][bj][m][1] * r + bv[bj][1];
                        const int col = u.pn * BM + bj * HALF + cl;
                        if constexpr (MODE == 0) {
                            if (u.pn < 4 || u.pn >= 16) {
#pragma unroll
                                for (int j = 0; j < 4; ++j) { v0[j] = siluf_(v0[j]); v1[j] = siluf_(v1[j]); } }
                            u32x4 w; w.x = cvt_pk_bf16(v0[0], v0[1]); w.y = cvt_pk_bf16(v0[2], v0[3]); w.z = cvt_pk_bf16(v1[0], v1[1]); w.w = cvt_pk_bf16(v1[2], v1[3]);
                            *(u32x4*)(O + (size_t)row * PLD + col) = w;
                        } else if constexpr (MODE == 1) {
                            if (u.pn < 20) {
                                u32x4 w; w.x = cvt_pk_bf16(v0[0], v0[1]); w.y = cvt_pk_bf16(v0[2], v0[3]); w.z = cvt_pk_bf16(v1[0], v1[1]); w.w = cvt_pk_bf16(v1[2], v1[3]);
                                *(u32x4*)(O + (size_t)row * PLD + col) = w;
                                if (u.pn >= 8) {
                                    const int rm = row & 63, tk = row >> 6;
                                    if (rm >= 62 && tk + 1 < 260) *(u32x4*)(HALO + ((size_t)(tk + 1) * 4 + (rm - 62)) * SSM_CD + (col - 2048)) = w;
                                    if (rm < 2 && tk >= 1) *(u32x4*)(HALO + ((size_t)(tk - 1) * 4 + 2 + rm) * SSM_CD + (col - 2048)) = w;
                                }
                            } else if (bj == 0 && wc < 2) {
                                float* dp = DT + (size_t)row * 64 + cl; *(f32x4*)dp = v0; *(f32x4*)(dp + 4) = v1;
                            }
                        }
                    }
                }
            }
    }
};
struct EpiQKV {
    static constexpr bool PERM = true;
    const float* slots; const float* bias; int bias_ld; bf16_t* O; const float* rope;
    __device__ __forceinline__ void operator()(const f32x4 (&acc)[2][2][4][2], const Unit& u, int wr, int wc, int fr, int fq) const {
        const int row0 = u.pm * BM + wr * 64 + fr; const int var = (u.pm >= 64) ? 1 : 0;
        float rs[2][4]; load_rstd(slots, row0, fq, rs);
        const int cl = wc * 32 + 8 * fq;
        const float* bp = bias + (size_t)var * bias_ld + u.pn * BM + cl;
        f32x4 bv[2][2];
#pragma unroll
        for (int bj = 0; bj < 2; ++bj)
#pragma unroll
            for (int n = 0; n < 2; ++n) bv[bj][n] = *(const f32x4*)(bp + bj * HALF + 4 * n);
        const float qs = (u.pn < 4) ? 0.125f : 1.0f; const float sg = (fq < 2) ? -1.f : 1.f; const bool do_rope = (var == 0) && (u.pn < 5);
        bf16_t* op = O + (size_t)row0 * QK_LD + u.pn * BM + cl;
#pragma unroll
        for (int ai = 0; ai < 2; ++ai)
#pragma unroll
            for (int m = 0; m < 4; ++m) { const int row = row0 + ai * HALF + m * 16; const float r = rs[ai][m];
                f32x4 c0 = {1.f, 1.f, 1.f, 1.f}, c1 = c0, s0 = {0.f, 0.f, 0.f, 0.f}, s1 = s0;
                if (do_rope) { const int pos = (wc & 1) ? (row & 63) : (row >> 6); const float* cp = rope + pos * 16 + 8 * (fq & 1);
                    c0 = *(const f32x4*)cp; c1 = *(const f32x4*)(cp + 4); s0 = *(const f32x4*)(cp + 4096) * sg; s1 = *(const f32x4*)(cp + 4100) * sg; }
#pragma unroll
                for (int bj = 0; bj < 2; ++bj) { f32x4 v0 = acc[ai][bj][m][0] * r + bv[bj][0], v1 = acc[ai][bj][m][1] * r + bv[bj][1];
                    f32x4 p0, p1;
#pragma unroll
                    for (int j = 0; j < 4; ++j) { p0[j] = __shfl_xor(v0[j], 32); p1[j] = __shfl_xor(v1[j], 32); }
                    v0 = (v0 * c0 + p0 * s0) * qs; v1 = (v1 * c1 + p1 * s1) * qs;
                    u32x4 w; w.x = cvt_pk_bf16(v0[0], v0[1]); w.y = cvt_pk_bf16(v0[2], v0[3]); w.z = cvt_pk_bf16(v1[0], v1[1]); w.w = cvt_pk_bf16(v1[2], v1[3]);
                    *(u32x4*)(op + (size_t)(ai * HALF + m * 16) * QK_LD + bj * HALF) = w; }
                asm volatile("" ::: "memory"); }
    }
};
struct EpiResid {
    static constexpr bool PERM = false;
    const float* base_lat; const float* base_ctx; float* out_lat; float* out_ctx;
    const float* gate; const float* csn; bf16_t* xs; float* slots;
    __device__ __forceinline__ void operator()(const f32x4 (&acc)[2][2][4][2], const Unit& u, int wr, int wc, int fr, int fq) const {
        const int var = (u.pm >= 64) ? 1 : 0;
        const int row0 = u.pm * BM + wr * 64 + fr, col0 = u.pn * BM + wc * 32 + 4 * fq;
        const float* base = var ? base_ctx - (size_t)NLAT * D : base_lat; float* out = var ? out_ctx - (size_t)NLAT * D : out_lat;
        f32x4 gv[2][2], cv[2][2];
#pragma unroll
        for (int bj = 0; bj < 2; ++bj)
#pragma unroll
            for (int n = 0; n < 2; ++n) { gv[bj][n] = *(const f32x4*)(gate + var * D + col0 + bj * HALF + n * 16);
                cv[bj][n] = csn ? *(const f32x4*)(csn + var * D + col0 + bj * HALF + n * 16) : (f32x4){0.f, 0.f, 0.f, 0.f}; }
#pragma unroll
        for (int ai = 0; ai < 2; ++ai)
#pragma unroll
            for (int m = 0; m < 4; ++m) {
                const int row = row0 + ai * HALF + m * 16; const size_t off = (size_t)row * D + col0; float ss = 0.f;
#pragma unroll
                for (int bj = 0; bj < 2; ++bj)
#pragma unroll
                    for (int n = 0; n < 2; ++n) {
                        const f32x4 b = *(const f32x4*)(base + off + bj * HALF + n * 16);
                        const f32x4 x = b + gv[bj][n] * acc[ai][bj][m][n];
                        *(f32x4*)(out + off + bj * HALF + n * 16) = x;
                        ss += (x[0] * x[0] + x[1] * x[1]) + (x[2] * x[2] + x[3] * x[3]);
                        if (csn) { const f32x4 y = x * cv[bj][n]; u32x2 w; w.x = cvt_pk_bf16(y[0], y[1]); w.y = cvt_pk_bf16(y[2], y[3]); *(u32x2*)(xs + off + bj * HALF + n * 16) = w; }
                    }
                ss += __shfl_xor(ss, 16); ss += __shfl_xor(ss, 32);
                if (fq == 0) slots[(size_t)row * 16 + u.pn * 4 + wc] = ss;
            }
    }
};

struct Args { const float* in[27]; float* out; unsigned char* ws; int ph_lo, ph_hi; };
struct Frame {
    LAS unsigned char* lds; int tid, lane, wave, G, bid;
    const float* const* in; float* out; unsigned char* ws;
};
#define WSF(off) ((float*)(F.ws + (off)))
#define WSB(off) ((bf16_t*)(F.ws + (off)))

__device__ __forceinline__ void transpose_item(const float* W, int K, int Nsrc, bf16_t* WT, int dst_row0, int src_col0, int kb, LAS float* scr, int lane) {
    const int k0 = 64 * kb;
    if (src_col0 >= 0) {
#pragma unroll 8
        for (int i = 0; i < 32; ++i) { const int kk = 2 * i + (lane >> 5); scr[kk * 33 + (lane & 31)] = W[(size_t)(k0 + kk) * Nsrc + src_col0 + (lane & 31)]; }
    } else {
#pragma unroll 8
        for (int i = 0; i < 32; ++i) { const int kk = 2 * i + (lane >> 5); scr[kk * 33 + (lane & 31)] = 0.f; }
    }
    asm volatile("s_waitcnt lgkmcnt(0)" ::: "memory");
    const int c = lane & 7;
#pragma unroll
    for (int j = 0; j < 4; ++j) { const int n = (lane >> 3) + 8 * j; const LAS float* s = scr + (8 * c) * 33 + n;
        u32x4 o; o.x = pk2(s[0 * 33], s[1 * 33]); o.y = pk2(s[2 * 33], s[3 * 33]); o.z = pk2(s[4 * 33], s[5 * 33]); o.w = pk2(s[6 * 33], s[7 * 33]);
        *(u32x4*)(WT + (size_t)(dst_row0 + n) * K + k0 + 8 * c) = o; }
    asm volatile("s_waitcnt lgkmcnt(0)" ::: "memory");
}
struct ConvJob { int in_idx; size_t src_off; int K, Nsrc, Ndst, mode; size_t dst; };
__device__ __forceinline__ void phase_p0a(Frame& F) {
    {
        LAS float* sv = (LAS float*)F.lds;
        LAS float* red = sv + 2048;
        for (int i = F.tid; i < 2048; i += NTHR) { const float x = (i < 1024) ? F.in[1][i] : F.in[3][i - 1024]; sv[i] = siluf_(x); }
        __syncthreads();
        for (int task = F.bid; task < 256; task += F.G) {
            const int layer = task >> 6, cg_ = task & 63, krow = F.tid >> 5, c4 = F.tid & 31;
            f32x4 aL = {0.f, 0.f, 0.f, 0.f}, aC = {0.f, 0.f, 0.f, 0.f};
            if (c4 < 24) {
                const float* wp = F.in[4] + (size_t)layer * 1024 * 6144 + cg_ * 96 + c4 * 4;
#pragma unroll 8
                for (int j = 0; j < 64; ++j) { const int k = krow + 16 * j; const f32x4 w = *(const f32x4*)(wp + (size_t)k * 6144); aL += w * sv[k]; aC += w * sv[1024 + k]; }
                LAS float* r = red + (krow * 24 + c4) * 8;
                r[0] = aL[0]; r[1] = aL[1]; r[2] = aL[2]; r[3] = aL[3]; r[4] = aC[0]; r[5] = aC[1]; r[6] = aC[2]; r[7] = aC[3];
            }
            __syncthreads();
            if (F.tid < 192) { const int var = F.tid / 96, cc = F.tid % 96; float s = 0.f;
#pragma unroll
                for (int kr = 0; kr < 16; ++kr) s += red[(kr * 24 + (cc >> 2)) * 8 + var * 4 + (cc & 3)];
                const int n = cg_ * 96 + cc; WSF(WS_MODS)[((size_t)layer * 2 + var) * 6144 + n] = s + F.in[5][layer * 6144 + n]; }
            __syncthreads();
        }
    }
    {
        const int gt = F.bid * NTHR + F.tid, GT = F.G * NTHR;
        for (int i = gt; i < 2048; i += GT) {
            const int dir = i >> 10, d = i & 1023; float v[5], mx = -1e30f;
#pragma unroll
            for (int j = 0; j < 5; ++j) { v[j] = F.in[11][(dir * 5 + j) * 1024 + d]; mx = fmaxf(mx, v[j]); }
            float s = 0.f;
#pragma unroll
            for (int j = 0; j < 5; ++j) { v[j] = __expf(v[j] - mx); s += v[j]; }
            WSF(WS_LB)[i] = v[0] / s;
        }
        for (int i = gt; i < 4096; i += GT) {
            const int pos = i >> 4, f = i & 15;
            const float inv = powf(10000.0f, -(float)(2 * f) / 32.0f); const float ang = (float)pos * inv;
            const double rev = (double)ang * 0.15915494309189533577; const float fr_ = (float)(rev - floor(rev));
            WSF(WS_ROPE)[i] = __builtin_amdgcn_cosf(fr_); WSF(WS_ROPE)[4096 + i] = __builtin_amdgcn_sinf(fr_);
        }
    }
    {
        LAS float* scr = (LAS float*)(F.lds + F.wave * 8704);
        const int gw = F.bid * NWAVES + F.wave, NGW = F.G * NWAVES;
        constexpr int NJ = 19;
        const ConvJob jobs[NJ] = {
            {10, 0, 1024, HG_N, HG_N, 0, WS_W_HGIN}, {13, 0, 1024, 1024, 1024, 0, WS_W_HGOUT},
            {14, 0, 1024, SSM_N, SSM_NP, 0, WS_W_SSMIN}, {21, 0, 2048, 1024, 1024, 0, WS_W_SSMOUT},
            {22, 0, 256, 256, 256, 0, WS_W_POOL}, {22, 65536, 256, 256, 256, 0, WS_W_POOL + 131072}, {22, 131072, 256, 256, 256, 0, WS_W_POOL + 262144}, {22, 196608, 256, 256, 256, 0, WS_W_POOL + 393216},
            {24, 0, 1024, ATT_N, ATT_N, 0, WS_W_QKV}, {26, 0, 1024, 1024, 1024, 0, WS_W_ATTOUT},
            {7, 0, 1024, FH2, FH2, 1, WS_W_FFNIN}, {7, (size_t)1024 * FH2, 1024, FH2, FH2, 1, WS_W_FFNIN + (size_t)FH2 * 1024 * 2},
            {7, (size_t)2 * 1024 * FH2, 1024, FH2, FH2, 1, WS_W_FFNIN + (size_t)2 * FH2 * 1024 * 2}, {7, (size_t)3 * 1024 * FH2, 1024, FH2, FH2, 1, WS_W_FFNIN + (size_t)3 * FH2 * 1024 * 2},
            {8, 0, FH, 1024, 1024, 0, WS_W_FFNOUT}, {8, (size_t)FH * 1024, FH, 1024, 1024, 0, WS_W_FFNOUT + (size_t)1024 * FH * 2},
            {8, (size_t)2 * FH * 1024, FH, 1024, 1024, 0, WS_W_FFNOUT + (size_t)2 * 1024 * FH * 2}, {8, (size_t)3 * FH * 1024, FH, 1024, 1024, 0, WS_W_FFNOUT + (size_t)3 * 1024 * FH * 2},
            {0, 0, 0, 0, 0, 0, 0}};
        int total = 0;
#pragma unroll
        for (int j = 0; j < NJ - 1; ++j) total += (jobs[j].Ndst / 32) * (jobs[j].K / 64);
        for (int it = gw; it < total; it += NGW) {
            int r = it, j = 0;
#pragma unroll
            for (int jj = 0; jj < NJ - 1; ++jj) { const int n = (jobs[jj].Ndst / 32) * (jobs[jj].K / 64); if (j == jj && r >= n) { r -= n; j = jj + 1; } }
            int in_idx = 0, K = 0, Nsrc = 0, Ndst = 0, mode = 0; size_t so = 0, dst = 0;
#pragma unroll
            for (int jj = 0; jj < NJ - 1; ++jj) if (j == jj) { in_idx = jobs[jj].in_idx; so = jobs[jj].src_off; K = jobs[jj].K; Nsrc = jobs[jj].Nsrc; Ndst = jobs[jj].Ndst; mode = jobs[jj].mode; dst = jobs[jj].dst; }
            const int nblk = Ndst / 32, kb = r / nblk, nb = r % nblk; const int drow = nb * 32;
            int scol;
            if (mode == 1) { const int pn = drow >> 8, w = drow & 255; scol = (w < 128) ? (pn * 128 + w) : (FH + pn * 128 + (w - 128)); }
            else scol = (drow < Nsrc) ? drow : -1;
            transpose_item(F.in[in_idx] + so, K, Nsrc, WSB(dst), drow, scol, kb, scr, F.lane);
        }
    }
}

__device__ __forceinline__ void phase_p0b(Frame& F) {
    const int gt = F.bid * NTHR + F.tid, GT = F.G * NTHR;
    const float* mods = WSF(WS_MODS);
    for (int i = gt; i < 4 * 2 * 2 * 1024; i += GT) {
        const int k = i & 1023, var = (i >> 10) & 1, nrm = (i >> 11) & 1, layer = i >> 12;
        const float sc = mods[((size_t)layer * 2 + var) * 6144 + (nrm ? 4 : 1) * 1024 + k];
        WSF(WS_CS)[i] = F.in[6][(layer * 2 + nrm) * 1024 + k] * (1.0f + sc);
        float g = mods[((size_t)layer * 2 + var) * 6144 + (nrm ? 5 : 2) * 1024 + k];
        if (layer == 2 && nrm == 0) g *= F.in[23][k];
        WSF(WS_GATE)[i] = g;
    }
    const int gw = F.bid * NWAVES + F.wave, NGW = F.G * NWAVES;
    {
        constexpr int R0 = HG_N, R1 = SSM_NP, R3 = ATT_N, RF = 4 * FH2, RT = R0 + R1 + R3 + RF;
        for (int it = gw; it < RT; it += NGW) {
            int r = it, layer, which, n; const bf16_t* wt;
            if (r < R0) { layer = 0; which = 0; n = r; wt = WSB(WS_W_HGIN) + (size_t)n * D; }
            else if ((r -= R0) < R1) { layer = 1; which = 0; n = r; wt = WSB(WS_W_SSMIN) + (size_t)n * D; }
            else if ((r -= R1) < R3) { layer = 3; which = 0; n = r; wt = WSB(WS_W_QKV) + (size_t)n * D; }
            else { r -= R3; layer = r / FH2; which = 1; n = r % FH2; wt = WSB(WS_W_FFNIN) + ((size_t)layer * FH2 + n) * D; }
            float aL = 0.f, aC = 0.f;
#pragma unroll
            for (int h = 0; h < 2; ++h) {
                const int k0 = h * 512 + F.lane * 8; const u32x4 w = *(const u32x4*)(wt + k0);
                const float* sL = mods + ((size_t)layer * 2 + 0) * 6144 + (which ? 3 : 0) * 1024 + k0; const float* sC = sL + 6144;
                const f32x4 l0 = *(const f32x4*)sL, l1 = *(const f32x4*)(sL + 4), c0 = *(const f32x4*)sC, c1 = *(const f32x4*)(sC + 4);
                const float w0 = lo_bf(w.x), w1 = hi_bf(w.x), w2 = lo_bf(w.y), w3 = hi_bf(w.y), w4 = lo_bf(w.z), w5 = hi_bf(w.z), w6 = lo_bf(w.w), w7 = hi_bf(w.w);
                aL += w0 * l0[0] + w1 * l0[1] + w2 * l0[2] + w3 * l0[3] + w4 * l1[0] + w5 * l1[1] + w6 * l1[2] + w7 * l1[3];
                aC += w0 * c0[0] + w1 * c0[1] + w2 * c0[2] + w3 * c0[3] + w4 * c1[0] + w5 * c1[1] + w6 * c1[2] + w7 * c1[3];
            }
            aL = wave_sum(aL); aC = wave_sum(aC);
            if (F.lane == 0) { float* bp = WSF(which ? WS_BIAS3 : WS_BIAS1) + (size_t)layer * 2 * FH2 + n; bp[0] = aL; bp[FH2] = aC; }
        }
    }
    for (int row = gw; row < MALL; row += NGW) {
        const int var = row >= NLAT; const float* xr = var ? F.in[2] + (size_t)(row - NLAT) * D : F.in[0] + (size_t)row * D;
        float ss = 0.f;
#pragma unroll
        for (int j = 0; j < 4; ++j) {
            const int k = j * 256 + F.lane * 4; const f32x4 x = *(const f32x4*)(xr + k);
            const f32x4 nw = *(const f32x4*)(F.in[6] + k); const f32x4 sc = *(const f32x4*)(mods + (size_t)var * 6144 + 1024 + k);
            ss += (x[0] * x[0] + x[1] * x[1]) + (x[2] * x[2] + x[3] * x[3]);
            const f32x4 y = x * (nw * (sc + 1.0f)); u32x2 w; w.x = pk2(y[0], y[1]); w.y = pk2(y[2], y[3]);
            *(u32x2*)(WSB(WS_XSA) + (size_t)row * D + k) = w;
        }
        ss = wave_sum(ss);
        if (F.lane < 16) WSF(WS_SLOTS)[(size_t)row * 16 + F.lane] = (F.lane == 0) ? ss : 0.f;
    }
}

__device__ __forceinline__ int scan_row(int p, int dir) {
    if (p < NCTX) return NLAT + (dir ? NCTX - 1 - p : p);
    const int q = p - NCTX; return dir ? NLAT - 1 - q : q;
}
struct NArgs { const float* in[27]; unsigned char* ws; };
#define NWSF(off) ((float*)(a.ws + (off)))
#define NWSB(off) ((bf16_t*)(a.ws + (off)))
__global__ void __launch_bounds__(128) naive_hg_scan_k(NArgs a) {
    __shared__ float sh[384];
    const bf16_t* P = NWSB(WS_P); bf16_t* OX = NWSB(WS_ST); const int tid = threadIdx.x;
    const int job = blockIdx.x, dir = job >> 3, h = job & 7;
    float S[128];
#pragma unroll
    for (int d = 0; d < 128; ++d) S[d] = 0.f;
    const float lb = NWSF(WS_LB)[dir * 1024 + h * 128 + tid];
    for (int p = 0; p < MALL; ++p) {
        const int row = scan_row(p, dir); const bf16_t* pr = P + (size_t)row * PLD;
        const float z = bf2f(pr[1024 + dir * 1024 + h * 128 + tid]); const float sg = 1.0f / (1.0f + expf(-z));
        sh[tid] = lb + (1.f - lb) * sg; sh[128 + tid] = (1.f - lb) * (1.f - sg); sh[256 + tid] = bf2f(pr[h * 128 + tid]);
        __syncthreads();
        const float v = bf2f(pr[3072 + h * 128 + tid]); float o = 0.f;
#pragma unroll
        for (int d = 0; d < 128; ++d) { S[d] = sh[d] * S[d] + sh[128 + d] * v; o += S[d] * sh[256 + d]; }
        OX[((size_t)dir * MALL + row) * D + h * 128 + tid] = (bf16_t)f2bf(o);
        __syncthreads();
    }
}
__global__ void __launch_bounds__(256) naive_hg_readout_k(NArgs a) {
    const bf16_t* P = NWSB(WS_P); const bf16_t* OX = NWSB(WS_ST); bf16_t* O = NWSB(WS_XSA);
    const int lane = threadIdx.x & 63, gw = blockIdx.x * 4 + (threadIdx.x >> 6), NGW = gridDim.x * 4;
    for (int it = gw; it < MALL * 8; it += NGW) {
        const int row = it >> 3, h = it & 7; const int c = h * 128 + lane * 2;
        const unsigned x = *(const unsigned*)(OX + (size_t)row * D + c), y = *(const unsigned*)(OX + ((size_t)MALL + row) * D + c);
        const float o0 = lo_bf(x) + lo_bf(y), o1 = hi_bf(x) + hi_bf(y);
        const float ss = wave_sum(o0 * o0 + o1 * o1); const float r = rsqrtf(ss * (1.0f / 128.0f) + EPS);
        const unsigned gg = *(const unsigned*)(P + (size_t)row * PLD + 4096 + c);
        const float w0 = a.in[12][lane * 2], w1 = a.in[12][lane * 2 + 1];
        *(unsigned*)(O + (size_t)row * D + c) = pk2(o0 * r * w0 * lo_bf(gg), o1 * r * w1 * hi_bf(gg));
    }
}
__global__ void __launch_bounds__(384) naive_ssm_scan_k(NArgs a) {
    __shared__ float sh[384];
    const bf16_t* P = NWSB(WS_P); bf16_t* YB = NWSB(WS_ST); const int tid = threadIdx.x;
    const int h = blockIdx.x, g = h >> 3;
    int ch = 0; if (tid < 64) ch = h * 64 + tid; else if (tid < 192) ch = 2048 + g * 128 + (tid - 64); else if (tid < 320) ch = 2560 + g * 128 + (tid - 192);
    float cw[5] = {0.f, 0.f, 0.f, 0.f, 0.f}, cb = 0.f;
    if (tid < 320) {
#pragma unroll
        for (int j = 0; j < 5; ++j) cw[j] = a.in[15][j * SSM_CD + ch];
        cb = a.in[16][ch]; }
    for (int dir = 1; dir >= 0; --dir) {
        const float A = -expf(a.in[18][dir * 32 + h]), dtb = a.in[17][dir * 32 + h], Dk = a.in[19][h];
        float S[128];
#pragma unroll
        for (int n = 0; n < 128; ++n) S[n] = 0.f;
        for (int p = 0; p < MALL; ++p) {
            const int row = scan_row(p, dir);
            const int s0 = (row >= NLAT) ? NLAT : 0, s1 = (row >= NLAT) ? MALL : NLAT;
            if (tid < 320) {
                float acc = cb;
#pragma unroll
                for (int j = 0; j < 5; ++j) { const int rr = row + j - 2; if (rr >= s0 && rr < s1) acc += cw[j] * bf2f(P[(size_t)rr * PLD + 2048 + ch]); }
                sh[tid] = acc / (1.0f + expf(-acc));
            } else if (tid == 320) {
                const float x = NWSF(WS_DT)[(size_t)row * 64 + dir * 32 + h] + dtb; const float dt = (x > 20.f) ? x : log1pf(expf(x));
                sh[320] = dt; sh[321] = expf(dt * A);
            }
            __syncthreads();
            if (tid < 64) {
                const float xp = sh[tid], dt = sh[320], da = sh[321], dx = dt * xp; float y = 0.f;
#pragma unroll
                for (int n = 0; n < 128; ++n) { S[n] = da * S[n] + dx * sh[64 + n]; y += S[n] * sh[192 + n]; }
                bf16_t* yp = YB + (size_t)row * SSM_DI + h * 64 + tid;
                if (dir == 1) *yp = (bf16_t)f2bf(y); else *yp = (bf16_t)f2bf(y + bf2f(*yp) + Dk * xp);
            }
            __syncthreads();
        }
    }
}
__global__ void __launch_bounds__(256) naive_ssm_readout_k(NArgs a) {
    bf16_t* P = NWSB(WS_P); const bf16_t* YB = NWSB(WS_ST);
    const int lane = threadIdx.x & 63, gw = blockIdx.x * 4 + (threadIdx.x >> 6), NGW = gridDim.x * 4;
    for (int it = gw; it < MALL * 4; it += NGW) {
        const int row = it >> 2, g = it & 3; const int c = g * 512 + lane * 8;
        const u32x4 yv = *(const u32x4*)(YB + (size_t)row * SSM_DI + c), zv = *(const u32x4*)(P + (size_t)row * PLD + c);
        float y[8]; const unsigned yw[4] = {yv.x, yv.y, yv.z, yv.w}, zw[4] = {zv.x, zv.y, zv.z, zv.w}; float ss = 0.f;
#pragma unroll
        for (int j = 0; j < 4; ++j) { const float z0 = lo_bf(zw[j]), z1 = hi_bf(zw[j]);
            y[2 * j] = lo_bf(yw[j]) * (z0 / (1.0f + expf(-z0))); y[2 * j + 1] = hi_bf(yw[j]) * (z1 / (1.0f + expf(-z1))); ss += y[2 * j] * y[2 * j] + y[2 * j + 1] * y[2 * j + 1]; }
        ss = wave_sum(ss); const float r = rsqrtf(ss * (1.0f / 512.0f) + EPS);
        const float* nw = a.in[20] + c; u32x4 o;
        o.x = pk2(y[0] * r * nw[0], y[1] * r * nw[1]); o.y = pk2(y[2] * r * nw[2], y[3] * r * nw[3]); o.z = pk2(y[4] * r * nw[4], y[5] * r * nw[5]); o.w = pk2(y[6] * r * nw[6], y[7] * r * nw[7]);
        *(u32x4*)(P + (size_t)row * PLD + c) = o;
    }
}
__global__ void __launch_bounds__(256) naive_attention_k(NArgs a) {
    const bf16_t* QK = NWSB(WS_P); bf16_t* O = NWSB(WS_XSA);
    const int gt = blockIdx.x * 256 + threadIdx.x, GT = gridDim.x * 256;
    for (int it = gt; it < NLAT * 16; it += GT) {
        const int t = it >> 4, qh = it & 15, kvh = qh >> 2;
        float q[64], acc[64];
#pragma unroll
        for (int d = 0; d < 64; d += 2) { const unsigned w = *(const unsigned*)(QK + (size_t)t * QK_LD + qh * 64 + d); q[d] = lo_bf(w); q[d + 1] = hi_bf(w); acc[d] = 0.f; acc[d + 1] = 0.f; }
        float m = a.in[25][qh], l = 1.0f;
        const int lo = (t - 128 < 0) ? 0 : t - 128, hi = (t + 128 > NLAT - 1) ? NLAT - 1 : t + 128;
        const int nk = (hi - lo + 1) + NCTX;
        for (int i = 0; i < nk; ++i) {
            const int s = (i <= hi - lo) ? lo + i : NLAT + (i - (hi - lo + 1));
            const bf16_t* kp = QK + (size_t)s * QK_LD + 1024 + kvh * 64; float sc = 0.f;
#pragma unroll
            for (int d = 0; d < 64; d += 2) { const unsigned w = *(const unsigned*)(kp + d); sc += q[d] * lo_bf(w) + q[d + 1] * hi_bf(w); }
            const float mn = fmaxf(m, sc), al = expf(m - mn), pe = expf(sc - mn);
            l = l * al + pe; m = mn;
            const bf16_t* vp = kp + 256;
#pragma unroll
            for (int d = 0; d < 64; d += 2) { const unsigned w = *(const unsigned*)(vp + d); acc[d] = acc[d] * al + pe * lo_bf(w); acc[d + 1] = acc[d + 1] * al + pe * hi_bf(w); }
        }
        const float il = 1.0f / l;
#pragma unroll
        for (int d = 0; d < 64; d += 2) *(unsigned*)(O + (size_t)t * D + qh * 64 + d) = pk2(acc[d] * il, acc[d + 1] * il);
    }
}


typedef float f32x16 __attribute__((ext_vector_type(16)));
#define MFMA32(a, b, c) __builtin_amdgcn_mfma_f32_32x32x16_bf16((a), (b), (c), 0, 0, 0)
__device__ __forceinline__ int tc_row0(int tc) { return tc < 256 ? tc * 64 : NLAT + (tc - 256) * 64; }
__device__ __forceinline__ int tc_pf(int tc) { return tc < 256 ? 4 + tc : tc - 256; }
__device__ __forceinline__ int tc_pb(int tc) { return tc < 256 ? 4 + 255 - tc : 3 - (tc - 256); }
__device__ __forceinline__ bf16_t* hg_state(const Frame& F, int dir, int h, int p) {
    return (h < 5) ? (bf16_t*)(F.ws + WS_ST) + ((size_t)(dir * 5 + h) * 260 + p) * 16384 : (bf16_t*)F.out + ((size_t)(dir * 3 + (h - 5)) * 260 + p) * 16384;
}
constexpr int HG_VT = 0, HG_QR = 18432, HG_KR = 53248, HG_QI = 88064, HG_ATT = 122880, HG_SEG = 140288, HG_RED = 144384;
constexpr int HG_PITCH = 272, HG_VPITCH = 144;
static_assert(HG_RED + 1024 <= MISC_OFF, "HGRN LDS map");
struct HgPrep { float k0[16], k1[16], c0[16], c1[16], off0, off1, tot0, tot1, ref0, ref1; };
__device__ __forceinline__ void hg_prep(const Frame& F, const bf16_t* P, int row0, int h, int dir, int seg, int cp, HgPrep& R) {
    const float lb0 = WSF(WS_LB)[dir * 1024 + h * 128 + 2 * cp], lb1 = WSF(WS_LB)[dir * 1024 + h * 128 + 2 * cp + 1];
    unsigned zw[16];
#pragma unroll
    for (int i = 0; i < 16; ++i) { const int si = seg * 16 + i, tok = dir ? 63 - si : si; zw[i] = *(const unsigned*)(P + (size_t)(row0 + tok) * PLD + 1024 + dir * 1024 + h * 128 + 2 * cp); }
    float a0 = 0.f, a1 = 0.f;
#pragma unroll
    for (int i = 0; i < 16; ++i) {
        const float s0 = sigmoidf_(lo_bf(zw[i])), s1 = sigmoidf_(hi_bf(zw[i]));
        a0 += __logf(lb0 + (1.f - lb0) * s0); a1 += __logf(lb1 + (1.f - lb1) * s1);
        R.c0[i] = a0; R.c1[i] = a1; R.k0[i] = (1.f - lb0) * (1.f - s0); R.k1[i] = (1.f - lb1) * (1.f - s1);
    }
    LAS float* sg = (LAS float*)(F.lds + HG_SEG) + (dir * 4) * 128 + 2 * cp;
    sg[seg * 128] = a0; sg[seg * 128 + 1] = a1;
    __syncthreads();
    float o0 = 0.f, o1 = 0.f, t0 = 0.f, t1 = 0.f;
#pragma unroll
    for (int s_ = 0; s_ < 4; ++s_) { const float x0 = sg[s_ * 128], x1 = sg[s_ * 128 + 1]; if (s_ < seg) { o0 += x0; o1 += x1; } t0 += x0; t1 += x1; }
    R.off0 = o0; R.off1 = o1; R.tot0 = t0; R.tot1 = t1; R.ref0 = sg[0] + sg[128]; R.ref1 = sg[1] + sg[129];
}
__device__ __forceinline__ void hg_stage_vt(const Frame& F, const bf16_t* P, int row0, int h, int seg, int cp) {
    unsigned vw[16];
#pragma unroll
    for (int i = 0; i < 16; ++i) vw[i] = *(const unsigned*)(P + (size_t)(row0 + seg * 16 + i) * PLD + 3072 + h * 128 + 2 * cp);
    u32x4 a, b, c, d;
    a.x = (vw[0] & 0xffffu) | (vw[1] << 16); a.y = (vw[2] & 0xffffu) | (vw[3] << 16); a.z = (vw[4] & 0xffffu) | (vw[5] << 16); a.w = (vw[6] & 0xffffu) | (vw[7] << 16);
    b.x = (vw[8] & 0xffffu) | (vw[9] << 16); b.y = (vw[10] & 0xffffu) | (vw[11] << 16); b.z = (vw[12] & 0xffffu) | (vw[13] << 16); b.w = (vw[14] & 0xffffu) | (vw[15] << 16);
    c.x = (vw[0] >> 16) | (vw[1] & 0xffff0000u); c.y = (vw[2] >> 16) | (vw[3] & 0xffff0000u); c.z = (vw[4] >> 16) | (vw[5] & 0xffff0000u); c.w = (vw[6] >> 16) | (vw[7] & 0xffff0000u);
    d.x = (vw[8] >> 16) | (vw[9] & 0xffff0000u); d.y = (vw[10] >> 16) | (vw[11] & 0xffff0000u); d.z = (vw[12] >> 16) | (vw[13] & 0xffff0000u); d.w = (vw[14] >> 16) | (vw[15] & 0xffff0000u);
    LAS unsigned char* r0 = F.lds + HG_VT + (2 * cp) * HG_VPITCH + seg * 32;
    *(LAS u32x4*)r0 = a; *(LAS u32x4*)(r0 + 16) = b; *(LAS u32x4*)(r0 + HG_VPITCH) = c; *(LAS u32x4*)(r0 + HG_VPITCH + 16) = d;
}
__device__ __forceinline__ void phase_hg_a(Frame& F) {
    const bf16_t* P = WSB(WS_P);
    const int dir = F.wave >> 2, seg = F.wave & 3, cp = F.lane, r = F.lane & 31, hf = F.lane >> 5;
    constexpr int HG_KD = HG_QR;
    for (int u = F.bid; u < 260 * 8; u += F.G) {
        const int tc = u >> 3, h = u & 7, row0 = tc_row0(tc), p = dir ? tc_pb(tc) : tc_pf(tc);
        __syncthreads();
        HgPrep R; hg_prep(F, P, row0, h, dir, seg, cp, R);
        if (dir == 0) hg_stage_vt(F, P, row0, h, seg, cp);
        {
            float e0[16], e1[16];
#pragma unroll
            for (int i = 0; i < 16; ++i) { e0[i] = R.k0[i] * __expf(R.tot0 - R.off0 - R.c0[i]); e1[i] = R.k1[i] * __expf(R.tot1 - R.off1 - R.c1[i]); }
            u32x4 a, b, c, d;
            if (dir == 0) {
                a.x = pk2(e0[0], e0[1]); a.y = pk2(e0[2], e0[3]); a.z = pk2(e0[4], e0[5]); a.w = pk2(e0[6], e0[7]); b.x = pk2(e0[8], e0[9]); b.y = pk2(e0[10], e0[11]); b.z = pk2(e0[12], e0[13]); b.w = pk2(e0[14], e0[15]);
                c.x = pk2(e1[0], e1[1]); c.y = pk2(e1[2], e1[3]); c.z = pk2(e1[4], e1[5]); c.w = pk2(e1[6], e1[7]); d.x = pk2(e1[8], e1[9]); d.y = pk2(e1[10], e1[11]); d.z = pk2(e1[12], e1[13]); d.w = pk2(e1[14], e1[15]);
            } else {
                a.x = pk2(e0[15], e0[14]); a.y = pk2(e0[13], e0[12]); a.z = pk2(e0[11], e0[10]); a.w = pk2(e0[9], e0[8]); b.x = pk2(e0[7], e0[6]); b.y = pk2(e0[5], e0[4]); b.z = pk2(e0[3], e0[2]); b.w = pk2(e0[1], e0[0]);
                c.x = pk2(e1[15], e1[14]); c.y = pk2(e1[13], e1[12]); c.z = pk2(e1[11], e1[10]); c.w = pk2(e1[9], e1[8]); d.x = pk2(e1[7], e1[6]); d.y = pk2(e1[5], e1[4]); d.z = pk2(e1[3], e1[2]); d.w = pk2(e1[1], e1[0]);
            }
            const int tok_lo = dir ? 48 - 16 * seg : 16 * seg;
            LAS unsigned char* r0 = F.lds + HG_KD + (dir * 128 + 2 * cp) * HG_VPITCH + tok_lo * 2;
            *(LAS u32x4*)r0 = a; *(LAS u32x4*)(r0 + 16) = b; *(LAS u32x4*)(r0 + HG_VPITCH) = c; *(LAS u32x4*)(r0 + HG_VPITCH + 16) = d;
            if (seg == 0) { float* dp = WSF(WS_DT) + ((size_t)(dir * 8 + h) * 260 + p) * 128 + 2 * cp; dp[0] = __expf(R.tot0); dp[1] = __expf(R.tot1); }
        }
        __syncthreads();
        f32x16 acc[4];
#pragma unroll
        for (int j = 0; j < 4; ++j)
#pragma unroll
            for (int i = 0; i < 16; ++i) acc[j][i] = 0.f;
#pragma unroll
        for (int ks = 0; ks < 4; ++ks) {
            const bf16x8 a = *(const LAS bf16x8*)(F.lds + HG_KD + (dir * 128 + seg * 32 + r) * HG_VPITCH + (ks * 16 + hf * 8) * 2);
#pragma unroll
            for (int j = 0; j < 4; ++j) { const bf16x8 b = *(const LAS bf16x8*)(F.lds + HG_VT + (j * 32 + r) * HG_VPITCH + (ks * 16 + hf * 8) * 2); acc[j] = MFMA32(a, b, acc[j]); }
        }
        bf16_t* st = hg_state(F, dir, h, p);
#pragma unroll
        for (int j = 0; j < 4; ++j)
#pragma unroll
            for (int g = 0; g < 4; ++g) { u32x2 w; w.x = cvt_pk_bf16(acc[j][4 * g], acc[j][4 * g + 1]); w.y = cvt_pk_bf16(acc[j][4 * g + 2], acc[j][4 * g + 3]);
                *(u32x2*)(st + (size_t)(j * 32 + r) * 128 + seg * 32 + 8 * g + 4 * hf) = w; }
    }
}
__device__ __forceinline__ void phase_hg_b(Frame& F) {
    for (int idx = F.bid * NTHR + F.tid; idx < 2 * 8 * 8192; idx += F.G * NTHR) {
        const int e2 = idx & 8191, h = (idx >> 13) & 7, dir = idx >> 16, dv = e2 >> 6, dk = (e2 & 63) * 2;
        unsigned* sp = (unsigned*)(hg_state(F, dir, h, 0) + dv * 128 + dk);
        const f32x2* dp = (const f32x2*)(WSF(WS_DT) + ((size_t)(dir * 8 + h) * 260) * 128 + dk);
        float s0 = 0.f, s1 = 0.f;
        for (int p = 0; p < 260; p += 4) {
            unsigned x[4]; f32x2 d[4];
#pragma unroll
            for (int j = 0; j < 4; ++j) { x[j] = sp[(size_t)(p + j) * 8192]; d[j] = dp[(size_t)(p + j) * 64]; }
#pragma unroll
            for (int j = 0; j < 4; ++j) { sp[(size_t)(p + j) * 8192] = pk2(s0, s1); s0 = d[j].x * s0 + lo_bf(x[j]); s1 = d[j].y * s1 + hi_bf(x[j]); }
        }
    }
}
__device__ __forceinline__ void phase_hg_c(Frame& F) {
    const bf16_t* P = WSB(WS_P); bf16_t* O = WSB(WS_XSA);
    const int dir = F.wave >> 2, seg = F.wave & 3, cp = F.lane, r = F.lane & 31, hf = F.lane >> 5;
    for (int u = F.bid; u < 260 * 8; u += F.G) {
        const int tc = u >> 3, h = u & 7, row0 = tc_row0(tc);
        const int tb2 = F.wave >> 2, jb = F.wave & 3;
        bf16x8 sf[16];
        {
            const bf16_t* s0p = hg_state(F, 0, h, tc_pf(tc)) + (size_t)(jb * 32 + r) * 128 + hf * 8;
            const bf16_t* s1p = hg_state(F, 1, h, tc_pb(tc)) + (size_t)(jb * 32 + r) * 128 + hf * 8;
#pragma unroll
            for (int ks = 0; ks < 8; ++ks) { sf[ks] = *(const bf16x8*)(s0p + ks * 16); sf[8 + ks] = *(const bf16x8*)(s1p + ks * 16); }
        }
        __syncthreads();
        HgPrep R; hg_prep(F, P, row0, h, dir, seg, cp, R);
        if (dir == 0) hg_stage_vt(F, P, row0, h, seg, cp);
        {
#pragma unroll
            for (int i = 0; i < 16; ++i) {
                const int si = seg * 16 + i, tok = dir ? 63 - si : si;
                const unsigned qw = *(const unsigned*)(P + (size_t)(row0 + tok) * PLD + h * 128 + 2 * cp);
                const float q0 = lo_bf(qw), q1 = hi_bf(qw);
                const float cu0 = R.off0 + R.c0[i], cu1 = R.off1 + R.c1[i], a0 = cu0 - R.ref0, a1 = cu1 - R.ref1;
                const int lo = (dir * 64 + tok) * HG_PITCH + 4 * cp;
                *(LAS unsigned*)(F.lds + HG_QR + lo) = pk2(q0 * __expf(a0), q1 * __expf(a1));
                *(LAS unsigned*)(F.lds + HG_KR + lo) = pk2(R.k0[i] * __expf(-a0), R.k1[i] * __expf(-a1));
                *(LAS unsigned*)(F.lds + HG_QI + lo) = pk2(q0 * __expf(cu0), q1 * __expf(cu1));
            }
        }
        __syncthreads();
        {
            const int tb = (F.wave >> 1) & 1, sb = F.wave & 1;
            f32x16 acc;
#pragma unroll
            for (int i = 0; i < 16; ++i) acc[i] = 0.f;
#pragma unroll
            for (int ks = 0; ks < 8; ++ks) {
                const bf16x8 a = *(const LAS bf16x8*)(F.lds + HG_KR + (dir * 64 + sb * 32 + r) * HG_PITCH + (ks * 16 + hf * 8) * 2);
                const bf16x8 b = *(const LAS bf16x8*)(F.lds + HG_QR + (dir * 64 + tb * 32 + r) * HG_PITCH + (ks * 16 + hf * 8) * 2);
                acc = MFMA32(a, b, acc);
            }
            const int t = tb * 32 + r;
#pragma unroll
            for (int g = 0; g < 4; ++g) {
                const int s0 = sb * 32 + 8 * g + 4 * hf; float v[4];
#pragma unroll
                for (int j = 0; j < 4; ++j) { const int s_ = s0 + j; const bool keep = dir ? (s_ >= t) : (s_ <= t); v[j] = keep ? acc[4 * g + j] : 0.f; }
                u32x2 w; w.x = pk2(v[0], v[1]); w.y = pk2(v[2], v[3]);
                *(LAS u32x2*)(F.lds + HG_ATT + t * HG_PITCH + (dir * 64 + s0) * 2) = w;
            }
        }
        __syncthreads();
        f32x16 o;
#pragma unroll
        for (int i = 0; i < 16; ++i) o[i] = 0.f;
#pragma unroll
        for (int ks = 0; ks < 8; ++ks) {
            const bf16x8 a = *(const LAS bf16x8*)(F.lds + HG_VT + (jb * 32 + r) * HG_VPITCH + ((ks & 3) * 16 + hf * 8) * 2);
            const bf16x8 b = *(const LAS bf16x8*)(F.lds + HG_ATT + (tb2 * 32 + r) * HG_PITCH + (ks * 16 + hf * 8) * 2);
            o = MFMA32(a, b, o);
        }
#pragma unroll
        for (int ks = 0; ks < 16; ++ks) {
            const bf16x8 b = *(const LAS bf16x8*)(F.lds + HG_QI + ((ks >> 3) * 64 + tb2 * 32 + r) * HG_PITCH + ((ks & 7) * 16 + hf * 8) * 2);
            o = MFMA32(sf[ks], b, o);
        }
        float ss = 0.f;
#pragma unroll
        for (int i = 0; i < 16; ++i) ss += o[i] * o[i];
        ss += __shfl_xor(ss, 32);
        LAS float* red = (LAS float*)(F.lds + HG_RED);
        if (hf == 0) red[(tb2 * 4 + jb) * 32 + r] = ss;
        __syncthreads();
        const float tot = red[(tb2 * 4 + 0) * 32 + r] + red[(tb2 * 4 + 1) * 32 + r] + red[(tb2 * 4 + 2) * 32 + r] + red[(tb2 * 4 + 3) * 32 + r];
        const float rn = rsqrtf(tot * (1.0f / 128.0f) + EPS);
        const int row = row0 + tb2 * 32 + r;
#pragma unroll
        for (int g = 0; g < 4; ++g) {
            const int dv = jb * 32 + 8 * g + 4 * hf;
            const u32x2 gw = *(const u32x2*)(P + (size_t)row * PLD + 4096 + h * 128 + dv);
            const f32x4 nw = *(const f32x4*)(F.in[12] + dv);
            u32x2 w; w.x = pk2(o[4 * g] * rn * nw[0] * lo_bf(gw.x), o[4 * g + 1] * rn * nw[1] * hi_bf(gw.x));
            w.y = pk2(o[4 * g + 2] * rn * nw[2] * lo_bf(gw.y), o[4 * g + 3] * rn * nw[3] * hi_bf(gw.y));
            *(u32x2*)(O + (size_t)row * D + h * 128 + dv) = w;
        }
    }
}


constexpr int AT_K = 0, AT_V = 2 * 9216, AT_PITCH = 144;
__device__ __forceinline__ void phase_att(Frame& F) {
    const bf16_t* QKV = WSB(WS_P); bf16_t* O = WSB(WS_XSA);
    const int r = F.lane & 31, hf = F.lane >> 5, g = F.wave >> 1, th = F.wave & 1;
    const int kkey = F.tid >> 3, kc = F.tid & 7, vkey = F.tid & 63, vdg = F.tid >> 6;
    for (int u = F.bid; u < 1024; u += F.G) {
        const int kvh = u & 3, t0 = (u >> 2) * 64, qh = kvh * 4 + g, t = t0 + 32 * th + r;
        bf16x8 qf[4];
#pragma unroll
        for (int ks = 0; ks < 4; ++ks) qf[ks] = *(const bf16x8*)(QKV + (size_t)t * QK_LD + qh * 64 + ks * 16 + hf * 8);
        int jfirst = 0, jlast = 4;
        if (t0 - 128 < 0) jfirst = (128 - t0) >> 6;
        if (t0 + 191 >= NLAT) jlast = 4 - ((t0 + 192 - NLAT) >> 6);
        const int ntl = jlast - jfirst + 1, nt = ntl + 4;
        const bf16_t* kbase = QKV + 1024 + kvh * 64;
        u32x4 kreg, vreg;
#define AT_LOAD(it) do { const int s0_ = ((it) < ntl) ? (t0 - 128 + 64 * (jfirst + (it))) : (NLAT + 64 * ((it) - ntl)); \
            kreg = *(const u32x4*)(kbase + (size_t)(s0_ + kkey) * QK_LD + 8 * kc); vreg = *(const u32x4*)(kbase + (size_t)(s0_ + vkey) * QK_LD + 256 + 8 * vdg); } while (0)
#define AT_WRITE(b) do { *(LAS u32x4*)(F.lds + AT_K + (b) * 9216 + kkey * AT_PITCH + 16 * kc) = kreg; \
            LAS unsigned short* vp_ = (LAS unsigned short*)(F.lds + AT_V + (b) * 9216 + (8 * vdg) * AT_PITCH + vkey * 2); \
            vp_[0] = (unsigned short)(vreg.x & 0xffffu); vp_[AT_PITCH / 2] = (unsigned short)(vreg.x >> 16); vp_[2 * (AT_PITCH / 2)] = (unsigned short)(vreg.y & 0xffffu); vp_[3 * (AT_PITCH / 2)] = (unsigned short)(vreg.y >> 16); \
            vp_[4 * (AT_PITCH / 2)] = (unsigned short)(vreg.z & 0xffffu); vp_[5 * (AT_PITCH / 2)] = (unsigned short)(vreg.z >> 16); vp_[6 * (AT_PITCH / 2)] = (unsigned short)(vreg.w & 0xffffu); vp_[7 * (AT_PITCH / 2)] = (unsigned short)(vreg.w >> 16); } while (0)
        AT_LOAD(0); AT_WRITE(0);
        __syncthreads();
        float m = F.in[25][qh], l = 1.0f;
        f32x16 o0, o1;
#pragma unroll
        for (int i = 0; i < 16; ++i) { o0[i] = 0.f; o1[i] = 0.f; }
        for (int it = 0; it < nt; ++it) {
            const int b = it & 1;
            if (it + 1 < nt) AT_LOAD(it + 1);
            f32x16 x0, x1;
#pragma unroll
            for (int i = 0; i < 16; ++i) { x0[i] = 0.f; x1[i] = 0.f; }
#pragma unroll
            for (int ks = 0; ks < 4; ++ks) {
                const bf16x8 a0 = *(const LAS bf16x8*)(F.lds + AT_K + b * 9216 + r * AT_PITCH + (ks * 16 + hf * 8) * 2);
                const bf16x8 a1 = *(const LAS bf16x8*)(F.lds + AT_K + b * 9216 + (32 + r) * AT_PITCH + (ks * 16 + hf * 8) * 2);
                x0 = MFMA32(a0, qf[ks], x0); x1 = MFMA32(a1, qf[ks], x1);
            }
            if (it < ntl) { const int j = jfirst + it;
                if (j == 0 || j == 4) { const int s0 = t0 - 128 + 64 * j;
#pragma unroll
                    for (int i = 0; i < 16; ++i) { const int sk = s0 + (i & 3) + 8 * (i >> 2) + 4 * hf; const int d0 = sk - t, d1 = sk + 32 - t;
                        if (d0 < -128 || d0 > 128) x0[i] = -1e30f; if (d1 < -128 || d1 > 128) x1[i] = -1e30f; } } }
            float mx = x0[0];
#pragma unroll
            for (int i = 0; i < 16; ++i) { mx = fmaxf(mx, x0[i]); mx = fmaxf(mx, x1[i]); }
            mx = fmaxf(mx, __shfl_xor(mx, 32));
            const float mn = fmaxf(m, mx), al = __expf(m - mn); m = mn;
            float ls = 0.f;
#pragma unroll
            for (int i = 0; i < 16; ++i) { x0[i] = __expf(x0[i] - mn); x1[i] = __expf(x1[i] - mn); ls += x0[i] + x1[i]; }
            ls += __shfl_xor(ls, 32);
            l = l * al + ls;
#pragma unroll
            for (int i = 0; i < 16; ++i) { o0[i] *= al; o1[i] *= al; }
#pragma unroll
            for (int kt = 0; kt < 2; ++kt)
#pragma unroll
                for (int s_ = 0; s_ < 2; ++s_) {
                    u32x4 pw;
                    if (kt == 0) { pw.x = cvt_pk_bf16(x0[8 * s_], x0[8 * s_ + 1]); pw.y = cvt_pk_bf16(x0[8 * s_ + 2], x0[8 * s_ + 3]); pw.z = cvt_pk_bf16(x0[8 * s_ + 4], x0[8 * s_ + 5]); pw.w = cvt_pk_bf16(x0[8 * s_ + 6], x0[8 * s_ + 7]); }
                    else { pw.x = cvt_pk_bf16(x1[8 * s_], x1[8 * s_ + 1]); pw.y = cvt_pk_bf16(x1[8 * s_ + 2], x1[8 * s_ + 3]); pw.z = cvt_pk_bf16(x1[8 * s_ + 4], x1[8 * s_ + 5]); pw.w = cvt_pk_bf16(x1[8 * s_ + 6], x1[8 * s_ + 7]); }
                    const bf16x8 pb = __builtin_bit_cast(bf16x8, pw);
                    const int koff = (kt * 32 + 16 * s_ + 4 * hf) * 2;
                    const LAS unsigned char* v0p = F.lds + AT_V + b * 9216 + r * AT_PITCH + koff; const LAS unsigned char* v1p = v0p + 32 * AT_PITCH;
                    u32x4 a0w, a1w; const u32x2 a00 = *(const LAS u32x2*)v0p, a01 = *(const LAS u32x2*)(v0p + 16), a10 = *(const LAS u32x2*)v1p, a11 = *(const LAS u32x2*)(v1p + 16);
                    a0w.x = a00.x; a0w.y = a00.y; a0w.z = a01.x; a0w.w = a01.y; a1w.x = a10.x; a1w.y = a10.y; a1w.z = a11.x; a1w.w = a11.y;
                    o0 = MFMA32(__builtin_bit_cast(bf16x8, a0w), pb, o0); o1 = MFMA32(__builtin_bit_cast(bf16x8, a1w), pb, o1);
                }
            if (it + 1 < nt) AT_WRITE(b ^ 1);
            __syncthreads();
        }
        const float il = 1.0f / l;
#pragma unroll
        for (int g4 = 0; g4 < 4; ++g4) {
            const int d = 8 * g4 + 4 * hf;
            u32x2 w0, w1; w0.x = cvt_pk_bf16(o0[4 * g4] * il, o0[4 * g4 + 1] * il); w0.y = cvt_pk_bf16(o0[4 * g4 + 2] * il, o0[4 * g4 + 3] * il);
            w1.x = cvt_pk_bf16(o1[4 * g4] * il, o1[4 * g4 + 1] * il); w1.y = cvt_pk_bf16(o1[4 * g4 + 2] * il, o1[4 * g4 + 3] * il);
            *(u32x2*)(O + (size_t)t * D + qh * 64 + d) = w0; *(u32x2*)(O + (size_t)t * D + qh * 64 + 32 + d) = w1;
        }
#undef AT_LOAD
#undef AT_WRITE
    }
}


constexpr size_t WS_SDEC = WS_CTL + 32768;
__device__ __forceinline__ bf16_t* ssm_state(const Frame& F, int dir, int h, int p) { return (bf16_t*)(F.ws + WS_ST) + ((size_t)(dir * 32 + h) * 65 + p) * 8192; }
constexpr int SS_PT = 528;
constexpr int SA_BT = 0, SA_XW = 128 * SS_PT, SA_SC = SA_XW + 2 * 64 * SS_PT;
constexpr int SC_BM = 0, SC_XT = 256 * 272, SC_SC = SC_XT + 64 * SS_PT;
static_assert(SA_SC + 4096 <= MISC_OFF && SC_SC + 4096 <= MISC_OFF, "Mamba LDS map");
__device__ __forceinline__ float wave_incl_scan(float v, int lane) {
#pragma unroll
    for (int o = 1; o < 64; o <<= 1) { const float t = __shfl_up(v, o); if (lane >= o) v += t; }
    return v;
}
__device__ __forceinline__ void ssm_scalars(const Frame& F, LAS float* SC, int r0, int h) {
    if (F.wave < 2) {
        const int dir = F.wave; const float A = -__expf(F.in[18][dir * 32 + h]), dtb = F.in[17][dir * 32 + h];
        float dt[4], c[4], run = 0.f;
#pragma unroll
        for (int j = 0; j < 4; ++j) { const int i = dir ? 255 - (4 * F.lane + j) : 4 * F.lane + j;
            const float x = WSF(WS_DT)[(size_t)(r0 + i) * 64 + dir * 32 + h] + dtb; dt[j] = (x > 20.f) ? x : log1pf(__expf(x)); run += dt[j] * A; c[j] = run; }
        const float off = wave_incl_scan(run, F.lane) - run;
#pragma unroll
        for (int j = 0; j < 4; ++j) { const int i = dir ? 255 - (4 * F.lane + j) : 4 * F.lane + j; SC[dir * 256 + i] = dt[j]; SC[512 + dir * 256 + i] = off + c[j]; }
    }
    __syncthreads();
}
__device__ __forceinline__ u32x4 pack8(const float (&v)[8]) { u32x4 w; w.x = cvt_pk_bf16(v[0], v[1]); w.y = cvt_pk_bf16(v[2], v[3]); w.z = cvt_pk_bf16(v[4], v[5]); w.w = cvt_pk_bf16(v[6], v[7]); return w; }
__device__ __forceinline__ void run_geom(int ru, int& r0, int& pf, int& pb) {
    if (ru < 64) { r0 = ru * 256; pf = 1 + ru; pb = 1 + (63 - ru); } else { r0 = NLAT; pf = 0; pb = 0; }
}
__device__ __forceinline__ void phase_ssm_conv(Frame& F) {
    bf16_t* P = WSB(WS_P); const bf16_t* HALO = WSB(WS_HALO);
    for (int u = F.bid; u < 260 * 3; u += F.G) {
        const int tk = u / 3, ch = (u % 3) * 1024 + F.tid * 2;
        const bool first = (tk == 0 || tk == 256), last = (tk == 255 || tk == 259);
        unsigned raw[68];
        raw[0] = first ? 0u : *(const unsigned*)(HALO + ((size_t)tk * 4 + 0) * SSM_CD + ch); raw[1] = first ? 0u : *(const unsigned*)(HALO + ((size_t)tk * 4 + 1) * SSM_CD + ch);
        raw[66] = last ? 0u : *(const unsigned*)(HALO + ((size_t)tk * 4 + 2) * SSM_CD + ch); raw[67] = last ? 0u : *(const unsigned*)(HALO + ((size_t)tk * 4 + 3) * SSM_CD + ch);
        bf16_t* colp = P + (size_t)tk * 64 * PLD + 2048 + ch;
#pragma unroll
        for (int i = 0; i < 64; ++i) raw[2 + i] = *(const unsigned*)(colp + (size_t)i * PLD);
        float cw0[5], cw1[5];
#pragma unroll
        for (int j = 0; j < 5; ++j) { const f32x2 w = *(const f32x2*)(F.in[15] + j * SSM_CD + ch); cw0[j] = w.x; cw1[j] = w.y; }
        const f32x2 cb = *(const f32x2*)(F.in[16] + ch);
#pragma unroll
        for (int i = 0; i < 64; ++i) {
            const float a0 = cb.x + cw0[0] * lo_bf(raw[i]) + cw0[1] * lo_bf(raw[i + 1]) + cw0[2] * lo_bf(raw[i + 2]) + cw0[3] * lo_bf(raw[i + 3]) + cw0[4] * lo_bf(raw[i + 4]);
            const float a1 = cb.y + cw1[0] * hi_bf(raw[i]) + cw1[1] * hi_bf(raw[i + 1]) + cw1[2] * hi_bf(raw[i + 2]) + cw1[3] * hi_bf(raw[i + 3]) + cw1[4] * hi_bf(raw[i + 4]);
            *(unsigned*)(colp + (size_t)i * PLD) = cvt_pk_bf16(siluf_(a0), siluf_(a1));
        }
    }
}
__device__ __forceinline__ void phase_ssm_a(Frame& F) {
    const bf16_t* P = WSB(WS_P); LAS float* SC = (LAS float*)(F.lds + SA_SC);
    const int r = F.lane & 31, hf = F.lane >> 5;
    for (int u = F.bid; u < 65 * 32; u += F.G) {
        const int ru = u >> 5, h = u & 31, g = h >> 3; int r0, pf, pb; run_geom(ru, r0, pf, pb);
        const int xcp = F.tid & 31, xsg = F.tid >> 5, bcp = F.tid & 63, bsg = F.tid >> 6;
        unsigned xr[16], br[32];
        { const bf16_t* xp = P + (size_t)(r0 + xsg * 16) * PLD + 2048 + h * 64 + 2 * xcp;
#pragma unroll
          for (int i = 0; i < 16; ++i) xr[i] = *(const unsigned*)(xp + (size_t)i * PLD);
          const bf16_t* bp = P + (size_t)(r0 + bsg * 32) * PLD + 4096 + g * 128 + 2 * bcp;
#pragma unroll
          for (int i = 0; i < 32; ++i) br[i] = *(const unsigned*)(bp + (size_t)i * PLD); }
        __syncthreads();
        ssm_scalars(F, SC, r0, h);
        const float lastf = SC[512 + 255], lastb = SC[768];
#pragma unroll
        for (int k8 = 0; k8 < 4; ++k8) {
            u32x4 lo, hi;
            lo.x = (br[8 * k8] & 0xffffu) | (br[8 * k8 + 1] << 16); lo.y = (br[8 * k8 + 2] & 0xffffu) | (br[8 * k8 + 3] << 16); lo.z = (br[8 * k8 + 4] & 0xffffu) | (br[8 * k8 + 5] << 16); lo.w = (br[8 * k8 + 6] & 0xffffu) | (br[8 * k8 + 7] << 16);
            hi.x = (br[8 * k8] >> 16) | (br[8 * k8 + 1] & 0xffff0000u); hi.y = (br[8 * k8 + 2] >> 16) | (br[8 * k8 + 3] & 0xffff0000u); hi.z = (br[8 * k8 + 4] >> 16) | (br[8 * k8 + 5] & 0xffff0000u); hi.w = (br[8 * k8 + 6] >> 16) | (br[8 * k8 + 7] & 0xffff0000u);
            LAS unsigned char* bp = F.lds + SA_BT + (2 * bcp) * SS_PT + (bsg * 32 + k8 * 8) * 2; *(LAS u32x4*)bp = lo; *(LAS u32x4*)(bp + SS_PT) = hi;
        }
#pragma unroll
        for (int k8 = 0; k8 < 2; ++k8) {
            float f0[8], f1[8], b0[8], b1[8];
#pragma unroll
            for (int j = 0; j < 8; ++j) { const int i = xsg * 16 + k8 * 8 + j; const float x0 = lo_bf(xr[k8 * 8 + j]), x1 = hi_bf(xr[k8 * 8 + j]);
                const float wf = SC[i] * __expf(lastf - SC[512 + i]), wb = SC[256 + i] * __expf(lastb - SC[768 + i]); f0[j] = x0 * wf; f1[j] = x1 * wf; b0[j] = x0 * wb; b1[j] = x1 * wb; }
            LAS unsigned char* xp = F.lds + SA_XW + (2 * xcp) * SS_PT + (xsg * 16 + k8 * 8) * 2;
            *(LAS u32x4*)xp = pack8(f0); *(LAS u32x4*)(xp + SS_PT) = pack8(f1); *(LAS u32x4*)(xp + 64 * SS_PT) = pack8(b0); *(LAS u32x4*)(xp + 65 * SS_PT) = pack8(b1);
        }
        if (F.tid == 0) { WSF(WS_SDEC)[(0 * 32 + h) * 65 + pf] = __expf(lastf); WSF(WS_SDEC)[(1 * 32 + h) * 65 + pb] = __expf(lastb); }
        __syncthreads();
        const int dir = F.wave >> 2, pt = (F.wave >> 1) & 1, nt0 = 2 * (F.wave & 1);
        f32x16 acc0, acc1;
#pragma unroll
        for (int i = 0; i < 16; ++i) { acc0[i] = 0.f; acc1[i] = 0.f; }
#pragma unroll 4
        for (int ks = 0; ks < 16; ++ks) {
            const bf16x8 b = *(const LAS bf16x8*)(F.lds + SA_XW + (dir * 64 + pt * 32 + r) * SS_PT + (ks * 16 + hf * 8) * 2);
            const bf16x8 a0 = *(const LAS bf16x8*)(F.lds + SA_BT + (nt0 * 32 + r) * SS_PT + (ks * 16 + hf * 8) * 2);
            const bf16x8 a1 = *(const LAS bf16x8*)(F.lds + SA_BT + ((nt0 + 1) * 32 + r) * SS_PT + (ks * 16 + hf * 8) * 2);
            acc0 = MFMA32(a0, b, acc0); acc1 = MFMA32(a1, b, acc1);
        }
        bf16_t* st = ssm_state(F, dir, h, dir ? pb : pf) + (size_t)(pt * 32 + r) * 128;
#pragma unroll
        for (int g4 = 0; g4 < 4; ++g4) { u32x2 w0, w1; w0.x = cvt_pk_bf16(acc0[4 * g4], acc0[4 * g4 + 1]); w0.y = cvt_pk_bf16(acc0[4 * g4 + 2], acc0[4 * g4 + 3]);
            w1.x = cvt_pk_bf16(acc1[4 * g4], acc1[4 * g4 + 1]); w1.y = cvt_pk_bf16(acc1[4 * g4 + 2], acc1[4 * g4 + 3]);
            *(u32x2*)(st + nt0 * 32 + 8 * g4 + 4 * hf) = w0; *(u32x2*)(st + (nt0 + 1) * 32 + 8 * g4 + 4 * hf) = w1; }
    }
}
__device__ __forceinline__ void phase_ssm_b(Frame& F) {
    for (int idx = F.bid * NTHR + F.tid; idx < 2 * 32 * 4096; idx += F.G * NTHR) {
        const int e2 = idx & 4095, hh = idx >> 12;
        unsigned* sp = (unsigned*)((bf16_t*)(F.ws + WS_ST) + (size_t)hh * 65 * 8192) + e2;
        const float* dp = WSF(WS_SDEC) + hh * 65;
        float s0 = 0.f, s1 = 0.f;
        for (int p = 0; p < 65; p += 5) {
            unsigned x[5]; float d[5];
#pragma unroll
            for (int j = 0; j < 5; ++j) { x[j] = sp[(size_t)(p + j) * 4096]; d[j] = dp[p + j]; }
#pragma unroll
            for (int j = 0; j < 5; ++j) { sp[(size_t)(p + j) * 4096] = cvt_pk_bf16(s0, s1); s0 = d[j] * s0 + lo_bf(x[j]); s1 = d[j] * s1 + hi_bf(x[j]); }
        }
    }
}
__device__ __forceinline__ void phase_ssm_c(Frame& F) {
    bf16_t* P = WSB(WS_P); LAS float* SC = (LAS float*)(F.lds + SC_SC);
    const int r = F.lane & 31, hf = F.lane >> 5, w = F.wave;
    for (int u = F.bid; u < 65 * 32; u += F.G) {
        const int ru = u >> 5, h = u & 31, g = h >> 3; int r0, pf, pb; run_geom(ru, r0, pf, pb);
        const int ti = 32 * w + r, trow = r0 + ti;
        bf16x8 cf[8];
#pragma unroll
        for (int ks = 0; ks < 8; ++ks) cf[ks] = *(const bf16x8*)(P + (size_t)trow * PLD + 4608 + g * 128 + ks * 16 + hf * 8);
        const int xcp = F.tid & 31, xsg = F.tid >> 5;
        unsigned xr[16];
        { const bf16_t* xp = P + (size_t)(r0 + xsg * 16) * PLD + 2048 + h * 64 + 2 * xcp;
#pragma unroll
          for (int i = 0; i < 16; ++i) xr[i] = *(const unsigned*)(xp + (size_t)i * PLD); }
        u32x4 bm[8];
#pragma unroll
        for (int k = 0; k < 8; ++k) { const int idx = F.tid + 512 * k, row = idx >> 4, c16 = idx & 15; bm[k] = *(const u32x4*)(P + (size_t)(r0 + row) * PLD + 4096 + g * 128 + c16 * 8); }
        __syncthreads();
        ssm_scalars(F, SC, r0, h);
#pragma unroll
        for (int k = 0; k < 8; ++k) { const int idx = F.tid + 512 * k, row = idx >> 4, c16 = idx & 15; *(LAS u32x4*)(F.lds + SC_BM + row * 272 + c16 * 16) = bm[k]; }
#pragma unroll
        for (int k8 = 0; k8 < 2; ++k8) {
            u32x4 lo, hi;
            lo.x = (xr[8 * k8] & 0xffffu) | (xr[8 * k8 + 1] << 16); lo.y = (xr[8 * k8 + 2] & 0xffffu) | (xr[8 * k8 + 3] << 16); lo.z = (xr[8 * k8 + 4] & 0xffffu) | (xr[8 * k8 + 5] << 16); lo.w = (xr[8 * k8 + 6] & 0xffffu) | (xr[8 * k8 + 7] << 16);
            hi.x = (xr[8 * k8] >> 16) | (xr[8 * k8 + 1] & 0xffff0000u); hi.y = (xr[8 * k8 + 2] >> 16) | (xr[8 * k8 + 3] & 0xffff0000u); hi.z = (xr[8 * k8 + 4] >> 16) | (xr[8 * k8 + 5] & 0xffff0000u); hi.w = (xr[8 * k8 + 6] >> 16) | (xr[8 * k8 + 7] & 0xffff0000u);
            LAS unsigned char* xp = F.lds + SC_XT + (2 * xcp) * SS_PT + (xsg * 16 + k8 * 8) * 2; *(LAS u32x4*)xp = lo; *(LAS u32x4*)(xp + SS_PT) = hi;
        }
        __syncthreads();
        const float cft = SC[512 + ti], cbt = SC[768 + ti];
        f32x16 y0, y1;
#pragma unroll
        for (int i = 0; i < 16; ++i) { y0[i] = 0.f; y1[i] = 0.f; }
#pragma unroll 1
        for (int sb = 0; sb < 8; ++sb) {
            f32x16 x;
#pragma unroll
            for (int i = 0; i < 16; ++i) x[i] = 0.f;
#pragma unroll
            for (int ks = 0; ks < 8; ++ks) { const bf16x8 a = *(const LAS bf16x8*)(F.lds + SC_BM + (sb * 32 + r) * 272 + (ks * 16 + hf * 8) * 2); x = MFMA32(a, cf[ks], x); }
#pragma unroll
            for (int g4 = 0; g4 < 4; ++g4) {
                const int sl = sb * 32 + 8 * g4 + 4 * hf;
                const f32x4 dtf = *(const LAS f32x4*)(SC + sl), dtb = *(const LAS f32x4*)(SC + 256 + sl), cfs = *(const LAS f32x4*)(SC + 512 + sl), cbs = *(const LAS f32x4*)(SC + 768 + sl);
#pragma unroll
                for (int j = 0; j < 4; ++j) { const int s_ = sl + j; float m = 0.f;
                    if (s_ <= ti) m += __expf(cft - cfs[j]) * dtf[j];
                    if (s_ >= ti) m += __expf(cbt - cbs[j]) * dtb[j];
                    x[4 * g4 + j] *= m; }
            }
#pragma unroll
            for (int s2 = 0; s2 < 2; ++s2) {
                u32x4 pw; pw.x = cvt_pk_bf16(x[8 * s2], x[8 * s2 + 1]); pw.y = cvt_pk_bf16(x[8 * s2 + 2], x[8 * s2 + 3]); pw.z = cvt_pk_bf16(x[8 * s2 + 4], x[8 * s2 + 5]); pw.w = cvt_pk_bf16(x[8 * s2 + 6], x[8 * s2 + 7]);
                const bf16x8 pb_ = __builtin_bit_cast(bf16x8, pw);
                const LAS unsigned char* a0p = F.lds + SC_XT + r * SS_PT + (sb * 32 + 16 * s2 + 4 * hf) * 2; const LAS unsigned char* a1p = a0p + 32 * SS_PT;
                const u32x2 a00 = *(const LAS u32x2*)a0p, a01 = *(const LAS u32x2*)(a0p + 16), a10 = *(const LAS u32x2*)a1p, a11 = *(const LAS u32x2*)(a1p + 16);
                u32x4 a0w, a1w; a0w.x = a00.x; a0w.y = a00.y; a0w.z = a01.x; a0w.w = a01.y; a1w.x = a10.x; a1w.y = a10.y; a1w.z = a11.x; a1w.w = a11.y;
                y0 = MFMA32(__builtin_bit_cast(bf16x8, a0w), pb_, y0); y1 = MFMA32(__builtin_bit_cast(bf16x8, a1w), pb_, y1);
            }
        }
#pragma unroll
        for (int dir = 0; dir < 2; ++dir) {
            const float e = __expf(dir ? cbt : cft);
            const bf16_t* sp = ssm_state(F, dir, h, dir ? pb : pf) + (size_t)r * 128 + hf * 8;
#pragma unroll
            for (int pt = 0; pt < 2; ++pt) {
                f32x16 yd;
#pragma unroll
                for (int i = 0; i < 16; ++i) yd[i] = 0.f;
#pragma unroll
                for (int kh = 0; kh < 2; ++kh) {
                    bf16x8 sa[4];
#pragma unroll
                    for (int ks = 0; ks < 4; ++ks) sa[ks] = *(const bf16x8*)(sp + (size_t)pt * 32 * 128 + (kh * 4 + ks) * 16);
#pragma unroll
                    for (int ks = 0; ks < 4; ++ks) yd = MFMA32(sa[ks], cf[kh * 4 + ks], yd);
                    asm volatile("" ::: "memory");
                }
                if (pt == 0) {
#pragma unroll
                    for (int i = 0; i < 16; ++i) y0[i] += e * yd[i];
                } else {
#pragma unroll
                    for (int i = 0; i < 16; ++i) y1[i] += e * yd[i];
                }
            }
        }
        const float Dk = F.in[19][h];
        bf16_t* zp = P + (size_t)trow * PLD + h * 64;
#pragma unroll
        for (int g4 = 0; g4 < 4; ++g4) {
            const int p0 = 8 * g4 + 4 * hf;
            const u32x2 z0 = *(const u32x2*)(zp + p0), z1 = *(const u32x2*)(zp + 32 + p0);
            float xa[4], xb[4];
#pragma unroll
            for (int j = 0; j < 4; ++j) { xa[j] = bf2f(*(const LAS unsigned short*)(F.lds + SC_XT + (p0 + j) * SS_PT + ti * 2)); xb[j] = bf2f(*(const LAS unsigned short*)(F.lds + SC_XT + (32 + p0 + j) * SS_PT + ti * 2)); }
            u32x2 o0, o1;
            o0.x = cvt_pk_bf16((y0[4 * g4] + Dk * xa[0]) * siluf_(lo_bf(z0.x)), (y0[4 * g4 + 1] + Dk * xa[1]) * siluf_(hi_bf(z0.x)));
            o0.y = cvt_pk_bf16((y0[4 * g4 + 2] + Dk * xa[2]) * siluf_(lo_bf(z0.y)), (y0[4 * g4 + 3] + Dk * xa[3]) * siluf_(hi_bf(z0.y)));
            o1.x = cvt_pk_bf16((y1[4 * g4] + Dk * xb[0]) * siluf_(lo_bf(z1.x)), (y1[4 * g4 + 1] + Dk * xb[1]) * siluf_(hi_bf(z1.x)));
            o1.y = cvt_pk_bf16((y1[4 * g4 + 2] + Dk * xb[2]) * siluf_(lo_bf(z1.y)), (y1[4 * g4 + 3] + Dk * xb[3]) * siluf_(hi_bf(z1.y)));
            *(u32x2*)(zp + p0) = o0; *(u32x2*)(zp + 32 + p0) = o1;
        }
    }
}
__device__ __forceinline__ void phase_ssm_d(Frame& F) {
    bf16_t* P = WSB(WS_P);
    const int gw = F.bid * NWAVES + F.wave, NGW = F.G * NWAVES;
    for (int it = gw; it < MALL * 4; it += NGW) {
        const int row = it >> 2, g = it & 3; const int c = g * 512 + F.lane * 8;
        const u32x4 yv = *(const u32x4*)(P + (size_t)row * PLD + c);
        float y[8] = {lo_bf(yv.x), hi_bf(yv.x), lo_bf(yv.y), hi_bf(yv.y), lo_bf(yv.z), hi_bf(yv.z), lo_bf(yv.w), hi_bf(yv.w)}; float ss = 0.f;
#pragma unroll
        for (int j = 0; j < 8; ++j) ss += y[j] * y[j];
        ss = wave_sum(ss); const float rn = rsqrtf(ss * (1.0f / 512.0f) + EPS);
        const f32x4 n0 = *(const f32x4*)(F.in[20] + c), n1 = *(const f32x4*)(F.in[20] + c + 4);
        u32x4 o; o.x = cvt_pk_bf16(y[0] * rn * n0[0], y[1] * rn * n0[1]); o.y = cvt_pk_bf16(y[2] * rn * n0[2], y[3] * rn * n0[3]); o.z = cvt_pk_bf16(y[4] * rn * n1[0], y[5] * rn * n1[1]); o.w = cvt_pk_bf16(y[6] * rn * n1[2], y[7] * rn * n1[3]);
        *(u32x4*)(P + (size_t)row * PLD + c) = o;
    }
}

template <int WIN> __device__ __forceinline__ void pool_unit(const bf16_t* XS, bf16_t* DL, const LAS float* rsd, int t0, int s0, int s1, int c) {
    constexpr int HB = WIN / 2, KLO = 8 - HB, KHI = 8 + 16 + HB - 1;
    unsigned raw[32];
#pragma unroll
    for (int k = KLO; k < KHI; ++k) { const int rr = t0 - 8 + k; const int rc = rr < s0 ? s0 : (rr >= s1 ? s1 - 1 : rr); raw[k] = *(const unsigned*)(XS + (size_t)rc * D + c); }
    float p0[33], p1[33], h0[32], h1[32];
    p0[KLO] = 0.f; p1[KLO] = 0.f;
#pragma unroll
    for (int k = KLO; k < KHI; ++k) { const float rr = rsd[k]; h0[k] = rr * lo_bf(raw[k]); h1[k] = rr * hi_bf(raw[k]); p0[k + 1] = p0[k] + h0[k]; p1[k + 1] = p1[k] + h1[k]; }
#pragma unroll
    for (int j = 0; j < 16; ++j) {
        const int t = t0 + j; int lo = t - HB, hi = t + WIN - HB; lo = lo < s0 ? s0 : lo; hi = hi > s1 ? s1 : hi;
        const float inv = 1.0f / (float)(hi - lo);
        const float a0 = (p0[8 + j + WIN - HB] - p0[8 + j - HB]) * inv - h0[8 + j], a1 = (p1[8 + j + WIN - HB] - p1[8 + j - HB]) * inv - h1[8 + j];
        *(unsigned*)(DL + (size_t)t * D + c) = cvt_pk_bf16(a0, a1);
    }
}
__device__ __forceinline__ void phase_pool_delta(Frame& F) {
    LAS float* rsd = (LAS float*)F.lds;
    const bf16_t* XS = WSB(WS_XSA); bf16_t* DL = WSB(WS_P);
    const int c = F.tid * 2, gi = F.tid >> 7;
    for (int u = F.bid; u < MALL / 16; u += F.G) {
        const int t0 = u * 16, s0 = (t0 >= NLAT) ? NLAT : 0, s1 = (t0 >= NLAT) ? MALL : NLAT;
        __syncthreads();
        if (F.tid < 32) { const int rr = t0 - 8 + F.tid; float v = 0.f;
            if (rr >= s0 && rr < s1) { const float* sp = WSF(WS_SLOTS) + (size_t)rr * 16; const f32x4 a = *(const f32x4*)sp, b_ = *(const f32x4*)(sp + 4), c_ = *(const f32x4*)(sp + 8), d = *(const f32x4*)(sp + 12);
                const float t = ((a[0] + a[1]) + (a[2] + a[3])) + ((b_[0] + b_[1]) + (b_[2] + b_[3])) + ((c_[0] + c_[1]) + (c_[2] + c_[3])) + ((d[0] + d[1]) + (d[2] + d[3]));
                v = rsqrtf(t * (1.0f / 1024.0f) + EPS); }
            rsd[F.tid] = v; }
        __syncthreads();
        if (gi == 0) pool_unit<2>(XS, DL, rsd, t0, s0, s1, c); else if (gi == 1) pool_unit<4>(XS, DL, rsd, t0, s0, s1, c);
        else if (gi == 2) pool_unit<8>(XS, DL, rsd, t0, s0, s1, c); else pool_unit<16>(XS, DL, rsd, t0, s0, s1, c);
    }
}
__device__ __forceinline__ void phase_final(Frame& F) {
    const int gw = F.bid * NWAVES + F.wave, NGW = F.G * NWAVES;
    for (int row = gw; row < NLAT; row += NGW) {
        float t = (F.lane < 16) ? WSF(WS_SLOTS)[(size_t)row * 16 + F.lane] : 0.f; t = wave_sum(t);
        const float r = rsqrtf(t * (1.0f / 1024.0f) + EPS);
        float* xr = F.out + (size_t)row * D;
#pragma unroll
        for (int j = 0; j < 4; ++j) { const int k = j * 256 + F.lane * 4; f32x4 x = *(const f32x4*)(xr + k); const f32x4 w = *(const f32x4*)(F.in[9] + k); *(f32x4*)(xr + k) = x * r * w; }
    }
}

enum { PH_P0A = 0, PH_P0B, PH_L0_G1, PH_L0_MA, PH_L0_MB, PH_L0_MC, PH_L0_G2, PH_L0_G3, PH_L0_G4,
       PH_L1_G1, PH_L1_CV, PH_L1_MA, PH_L1_MB, PH_L1_MC, PH_L1_MD, PH_L1_G2, PH_L1_G3, PH_L1_G4,
       PH_L2_DELTA, PH_L2_G2, PH_L2_G3, PH_L2_G4,
       PH_L3_G1, PH_L3_ATT, PH_L3_G2, PH_L3_G3, PH_L3_G4, PH_FINAL, NPHASE };
__global__ void __launch_bounds__(NTHR, 2) fwd_kernel(Args args) {
    extern __shared__ __attribute__((aligned(16))) unsigned char lds_raw[];
    Frame F; F.lds = (LAS unsigned char*)lds_raw; F.tid = threadIdx.x; F.lane = F.tid & 63; F.wave = __builtin_amdgcn_readfirstlane(F.tid >> 6);
    F.G = gridDim.x; F.bid = blockIdx.x; F.in = args.in; F.out = args.out; F.ws = args.ws;
    volatile LAS unsigned* MISC = (volatile LAS unsigned*)(F.lds + MISC_OFF);
    for (int u = F.tid; u < 128; u += NTHR) ((LAS unsigned*)(F.lds + MISC_OFF))[u] = 0u;
    __syncthreads();
    const int lo = args.ph_lo, hi = args.ph_hi;
#if MK_ONE_LAUNCH
    XcdBarrier bar = xcd_barrier_post((unsigned*)(F.ws + WS_CTL), MISC + 8);
    bool first_sync = true;
#define SEAM() do { if (first_sync) { cg::this_grid().sync(); first_sync = false; } else xcd_barrier(bar); } while (0)
#else
    (void)MISC;
#define SEAM() do { } while (0)
#endif
#define IN(k) (lo <= (k) && (k) < hi)
#ifndef PHASE_MASK
#define PHASE_MASK 0xFFFFFFFFull
#endif
#ifndef DUP_MASK
#define DUP_MASK 0ull
#endif
#define PH(k, ...) do { if constexpr (((PHASE_MASK) >> (k)) & 1ull) { if (IN(k)) { __VA_ARGS__; if constexpr (((DUP_MASK) >> (k)) & 1ull) { __syncthreads(); __VA_ARGS__; } if (IN((k) + 1)) SEAM(); } } } while (0)
#define PH_EMPTY(k) do { } while (0)
    LAS unsigned char* ring = F.lds;
    const int c_ = F.bid;
#define RUN_G1(k, epi, Wt, nN) PH(k, { Gemm g{WSB(WS_XSA), Wt, D, D, D, 0}; StaticOrder S; S.init(65, nN, F.G, c_); pg8::gemm_phase(ring, g, S, epi); })
#define RUN_G2(k, layer, Aptr, lda_, K_, Wt_, apn_, ldb_, nMr_, blat_, bctx_, xsout_) PH(k, { \
        EpiResid e{blat_, bctx_, F.out, WSF(WS_XCTX), WSF(WS_GATE) + ((size_t)(layer) * 2 + 0) * 2 * 1024, WSF(WS_CS) + ((size_t)(layer) * 2 + 1) * 2 * 1024, xsout_, WSF(WS_SLOTS)}; \
        Gemm g{Aptr, Wt_, lda_, ldb_, K_, apn_}; StaticOrder S; S.init(nMr_, 4, F.G, c_); pg8::gemm_phase(ring, g, S, e); })
#define RUN_G3(k, layer, nMr_, xsin_) PH(k, { \
        EpiG1<3> e{WSF(WS_SLOTS), WSF(WS_BIAS3) + (size_t)(layer) * 2 * FH2, FH2, WSB(WS_P), nullptr, nullptr}; \
        Gemm g{xsin_, WSB(WS_W_FFNIN) + (size_t)(layer) * FH2 * D, D, D, D, 0}; StaticOrder S; S.init(nMr_, FH2 / 256, F.G, c_); pg8::gemm_phase(ring, g, S, e); })
#define RUN_G4(k, layer, nMr_) PH(k, { \
        EpiResid e{F.out, WSF(WS_XCTX), F.out, WSF(WS_XCTX), WSF(WS_GATE) + ((size_t)(layer) * 2 + 1) * 2 * 1024, ((layer) < 3) ? WSF(WS_CS) + ((size_t)((layer) + 1) * 2 + 0) * 2 * 1024 : (const float*)nullptr, WSB(WS_XSA), WSF(WS_SLOTS)}; \
        Gemm g{WSB(WS_P), WSB(WS_W_FFNOUT) + (size_t)(layer) * D * FH, FH, FH, FH, 0}; StaticOrder S; S.init(nMr_, 4, F.G, c_); pg8::gemm_phase(ring, g, S, e); })

    PH(PH_P0A, phase_p0a(F));
    PH(PH_P0B, phase_p0b(F));
    { EpiG1<0> e{WSF(WS_SLOTS), WSF(WS_BIAS1), FH2, WSB(WS_P), nullptr, nullptr}; RUN_G1(PH_L0_G1, e, WSB(WS_W_HGIN), HG_N / 256); }
#if !NAIVE_HG
    PH(PH_L0_MA, phase_hg_a(F));
    PH(PH_L0_MB, phase_hg_b(F));
    PH(PH_L0_MC, phase_hg_c(F));
#endif
    RUN_G2(PH_L0_G2, 0, WSB(WS_XSA), D, D, WSB(WS_W_HGOUT), 0, D, 65, F.in[0], F.in[2], WSB(WS_XSB));
    RUN_G3(PH_L0_G3, 0, 65, WSB(WS_XSB));
    RUN_G4(PH_L0_G4, 0, 65);
    { EpiG1<1> e{WSF(WS_SLOTS), WSF(WS_BIAS1) + (size_t)1 * 2 * FH2, FH2, WSB(WS_P), WSF(WS_DT), WSB(WS_HALO)}; RUN_G1(PH_L1_G1, e, WSB(WS_W_SSMIN), SSM_NP / 256); }
#if !NAIVE_SSM
    PH(PH_L1_CV, phase_ssm_conv(F));
    PH(PH_L1_MA, phase_ssm_a(F));
    PH(PH_L1_MB, phase_ssm_b(F));
    PH(PH_L1_MC, phase_ssm_c(F));
    PH(PH_L1_MD, phase_ssm_d(F));
#endif
    RUN_G2(PH_L1_G2, 1, WSB(WS_P), PLD, SSM_DI, WSB(WS_W_SSMOUT), 0, SSM_DI, 65, F.out, WSF(WS_XCTX), WSB(WS_XSA));
    RUN_G3(PH_L1_G3, 1, 65, WSB(WS_XSA));
    RUN_G4(PH_L1_G4, 1, 65);
    PH(PH_L2_DELTA, phase_pool_delta(F));
    RUN_G2(PH_L2_G2, 2, WSB(WS_P), D, 256, WSB(WS_W_POOL), 256, 256, 65, F.out, WSF(WS_XCTX), WSB(WS_XSB));
    RUN_G3(PH_L2_G3, 2, 65, WSB(WS_XSB));
    RUN_G4(PH_L2_G4, 2, 65);
    { EpiQKV e{WSF(WS_SLOTS), WSF(WS_BIAS1) + (size_t)3 * 2 * FH2, FH2, WSB(WS_P), WSF(WS_ROPE)}; RUN_G1(PH_L3_G1, e, WSB(WS_W_QKV), ATT_N / 256); }
#if !NAIVE_ATT
    PH(PH_L3_ATT, phase_att(F));
#endif
    RUN_G2(PH_L3_G2, 3, WSB(WS_XSA), D, D, WSB(WS_W_ATTOUT), 0, D, 64, F.out, WSF(WS_XCTX), WSB(WS_XSB));
    RUN_G3(PH_L3_G3, 3, 64, WSB(WS_XSB));
    RUN_G4(PH_L3_G4, 3, 64);
    PH(PH_FINAL, phase_final(F));
#undef IN
#undef PH
#undef SEAM
}

extern "C" void kernel_launch(void* const* d_in, const int* in_sizes, int n_in, void* d_out, int out_size, void* d_ws, size_t ws_size, hipStream_t stream) {
    static int grid = 0;
    if (grid == 0) {
        if (n_in != 27 || out_size != NLAT * D || ws_size < WS_END) { fprintf(stderr, "kernel_launch: unexpected shapes (n_in %d out %d ws %zu need %zu)\n", n_in, out_size, ws_size, (size_t)WS_END); grid = -1; return; }
        int dev = 0, cus = 0, per_cu = 0;
        hipGetDevice(&dev); hipDeviceGetAttribute(&cus, hipDeviceAttributeMultiprocessorCount, dev);
        if (hipFuncSetAttribute((const void*)fwd_kernel, hipFuncAttributeMaxDynamicSharedMemorySize, LDS_BYTES) != hipSuccess) { fprintf(stderr, "hipFuncSetAttribute failed\n"); grid = -1; return; }
        hipOccupancyMaxActiveBlocksPerMultiprocessor(&per_cu, (const void*)fwd_kernel, NTHR, LDS_BYTES);
        (void)hipGetLastError();
        if (per_cu < 1) { fprintf(stderr, "occupancy query says %d\n", per_cu); grid = -1; return; }
        grid = cus;
    }
    if (grid < 0) return;
    hipMemsetAsync((char*)d_ws + WS_CTL, 0, CTL_BYTES, stream);
    Args a{};
    for (int i = 0; i < 27; ++i) a.in[i] = (const float*)d_in[i];
    a.out = (float*)d_out; a.ws = (unsigned char*)d_ws;
#if MK_ONE_LAUNCH
    a.ph_lo = 0; a.ph_hi = NPHASE;
    void* kargs[] = {&a};
    hipError_t e = hipLaunchCooperativeKernel((const void*)fwd_kernel, dim3(grid), dim3(NTHR), kargs, LDS_BYTES, stream);
    if (e != hipSuccess) fprintf(stderr, "cooperative launch failed: %s\n", hipGetErrorString(e));
#else
    NArgs na{}; for (int i = 0; i < 27; ++i) na.in[i] = (const float*)d_in[i]; na.ws = (unsigned char*)d_ws;
    for (int p = 0; p < NPHASE; ++p) {
        if (p == PH_L0_MA && NAIVE_HG) { hipLaunchKernelGGL(naive_hg_scan_k, dim3(16), dim3(128), 0, stream, na); continue; }
        if (p == PH_L0_MC && NAIVE_HG) { hipLaunchKernelGGL(naive_hg_readout_k, dim3(1024), dim3(256), 0, stream, na); continue; }
        if (p == PH_L1_MA && NAIVE_SSM) { hipLaunchKernelGGL(naive_ssm_scan_k, dim3(32), dim3(384), 0, stream, na); continue; }
        if (p == PH_L1_MC && NAIVE_SSM) { hipLaunchKernelGGL(naive_ssm_readout_k, dim3(1024), dim3(256), 0, stream, na); continue; }
        if (p == PH_L3_ATT && NAIVE_ATT) { hipLaunchKernelGGL(naive_attention_k, dim3(1024), dim3(256), 0, stream, na); continue; }
        if ((p == PH_L0_MB && NAIVE_HG) || ((p == PH_L1_MB || p == PH_L1_MD || p == PH_L1_CV) && NAIVE_SSM)) continue;
        a.ph_lo = p; a.ph_hi = p + 1; hipLaunchKernelGGL(fwd_kernel, dim3(grid), dim3(NTHR), LDS_BYTES, stream, a);
    }
#endif
}
```

```cpp
#include <hip/hip_runtime.h>
#include <hip/hip_cooperative_groups.h>
#include <cstdio>
#include <cstdint>
namespace cg = cooperative_groups;

#ifndef MK_ONE_LAUNCH
#define MK_ONE_LAUNCH 1
#endif

#define LAS __attribute__((address_space(3)))
typedef unsigned short bf16_t;
typedef short bf16x8 __attribute__((ext_vector_type(8)));
typedef float f32x4 __attribute__((ext_vector_type(4)));
typedef float f32x2 __attribute__((ext_vector_type(2)));
typedef unsigned u32x4 __attribute__((ext_vector_type(4)));
typedef unsigned u32x2 __attribute__((ext_vector_type(2)));
typedef float f32x16 __attribute__((ext_vector_type(16)));
#define MFMA32(a, b, c) __builtin_amdgcn_mfma_f32_32x32x16_bf16((a), (b), (c), 0, 0, 0)

constexpr int D = 1024, NLAT = 16384, NCTX = 256, MALL = NLAT + NCTX, DEPTH = 4;
constexpr int FH = 2816, FH2 = 5632;
constexpr int HG_N = 5120;
constexpr int SSM_N = 5184, SSM_NP = 5376;
constexpr int SSM_DI = 2048, SSM_CD = 3072;
constexpr int ATT_N = 1536, QK_LD = 1536;
constexpr int PLD = 5120;
constexpr float EPS = 1e-6f;
constexpr int NWAVES = 8, NTHR = 512;
constexpr int LDS_BYTES = 147456, MISC_OFF = LDS_BYTES - 512;

constexpr size_t al256(size_t x) { return (x + 255) & ~(size_t)255; }
constexpr size_t WS_CTL = 0, CTL_BYTES = 131072;
constexpr size_t WS_MODS = WS_CTL + CTL_BYTES;
constexpr size_t WS_CS = WS_MODS + (size_t)4 * 2 * 6144 * 4;
constexpr size_t WS_GATE = WS_CS + (size_t)4 * 2 * 2 * 1024 * 4;
constexpr size_t WS_BIAS1 = WS_GATE + (size_t)4 * 2 * 2 * 1024 * 4;
constexpr size_t WS_BIAS3 = WS_BIAS1 + (size_t)4 * 2 * FH2 * 4;
constexpr size_t WS_LB = WS_BIAS3 + (size_t)4 * 2 * FH2 * 4;
constexpr size_t WS_ROPE = WS_LB + 2 * 1024 * 4;
constexpr size_t WS_SLOTS = WS_ROPE + 2 * 256 * 16 * 4;
constexpr size_t WS_XCTX = WS_SLOTS + (size_t)MALL * 16 * 4;
constexpr size_t WS_DT = WS_XCTX + (size_t)NCTX * D * 4;
constexpr size_t WS_W_HGIN = al256(WS_DT + (size_t)MALL * 64 * 4);
constexpr size_t WS_W_HGOUT = WS_W_HGIN + (size_t)HG_N * D * 2;
constexpr size_t WS_W_SSMIN = WS_W_HGOUT + (size_t)D * D * 2;
constexpr size_t WS_W_SSMOUT = WS_W_SSMIN + (size_t)SSM_NP * D * 2;
constexpr size_t WS_W_POOL = WS_W_SSMOUT + (size_t)D * SSM_DI * 2;
constexpr size_t WS_W_QKV = WS_W_POOL + (size_t)4 * 256 * 256 * 2;
constexpr size_t WS_W_ATTOUT = WS_W_QKV + (size_t)ATT_N * D * 2;
constexpr size_t WS_W_FFNIN = WS_W_ATTOUT + (size_t)D * D * 2;
constexpr size_t WS_W_FFNOUT = WS_W_FFNIN + (size_t)4 * FH2 * D * 2;
constexpr size_t WS_XSA = WS_W_FFNOUT + (size_t)4 * D * FH * 2;
constexpr size_t WS_P = WS_XSA + (size_t)MALL * D * 2;
constexpr size_t P_BYTES = (size_t)MALL * PLD * 2;
constexpr size_t WS_XSB = WS_P + (size_t)96 * 1024 * 1024;
constexpr size_t WS_ST = WS_P + P_BYTES;
constexpr size_t ST_BYTES = (size_t)2 * 5 * 260 * 128 * 128 * 2;
constexpr size_t WS_HALO = WS_ST + (size_t)72 * 1024 * 1024;
constexpr size_t WS_SSQ = WS_ST + (size_t)79 * 1024 * 1024;
constexpr size_t WS_END = WS_ST + ST_BYTES;
static_assert(WS_HALO + (size_t)260 * 4 * 3072 * 2 <= WS_SSQ && WS_SSQ + (size_t)MALL * 32 * 4 <= WS_END && (size_t)2 * 32 * 65 * 8192 * 2 <= (size_t)72 * 1024 * 1024, "halo buffer");
static_assert(WS_END <= (size_t)402653184, "workspace map exceeds 4 x largest input");
static_assert((size_t)MALL * FH * 2 <= (size_t)96 * 1024 * 1024 && WS_XSB + (size_t)NLAT * D * 4 <= WS_ST, "H / XS_B / final f32 X overlay inside P");

__device__ __forceinline__ float bf2f(bf16_t b) { return __uint_as_float(((unsigned)b) << 16); }
__device__ __forceinline__ unsigned f2bf(float f) { unsigned u = __float_as_uint(f); return (u + 0x7fffu + ((u >> 16) & 1u)) >> 16; }
__device__ __forceinline__ unsigned pk2(float lo, float hi) { return f2bf(lo) | (f2bf(hi) << 16); }
typedef __bf16 bf16v2_t __attribute__((ext_vector_type(2)));
__device__ __forceinline__ unsigned cvt_pk_bf16(float lo, float hi) { const f32x2 f = {lo, hi}; return __builtin_bit_cast(unsigned, __builtin_convertvector(f, bf16v2_t)); }
__device__ __forceinline__ float sigmoidf_(float x) { return __builtin_amdgcn_rcpf(1.0f + __expf(-x)); }
__device__ __forceinline__ float siluf_(float x) { return x * sigmoidf_(x); }
__device__ __forceinline__ float lo_bf(unsigned w) { return __uint_as_float(w << 16); }
__device__ __forceinline__ float hi_bf(unsigned w) { return __uint_as_float(w & 0xffff0000u); }
__device__ __forceinline__ float wave_sum(float v) {
#pragma unroll
    for (int o = 1; o < 64; o <<= 1) v += __shfl_xor(v, o);
    return v;
}

#define XB_TMO      128
#define XB_XCNT(j)  (256  + 64 * (j))
#define XB_XSUB(j)  (1280 + 64 * (j))
#define XB_XGEN(j)  (2304 + 64 * (j))
#define XB_TOP      3328
#define XB_TOPGEN   3392
#define XCD_BAR_WORDS 3456
#define XB_SPIN_CAP (1u << 22)
__device__ __forceinline__ unsigned xb_ld(unsigned* p)              { return __hip_atomic_load(p, __ATOMIC_RELAXED, __HIP_MEMORY_SCOPE_AGENT); }
__device__ __forceinline__ unsigned xb_add(unsigned* p, unsigned v) { return __hip_atomic_fetch_add(p, v, __ATOMIC_RELAXED, __HIP_MEMORY_SCOPE_AGENT); }
__device__ __forceinline__ unsigned xb_xcc_id() { return (unsigned)__builtin_amdgcn_s_getreg((3 << 11) | 20) & 0xFu; }
#define XB_SPIN(cond, bar) do { unsigned _sp = 0; while (cond) { __builtin_amdgcn_s_sleep(1); \
    if ((++_sp & 255u) == 0u) { if (xb_ld(&(bar)[XB_TMO])) break; if (_sp > XB_SPIN_CAP) { atomicAdd(&(bar)[XB_TMO], 1u); break; } } } } while (0)
struct XcdBarrier { unsigned* bar; unsigned x; volatile LAS unsigned* st; };
__device__ __forceinline__ XcdBarrier xcd_barrier_post(unsigned* bar, volatile LAS unsigned* st) {
    XcdBarrier b; b.bar = bar; b.x = xb_xcc_id(); b.st = st;
    if (threadIdx.x == 0) (void)xb_add(&bar[XB_XCNT(b.x)], 1u);
    return b;
}
__device__ __forceinline__ void xcd_barrier_complete(unsigned* bar, unsigned x, unsigned& nloc, unsigned& nx) {
    const unsigned G = gridDim.x * gridDim.y * gridDim.z;
    unsigned sum, cnt, mine, sp = 0u;
    for (;;) {
        sum = 0u; cnt = 0u; mine = 0u;
#pragma unroll
        for (unsigned j = 0; j < 16; ++j) { const unsigned c = xb_ld(&bar[XB_XCNT(j)]); sum += c; cnt += (c > 0u) ? 1u : 0u; mine = (j == x) ? c : mine; }
        if (sum == G) break;
        __builtin_amdgcn_s_sleep(1);
        if ((++sp & 255u) == 0u) { if (xb_ld(&bar[XB_TMO])) break; if (sp > XB_SPIN_CAP) { atomicAdd(&bar[XB_TMO], 1u); break; } }
    }
    nloc = mine > 0u ? mine : 1u; nx = cnt > 0u ? cnt : 1u;
}
__device__ __forceinline__ void xcd_barrier(const XcdBarrier& b) {
    asm volatile("s_waitcnt vmcnt(0)" ::: "memory");
    __syncthreads();
    if (threadIdx.x == 0) {
        unsigned* bar = b.bar;
        __builtin_amdgcn_s_waitcnt(0);
        unsigned nloc = b.st[0], nx = b.st[1];
        if (nloc == 0u) { xcd_barrier_complete(bar, b.x, nloc, nx); b.st[0] = nloc; b.st[1] = nx; }
        const unsigned old = xb_add(&bar[XB_XSUB(b.x)], 1u);
        const unsigned gen = old / nloc;
        if (old + 1u == (gen + 1u) * nloc) {
            __builtin_amdgcn_fence(__ATOMIC_RELEASE, "agent");
            asm volatile("s_waitcnt vmcnt(0)" ::: "memory");
            const unsigned og = xb_add(&bar[XB_TOP], 1u);
            const unsigned tg = og / nx;
            if (og + 1u == (tg + 1u) * nx) xb_add(&bar[XB_TOPGEN], 1u);
            else XB_SPIN(xb_ld(&bar[XB_TOPGEN]) == tg, bar);
            __builtin_amdgcn_fence(__ATOMIC_ACQUIRE, "agent");
            xb_add(&bar[XB_XGEN(b.x)], 1u);
            asm volatile("s_waitcnt vmcnt(0)" ::: "memory");
        } else {
            XB_SPIN(xb_ld(&bar[XB_XGEN(b.x)]) == gen, bar);
            __builtin_amdgcn_fence(__ATOMIC_ACQUIRE, "agent");
            asm volatile("s_waitcnt vmcnt(0)" ::: "memory");
        }
    }
    __syncthreads();
}

#ifndef PA_I
#define PA_I -1
#define PA_J -1
#endif
#ifndef PA_FINE
#define PA_FINE 1.0f
#endif
#ifndef PB_I
#define PB_I -1
#define PB_J -1
#endif
__device__ unsigned long long g_ts[96];
#define STAMPX(i) do { if ((PA_I >= 0 || PB_I >= 0) && blockIdx.x == 0 && threadIdx.x == 0) g_ts[(i)] = __builtin_amdgcn_s_memrealtime(); } while (0)
namespace pg8 {
constexpr int BM = 256, BK = 64, HALF = 128, HTB = HALF * BK * 2, STAGE_BYTES = 8 * HTB, NXCD = 8, WGM = 8;
__host__ __device__ __forceinline__ int lds_byte(int r, int c) { const int st = (r >> 4) * 2 + (c >> 5), rr = r & 15, cc = c & 31, ob = rr * 64 + cc * 2; return st * 1024 + (ob ^ (((ob >> 9) & 1) << 5)); }
__host__ __device__ __forceinline__ void stage_rc(int b, int& R, int& C) { const int st = b / 1024, sb = b % 1024, swz = sb ^ (((sb >> 9) & 1) << 5); R = (st >> 1) * 16 + swz / 64; C = (st & 1) * 32 + (swz % 64) / 2; }
__host__ __device__ __forceinline__ int perm32(int rho) { const int n = rho >> 4, i = rho & 15; return 8 * (i >> 2) + 4 * n + (i & 3); }
struct Unit { int pm, pn; };
struct Gemm { const bf16_t* A; const bf16_t* Bt; int lda, ldb, K, a_pn_step; int stamp = 0; };
struct StaticOrder {
    int nM, nN, nwg, G, c;
    __device__ __forceinline__ void init(int nM_, int nN_, int G_, int c_) { nM = nM_; nN = nN_; nwg = nM * nN; G = G_; c = c_; }
    __device__ __forceinline__ bool next(int i, Unit& u) const {
        const long L = (long)i * G + c; if (L >= nwg) return false;
        int wgid = (int)L; { const int q = nwg / NXCD, r = nwg % NXCD, xcd = wgid % NXCD, off = wgid / NXCD; wgid = (xcd < r ? xcd * (q + 1) : r * (q + 1) + (xcd - r) * q) + off; }
        const int nig = WGM * nN, gid = wgid / nig, fm = gid * WGM, gsz = (nM - fm) < WGM ? (nM - fm) : WGM;
        u.pm = fm + ((wgid % nig) % gsz); u.pn = (wgid % nig) / gsz; return true;
    }
};

template <class Epi, bool ALIGN_EPI = true, bool SP2 = true>
__device__ __forceinline__ void gemm_phase(LAS unsigned char* lds, const Gemm g, const StaticOrder& S, const Epi& E) {
    const int tid = threadIdx.x, wid = __builtin_amdgcn_readfirstlane(tid >> 6), lane = tid & 63, wr = wid >> 2, wc = wid & 3, fr = lane & 15, fq = lane >> 4;
    const int nt = g.K / BK;
    unsigned voffA[2], voffB[2];
#pragma unroll
    for (int i = 0; i < 2; ++i) { int R, C; stage_rc(tid * 16 + i * 8192, R, C); const int Rb = Epi::PERM ? ((R & ~31) + perm32(R & 31)) : R;
        voffA[i] = (unsigned)(R * g.lda + C) * 2u; voffB[i] = (unsigned)(Rb * g.ldb + C) * 2u; }
    const size_t kstep = (size_t)(BK * 2);
    const size_t hstepA = (size_t)HALF * g.lda * 2, hstepB = (size_t)HALF * g.ldb * 2;
    const unsigned ldsw = (unsigned)wid * 1024u;
    const int aoff = lds_byte(wr * 64 + fr, fq * 8), boff = lds_byte(wc * 32 + fr, fq * 8);
#define PG8_SA(b, h) (((b) * 2 + (h)) * HTB)
#define PG8_SB(b, h) ((4 + (b) * 2 + (h)) * HTB)
#define PG8_STAGE(bufoff, gbase, voff) do { _Pragma("unroll") for (int _i = 0; _i < 2; ++_i) \
        __builtin_amdgcn_global_load_lds((const unsigned*)((const char*)(gbase) + (voff)[_i]), (LAS unsigned*)(lds + (bufoff) + ldsw + _i * 8192), 16, 0, 0); } while (0)
#define PG8_LDA(dst, b, h) do { _Pragma("unroll") for (int m = 0; m < 4; ++m) _Pragma("unroll") for (int k = 0; k < 2; ++k) dst[m][k] = *(const LAS bf16x8*)(lds + PG8_SA(b, h) + aoff + m * 2048 + k * 1024); } while (0)
#define PG8_LDB(dst, b, h) do { _Pragma("unroll") for (int n = 0; n < 2; ++n) _Pragma("unroll") for (int k = 0; k < 2; ++k) dst[n][k] = *(const LAS bf16x8*)(lds + PG8_SB(b, h) + boff + n * 2048 + k * 1024); } while (0)
#define PG8_MMA(ai, bj, At, Bt) do { __builtin_amdgcn_s_setprio(1); _Pragma("unroll") for (int m = 0; m < 4; ++m) _Pragma("unroll") for (int n = 0; n < 2; ++n) _Pragma("unroll") for (int k = 0; k < 2; ++k) \
        acc[ai][bj][m][n] = __builtin_amdgcn_mfma_f32_16x16x32_bf16(Bt[n][k], At[m][k], acc[ai][bj][m][n], 0, 0, 0); __builtin_amdgcn_s_setprio(0); } while (0)
#define PG8_WAIT_V(n) asm volatile("s_waitcnt vmcnt(" #n ")" ::: "memory")
#define PG8_WAIT_L(n) asm volatile("s_waitcnt lgkmcnt(" #n ")" ::: "memory")
#define PG8_BAR __builtin_amdgcn_s_barrier()
#define PG8_SCHED __builtin_amdgcn_sched_barrier(0)
    Unit cur, nxt; int ui = 0;
    if (!S.next(0, cur)) return;
    f32x4 acc[2][2][4][2];
#pragma unroll
    for (int a = 0; a < 2; ++a)
#pragma unroll
        for (int b = 0; b < 2; ++b)
#pragma unroll
            for (int m = 0; m < 4; ++m)
#pragma unroll
                for (int n = 0; n < 2; ++n) acc[a][b][m][n] = (f32x4){0.f, 0.f, 0.f, 0.f};
    bf16x8 At[4][2], B0[2][2], B1[2][2];
    const char* cA = (const char*)g.A + ((size_t)cur.pm * BM * g.lda + (size_t)cur.pn * g.a_pn_step) * 2; const char* cB = (const char*)g.Bt + (size_t)cur.pn * BM * g.ldb * 2;
    if constexpr (SP2) {
        PG8_STAGE(PG8_SB(0, 0), cB, voffB); PG8_STAGE(PG8_SB(0, 1), cB + hstepB, voffB); PG8_STAGE(PG8_SA(0, 0), cA, voffA); PG8_STAGE(PG8_SA(0, 1), cA + hstepA, voffA);
        if (wr == 1) PG8_BAR;
        PG8_WAIT_V(2); PG8_BAR;
        PG8_STAGE(PG8_SB(1, 0), cB + kstep, voffB); PG8_STAGE(PG8_SA(1, 0), cA + kstep, voffA); PG8_STAGE(PG8_SB(1, 1), cB + hstepB + kstep, voffB);
        PG8_WAIT_V(6); PG8_BAR;
    } else {
        PG8_STAGE(PG8_SB(0, 0), cB, voffB); PG8_STAGE(PG8_SA(0, 0), cA, voffA); PG8_STAGE(PG8_SB(0, 1), cB + hstepB, voffB); PG8_STAGE(PG8_SA(0, 1), cA + hstepA, voffA);
        if (wr == 1) PG8_BAR;
        PG8_WAIT_V(4); PG8_BAR;
        PG8_STAGE(PG8_SB(1, 0), cB + kstep, voffB); PG8_STAGE(PG8_SA(1, 0), cA + kstep, voffA); PG8_STAGE(PG8_SB(1, 1), cB + hstepB + kstep, voffB);
        PG8_WAIT_V(6); PG8_BAR;
    }
    for (;;) {
        const bool has_next = S.next(ui + 1, nxt);
        const char* nA = has_next ? (const char*)g.A + ((size_t)nxt.pm * BM * g.lda + (size_t)nxt.pn * g.a_pn_step) * 2 : cA; const char* nB = has_next ? (const char*)g.Bt + (size_t)nxt.pn * BM * g.ldb * 2 : cB;
        for (int t = 0; t < nt; t += 2) {
            if constexpr (Epi::KSCALE) { if (t != 0 && (t & 7) == 0) E.kscale(acc, t >> 3, wr, fr, lds); }
            const bool last = (t == nt - 2);
            const char* a1 = cA + (size_t)(t + 1) * kstep;
            const char* a2 = last ? nA : cA + (size_t)(t + 2) * kstep; const char* b2 = last ? nB : cB + (size_t)(t + 2) * kstep;
            const char* a3 = a2 + kstep; const char* b3 = b2 + kstep;
            if constexpr (SP2) {
            PG8_LDB(B0, 0, 0); PG8_LDB(B1, 0, 1); PG8_SCHED; PG8_LDA(At, 0, 0); PG8_STAGE(PG8_SA(1, 1), a1 + hstepA, voffA);
            PG8_WAIT_V(8); PG8_WAIT_L(0); PG8_BAR; PG8_MMA(0, 0, At, B0); PG8_MMA(0, 1, At, B1); PG8_BAR; PG8_SCHED;
            PG8_LDA(At, 0, 1); PG8_STAGE(PG8_SB(0, 0), b2, voffB); PG8_STAGE(PG8_SB(0, 1), b2 + hstepB, voffB); PG8_STAGE(PG8_SA(0, 0), a2, voffA);
            PG8_WAIT_V(8); PG8_WAIT_L(0); PG8_BAR; PG8_MMA(1, 0, At, B0); PG8_MMA(1, 1, At, B1); PG8_BAR; PG8_SCHED;
            PG8_LDB(B0, 1, 0); PG8_LDB(B1, 1, 1); PG8_SCHED; PG8_LDA(At, 1, 0); PG8_STAGE(PG8_SA(0, 1), a2 + hstepA, voffA);
            PG8_WAIT_V(8); PG8_WAIT_L(0); PG8_BAR; PG8_MMA(0, 0, At, B0); PG8_MMA(0, 1, At, B1); PG8_BAR; PG8_SCHED;
            PG8_LDA(At, 1, 1); PG8_STAGE(PG8_SB(1, 0), b3, voffB); PG8_STAGE(PG8_SB(1, 1), b3 + hstepB, voffB); PG8_STAGE(PG8_SA(1, 0), a3, voffA);
            PG8_WAIT_V(8); PG8_WAIT_L(0); PG8_BAR; PG8_MMA(1, 0, At, B0); PG8_MMA(1, 1, At, B1); PG8_BAR; PG8_SCHED;
            } else {
            PG8_LDB(B0, 0, 0); PG8_SCHED; PG8_LDA(At, 0, 0); PG8_STAGE(PG8_SA(1, 1), a1 + hstepA, voffA);
            PG8_WAIT_L(8); PG8_BAR; PG8_WAIT_L(0); PG8_MMA(0, 0, At, B0); PG8_BAR; PG8_SCHED;
            PG8_LDB(B1, 0, 1); PG8_STAGE(PG8_SB(0, 0), b2, voffB);
            PG8_BAR; PG8_WAIT_L(0); PG8_MMA(0, 1, At, B1); PG8_BAR;
            PG8_LDA(At, 0, 1); PG8_STAGE(PG8_SA(0, 0), a2, voffA);
            PG8_BAR; PG8_WAIT_L(0); PG8_MMA(1, 0, At, B0); PG8_BAR; PG8_SCHED;
            PG8_STAGE(PG8_SB(0, 1), b2 + hstepB, voffB);
            PG8_WAIT_V(6); PG8_BAR; PG8_MMA(1, 1, At, B1); PG8_BAR;
            PG8_LDB(B0, 1, 0); PG8_SCHED; PG8_LDA(At, 1, 0); PG8_STAGE(PG8_SA(0, 1), a2 + hstepA, voffA);
            PG8_WAIT_L(8); PG8_BAR; PG8_WAIT_L(0); PG8_MMA(0, 0, At, B0); PG8_BAR; PG8_SCHED;
            PG8_LDB(B1, 1, 1); PG8_STAGE(PG8_SB(1, 0), b3, voffB);
            PG8_BAR; PG8_WAIT_L(0); PG8_MMA(0, 1, At, B1); PG8_BAR;
            PG8_LDA(At, 1, 1); PG8_STAGE(PG8_SA(1, 0), a3, voffA);
            PG8_BAR; PG8_WAIT_L(0); PG8_MMA(1, 0, At, B0); PG8_BAR; PG8_SCHED;
            PG8_STAGE(PG8_SB(1, 1), b3 + hstepB, voffB);
            PG8_WAIT_V(6); PG8_BAR; PG8_MMA(1, 1, At, B1); PG8_BAR;
            }
        }
        if (ui == 0) STAMPX(32 + 4 * g.stamp);
        if constexpr (ALIGN_EPI) { if (wr == 0) PG8_BAR; }
        if constexpr (!Epi::AFTER_DRAIN) { E(acc, cur, wr, wc, fr, fq); if (ui == 0) STAMPX(33 + 4 * g.stamp); }
        if (!has_next) break;
#pragma unroll
        for (int a = 0; a < 2; ++a)
#pragma unroll
            for (int b = 0; b < 2; ++b)
#pragma unroll
                for (int m = 0; m < 4; ++m)
#pragma unroll
                    for (int n = 0; n < 2; ++n) acc[a][b][m][n] = (f32x4){0.f, 0.f, 0.f, 0.f};
        cur = nxt; cA = nA; cB = nB; ++ui;
        if constexpr (ALIGN_EPI) { if (wr == 1) PG8_BAR; }
    }
    PG8_WAIT_V(0);
    if constexpr (!ALIGN_EPI) { if (wr == 0) PG8_BAR; }
    PG8_BAR;
    if constexpr (Epi::AFTER_DRAIN) { E.fused(acc, cur, wr, wc, fr, fq, lds, wid, lane); STAMPX(33 + 4 * g.stamp); }
#undef PG8_SA
#undef PG8_SB
#undef PG8_STAGE
#undef PG8_LDA
#undef PG8_LDB
#undef PG8_MMA
#undef PG8_WAIT_V
#undef PG8_WAIT_L
#undef PG8_BAR
#undef PG8_SCHED
}
}
using pg8::Unit; using pg8::Gemm; using pg8::StaticOrder; using pg8::HALF; using pg8::BM;

__device__ __forceinline__ void load_rstd(const float* slots, int row0, int fq, float (&rs)[2][4]) {
#pragma unroll
    for (int ai = 0; ai < 2; ++ai)
#pragma unroll
        for (int m = 0; m < 4; ++m) {
            const f32x4 s = *(const f32x4*)(slots + (size_t)(row0 + ai * HALF + m * 16) * 16 + 4 * fq);
            float t = (s.x + s.y) + (s.z + s.w); t += __shfl_xor(t, 16); t += __shfl_xor(t, 32);
            rs[ai][m] = rsqrtf(t * (1.0f / 1024.0f) + EPS);
        }
}
template <int MODE> struct EpiG1 {
    static constexpr bool PERM = true, AFTER_DRAIN = false, KSCALE = false;
    const float* slots; const float* bias; int bias_ld;
    bf16_t* O; float* DT; bf16_t* HALO;
    __device__ __forceinline__ void operator()(const f32x4 (&acc)[2][2][4][2], const Unit& u, int wr, int wc, int fr, int fq) const {
        const int row0 = u.pm * BM + wr * 64 + fr; const int var = (u.pm >= 64) ? 1 : 0;
        float rs[2][4]; load_rstd(slots, row0, fq, rs);
        const int cl = wc * 32 + 8 * fq;
        const float* bp = bias + (size_t)var * bias_ld + u.pn * BM + cl;
        f32x4 bv[2][2];
#pragma unroll
        for (int bj = 0; bj < 2; ++bj)
#pragma unroll
            for (int n = 0; n < 2; ++n) bv[bj][n] = *(const f32x4*)(bp + bj * HALF + 4 * n);
#pragma unroll
        for (int ai = 0; ai < 2; ++ai)
#pragma unroll
            for (int m = 0; m < 4; ++m) {
                const int row = row0 + ai * HALF + m * 16; const float r = rs[ai][m];
                if constexpr (MODE == 3) {
                    f32x4 g0 = acc[ai][0][m][0] * r + bv[0][0], g1 = acc[ai][0][m][1] * r + bv[0][1];
                    f32x4 u0 = acc[ai][1][m][0] * r + bv[1][0], u1 = acc[ai][1][m][1] * r + bv[1][1];
                    u32x4 w;
                    w.x = cvt_pk_bf16(siluf_(g0[0]) * u0[0], siluf_(g0[1]) * u0[1]); w.y = cvt_pk_bf16(siluf_(g0[2]) * u0[2], siluf_(g0[3]) * u0[3]);
                    w.z = cvt_pk_bf16(siluf_(g1[0]) * u1[0], siluf_(g1[1]) * u1[1]); w.w = cvt_pk_bf16(siluf_(g1[2]) * u1[2], siluf_(g1[3]) * u1[3]);
                    *(u32x4*)(O + (size_t)row * FH + u.pn * HALF + cl) = w;
                } else {
#pragma unroll
                    for (int bj = 0; bj < 2; ++bj) {
                        f32x4 v0 = acc[ai][bj][m][0] * r + bv[bj][0], v1 = acc[ai][bj][m][1] * r + bv[bj][1];
                        const int col = u.pn * BM + bj * HALF + cl;
                        if constexpr (MODE == 0) {
                            if (u.pn < 4 || u.pn >= 16) {
#pragma unroll
                                for (int j = 0; j < 4; ++j) { v0[j] = siluf_(v0[j]); v1[j] = siluf_(v1[j]); } }
                            u32x4 w; w.x = cvt_pk_bf16(v0[0], v0[1]); w.y = cvt_pk_bf16(v0[2], v0[3]); w.z = cvt_pk_bf16(v1[0], v1[1]); w.w = cvt_pk_bf16(v1[2], v1[3]);
                            *(u32x4*)(O + (size_t)row * PLD + col) = w;
                        } else if constexpr (MODE == 1) {
                            if (u.pn < 20) {
                                u32x4 w; w.x = cvt_pk_bf16(v0[0], v0[1]); w.y = cvt_pk_bf16(v0[2], v0[3]); w.z = cvt_pk_bf16(v1[0], v1[1]); w.w = cvt_pk_bf16(v1[2], v1[3]);
                                *(u32x4*)(O + (size_t)row * PLD + col) = w;
                                if (u.pn >= 8) {
                                    const int rm = row & 63, tk = row >> 6;
                                    if (rm >= 62 && tk + 1 < 260) *(u32x4*)(HALO + ((size_t)(tk + 1) * 4 + (rm - 62)) * SSM_CD + (col - 2048)) = w;
                                    if (rm < 2 && tk >= 1) *(u32x4*)(HALO + ((size_t)(tk - 1) * 4 + 2 + rm) * SSM_CD + (col - 2048)) = w;
                                }
                            } else if (bj == 0 && wc < 2) {
                                float* dp = DT + (size_t)row * 64 + cl; *(f32x4*)dp = v0; *(f32x4*)(dp + 4) = v1;
                            }
                        }
                    }
                }
            }
    }
};
struct EpiQKV {
    static constexpr bool PERM = true, AFTER_DRAIN = false, KSCALE = false;
    const float* slots; const float* bias; int bias_ld; bf16_t* O; const float* rope;
    __device__ __forceinline__ void operator()(const f32x4 (&acc)[2][2][4][2], const Unit& u, int wr, int wc, int fr, int fq) const {
        const int row0 = u.pm * BM + wr * 64 + fr; const int var = (u.pm >= 64) ? 1 : 0;
        float rs[2][4]; load_rstd(slots, row0, fq, rs);
        const int cl = wc * 32 + 8 * fq;
        const float* bp = bias + (size_t)var * bias_ld + u.pn * BM + cl;
        f32x4 bv[2][2];
#pragma unroll
        for (int bj = 0; bj < 2; ++bj)
#pragma unroll
            for (int n = 0; n < 2; ++n) bv[bj][n] = *(const f32x4*)(bp + bj * HALF + 4 * n);
        const float qs = (u.pn < 4) ? 0.125f * 1.4426950408889634f : 1.0f;     const float sg = (fq < 2) ? -1.f : 1.f; const bool do_rope = (var == 0) && (u.pn < 5);
        bf16_t* op = O + (size_t)row0 * QK_LD + u.pn * BM + cl;
#pragma unroll
        for (int ai = 0; ai < 2; ++ai)
#pragma unroll
            for (int m = 0; m < 4; ++m) { const int row = row0 + ai * HALF + m * 16; const float r = rs[ai][m];
                f32x4 c0 = {1.f, 1.f, 1.f, 1.f}, c1 = c0, s0 = {0.f, 0.f, 0.f, 0.f}, s1 = s0;
                if (do_rope) { const int pos = (wc & 1) ? (row & 63) : (row >> 6); const float* cp = rope + pos * 16 + 8 * (fq & 1);
                    c0 = *(const f32x4*)cp; c1 = *(const f32x4*)(cp + 4); s0 = *(const f32x4*)(cp + 4096) * sg; s1 = *(const f32x4*)(cp + 4100) * sg; }
#pragma unroll
                for (int bj = 0; bj < 2; ++bj) { f32x4 v0 = acc[ai][bj][m][0] * r + bv[bj][0], v1 = acc[ai][bj][m][1] * r + bv[bj][1];
                    f32x4 p0, p1;
#pragma unroll
                    for (int j = 0; j < 4; ++j) { p0[j] = __shfl_xor(v0[j], 32); p1[j] = __shfl_xor(v1[j], 32); }
                    v0 = (v0 * c0 + p0 * s0) * qs; v1 = (v1 * c1 + p1 * s1) * qs;
                    u32x4 w; w.x = cvt_pk_bf16(v0[0], v0[1]); w.y = cvt_pk_bf16(v0[2], v0[3]); w.z = cvt_pk_bf16(v1[0], v1[1]); w.w = cvt_pk_bf16(v1[2], v1[3]);
                    *(u32x4*)(op + (size_t)(ai * HALF + m * 16) * QK_LD + bj * HALF) = w; }
                asm volatile("" ::: "memory"); }
    }
};
typedef _Float16 h16x4 __attribute__((ext_vector_type(4)));
typedef _Float16 h16x8 __attribute__((ext_vector_type(8)));
typedef float f32x8 __attribute__((ext_vector_type(8)));
template <bool BH, bool OH> struct EpiResid {
    static constexpr bool PERM = false, AFTER_DRAIN = false, KSCALE = false;
    const void* base; void* out;
    const float* gate; const float* csn; bf16_t* xs; float* slots;
    __device__ __forceinline__ void operator()(const f32x4 (&acc)[2][2][4][2], const Unit& u, int wr, int wc, int fr, int fq) const {
        const int row0 = u.pm * BM + wr * 64 + fr, col0 = u.pn * BM + wc * 32 + 4 * fq;
        f32x4 gv[2][2], cv[2][2];
#pragma unroll
        for (int bj = 0; bj < 2; ++bj)
#pragma unroll
            for (int n = 0; n < 2; ++n) { gv[bj][n] = *(const f32x4*)(gate + col0 + bj * HALF + n * 16);
                cv[bj][n] = csn ? *(const f32x4*)(csn + col0 + bj * HALF + n * 16) : (f32x4){0.f, 0.f, 0.f, 0.f}; }
#pragma unroll
        for (int ai = 0; ai < 2; ++ai)
#pragma unroll
            for (int m = 0; m < 4; ++m) {
                const int row = row0 + ai * HALF + m * 16; const size_t off = (size_t)row * D + col0; float ss = 0.f;
#pragma unroll
                for (int bj = 0; bj < 2; ++bj)
#pragma unroll
                    for (int n = 0; n < 2; ++n) {
                        f32x4 b;
                        if constexpr (BH) b = __builtin_convertvector(*(const h16x4*)((const _Float16*)base + off + bj * HALF + n * 16), f32x4);
                        else b = *(const f32x4*)((const float*)base + off + bj * HALF + n * 16);
                        const f32x4 x = b + gv[bj][n] * acc[ai][bj][m][n];
                        if constexpr (OH) *(h16x4*)((_Float16*)out + off + bj * HALF + n * 16) = __builtin_convertvector(x, h16x4);
                        else *(f32x4*)((float*)out + off + bj * HALF + n * 16) = x;
                        ss += (x[0] * x[0] + x[1] * x[1]) + (x[2] * x[2] + x[3] * x[3]);
                        if (csn) { const f32x4 y = x * cv[bj][n]; u32x2 w; w.x = cvt_pk_bf16(y[0], y[1]); w.y = cvt_pk_bf16(y[2], y[3]); *(u32x2*)(xs + off + bj * HALF + n * 16) = w; }
                    }
                ss += __shfl_xor(ss, 16); ss += __shfl_xor(ss, 32);
                if (fq == 0) slots[(size_t)row * 16 + u.pn * 4 + wc] = ss;
            }
    }
};

constexpr int RQ_OFF = 133120;
template <bool BH, bool OH, bool KS = false> struct EpiResidLds {
    static constexpr bool PERM = false, AFTER_DRAIN = true, KSCALE = KS;
    __device__ __forceinline__ void kscale(f32x4 (&acc)[2][2][4][2], int g, int wr, int fr, LAS unsigned char* lds) const {
        const LAS float* RQ = (const LAS float*)(lds + RQ_OFF);
#pragma unroll
        for (int ai = 0; ai < 2; ++ai)
#pragma unroll
            for (int m = 0; m < 4; ++m) { const float q = RQ[(ai * HALF + wr * 64 + m * 16 + fr) * 4 + (g - 1)];
#pragma unroll
                for (int bj = 0; bj < 2; ++bj)
#pragma unroll
                    for (int n = 0; n < 2; ++n) acc[ai][bj][m][n] = acc[ai][bj][m][n] * q; }
    }
    const void* base; void* out;
    const float* gate; const float* csn; bf16_t* xs; float* slots;
    __device__ __forceinline__ void fused(const f32x4 (&acc)[2][2][4][2], const Unit& u, int wr, int wc, int fr, int fq, LAS unsigned char* lds, int wid, int lane) const {
        constexpr int PITCH = 1040;
        const int hl = lane & 31, hw = lane >> 5;
        const int colg = u.pn * BM + 8 * hl;
        const f32x4 gv0 = *(const f32x4*)(gate + colg), gv1 = *(const f32x4*)(gate + colg + 4);
        const f32x4 cv0 = csn ? *(const f32x4*)(csn + colg) : (f32x4){0.f, 0.f, 0.f, 0.f}, cv1 = csn ? *(const f32x4*)(csn + colg + 4) : (f32x4){0.f, 0.f, 0.f, 0.f};
        h16x8 bh[BH ? 16 : 1]; f32x4 bf[BH ? 1 : 16];
        if constexpr (BH) {
#pragma unroll
            for (int q = 0; q < 16; ++q) bh[q] = *(const h16x8*)((const _Float16*)base + (size_t)(u.pm * BM + (q >> 3) * HALF + wid * 16 + 2 * (q & 7) + hw) * D + colg);
        }
#pragma unroll
        for (int ai = 0; ai < 2; ++ai) {
            if constexpr (!BH) {
#pragma unroll
                for (int q = 0; q < 8; ++q) { const float* bp_ = (const float*)base + (size_t)(u.pm * BM + ai * HALF + wid * 16 + 2 * q + hw) * D + colg; bf[2 * q] = *(const f32x4*)bp_; bf[2 * q + 1] = *(const f32x4*)(bp_ + 4); }
            }
#pragma unroll
            for (int m = 0; m < 4; ++m)
#pragma unroll
                for (int bj = 0; bj < 2; ++bj)
#pragma unroll
                    for (int n = 0; n < 2; ++n) *(LAS f32x4*)(lds + (wr * 64 + m * 16 + fr) * PITCH + (bj * HALF + wc * 32 + n * 16 + fq * 4) * 4) = acc[ai][bj][m][n];
            __syncthreads();
#pragma unroll
            for (int st = 0; st < 8; ++st) {
                const int lr = wid * 16 + 2 * st + hw, row = u.pm * BM + ai * HALF + lr; const size_t off = (size_t)row * D + colg;
                f32x4 a0 = *(const LAS f32x4*)(lds + lr * PITCH + hl * 32), a1 = *(const LAS f32x4*)(lds + lr * PITCH + hl * 32 + 16);
                if constexpr (KS) { const float q_ = ((const LAS float*)(lds + RQ_OFF))[(ai * HALF + lr) * 4 + 3]; a0 = a0 * q_; a1 = a1 * q_; }
                f32x4 b0, b1;
                if constexpr (BH) { const f32x8 bb = __builtin_convertvector(bh[ai * 8 + st], f32x8); b0 = (f32x4){bb[0], bb[1], bb[2], bb[3]}; b1 = (f32x4){bb[4], bb[5], bb[6], bb[7]}; }
                else { b0 = bf[2 * st]; b1 = bf[2 * st + 1]; }
                const f32x4 x0 = b0 + gv0 * a0, x1 = b1 + gv1 * a1;
                if constexpr (OH) { const h16x4 l_ = __builtin_convertvector(x0, h16x4), h_ = __builtin_convertvector(x1, h16x4);
                    *(h16x8*)((_Float16*)out + off) = (h16x8){l_[0], l_[1], l_[2], l_[3], h_[0], h_[1], h_[2], h_[3]}; }
                else { *(f32x4*)((float*)out + off) = x0; *(f32x4*)((float*)out + off + 4) = x1; }
                if (csn) { const f32x4 y0 = x0 * cv0, y1 = x1 * cv1; u32x4 w; w.x = cvt_pk_bf16(y0[0], y0[1]); w.y = cvt_pk_bf16(y0[2], y0[3]); w.z = cvt_pk_bf16(y1[0], y1[1]); w.w = cvt_pk_bf16(y1[2], y1[3]); *(u32x4*)(xs + off) = w; }
                float ss = ((x0[0] * x0[0] + x0[1] * x0[1]) + (x0[2] * x0[2] + x0[3] * x0[3])) + ((x1[0] * x1[0] + x1[1] * x1[1]) + (x1[2] * x1[2] + x1[3] * x1[3]));
#pragma unroll
                for (int o = 1; o < 32; o <<= 1) ss += __shfl_xor(ss, o);
                if (hl < 4) slots[(size_t)row * 16 + u.pn * 4 + hl] = (hl == 0) ? ss : 0.f;
            }
            __syncthreads();
        }
    }
};

struct Args { const float* in[27]; float* out; unsigned char* ws; int ph_lo, ph_hi; };
struct Frame {
    LAS unsigned char* lds; int tid, lane, wave, G, bid, vcu;
    const float* const* in; float* out; unsigned char* ws;
};
#define WSF(off) ((float*)(F.ws + (off)))
#define WSB(off) ((bf16_t*)(F.ws + (off)))


constexpr size_t WS_CSS = WS_CTL + 65536;
__device__ __forceinline__ float ctx_rstd(const Frame& F, int crow_) {
    const float* p = WSF(WS_CSS) + crow_ * 32; float t = 0.f;
#pragma unroll
    for (int j = 0; j < 8; ++j) { const f32x4 v = *(const f32x4*)(p + 4 * j); t += (v[0] + v[1]) + (v[2] + v[3]); }
    return rsqrtf(t * (1.0f / 1024.0f) + EPS);
}
struct CtxP { const bf16_t* A; int lda, a_grp_step; const bf16_t* Wt; int ldb, K, ncb; const float* bias; bf16_t* O; int ldo; float* DT; bf16_t* HALO;
              const float* base; float* xout; const float* gate; const float* csn; bf16_t* xs; int dbg = 0; const float* ssq = nullptr; };
template <int MODE, int NKS> __device__ __forceinline__ void ctx_gemm(Frame& F, const CtxP p, int heavy) {
    const int r = F.lane & 31, hf = F.lane >> 5, w = F.wave;
    if (F.bid < heavy) return;
    const int t0_ = F.bid - heavy, tstep_ = F.G - heavy;
    constexpr int nks = NKS; const int kslice = NKS * 16;
    LAS float* red = (LAS float*)F.lds;
    LAS float* ssq = (LAS float*)(F.lds + 65536);
    if (p.dbg) STAMPX(80);
    for (int t = t0_; t < p.ncb * 8; t += tstep_) {
        const int cb = t >> 3, rb = t & 7;
        const bf16_t* ap = p.A + (size_t)(NLAT + rb * 32 + r) * p.lda + (cb >> 3) * p.a_grp_step + w * kslice + hf * 8;
        int wrow = cb * 32 + r; if (MODE == 3) wrow = 256 * (cb >> 2) + 32 * (cb & 3) + r;
        const bf16_t* bp = p.Wt + (size_t)wrow * p.ldb + w * kslice + hf * 8;
        f32x16 acc, acc2;
#pragma unroll
        for (int i = 0; i < 16; ++i) { acc[i] = 0.f; acc2[i] = 0.f; }
        const int e_ln = F.tid & 63, e_g4 = (F.tid >> 6) & 3, e_rr = e_ln & 31, e_hh = e_ln >> 5;
        const int e_crow = rb * 32 + e_rr, e_col = cb * 32 + 8 * e_g4 + 4 * e_hh;
        f32x4 pe0 = {0.f, 0.f, 0.f, 0.f}, pe1 = pe0, pe2 = pe0; float pe_rs = 0.f;
        if (F.tid < 256) {
            if (MODE == 4) { pe0 = *(const f32x4*)(p.base + (size_t)e_crow * D + e_col); pe1 = *(const f32x4*)(p.gate + D + e_col); if (p.csn) pe2 = *(const f32x4*)(p.csn + D + e_col); }
            else { pe_rs = ctx_rstd(F, e_crow);
                if (MODE == 3) { const int brow = 256 * (cb >> 2) + 32 * (cb & 3) + 8 * e_g4 + 4 * e_hh; pe0 = *(const f32x4*)(p.bias + brow); pe1 = *(const f32x4*)(p.bias + brow + 128); }
                else pe0 = *(const f32x4*)(p.bias + e_col); }
        }
        constexpr int KB = (NKS > 16) ? (NKS + 1) / 2 : 8;
#pragma unroll
        for (int k0 = 0; k0 < nks; k0 += KB) {
            bf16x8 a[KB], b[KB], b2[KB];
#pragma unroll
            for (int j = 0; j < KB; ++j) if (k0 + j < nks) { a[j] = *(const bf16x8*)(ap + (k0 + j) * 16); b[j] = *(const bf16x8*)(bp + (k0 + j) * 16); if (MODE == 3) b2[j] = *(const bf16x8*)(bp + (size_t)128 * p.ldb + (k0 + j) * 16); }
#pragma unroll
            for (int j = 0; j < KB; ++j) if (k0 + j < nks) { acc = MFMA32(b[j], a[j], acc); if (MODE == 3) acc2 = MFMA32(b2[j], a[j], acc2); }
            if (nks > KB) asm volatile("" ::: "memory");
        }
        if (p.dbg) STAMPX(81);
        if (MODE == 4 && p.ssq) { const float* sp_ = p.ssq + (size_t)(NLAT + rb * 32 + r) * 32 + (w >> 1) * 8; const f32x4 s0_ = *(const f32x4*)sp_, s1_ = *(const f32x4*)(sp_ + 4);
            const float rg = rsqrtf((((s0_[0] + s0_[1]) + (s0_[2] + s0_[3])) + ((s1_[0] + s1_[1]) + (s1_[2] + s1_[3]))) * (1.0f / 512.0f) + EPS);
#pragma unroll
            for (int i = 0; i < 16; ++i) acc[i] *= rg; }
        __syncthreads();
#pragma unroll
        for (int i = 0; i < 16; ++i) { red[(w * 16 + i) * 64 + F.lane] = acc[i]; if (MODE == 3) red[8192 + (w * 16 + i) * 64 + F.lane] = acc2[i]; }
        __syncthreads();
        if (p.dbg) STAMPX(82);
        float ss = 0.f;
        if (F.tid < 256) {
            const int ln = F.tid & 63, g4 = F.tid >> 6, rr = ln & 31, hh = ln >> 5;
            float v[4], v2[4];
#pragma unroll
            for (int j = 0; j < 4; ++j) { float sa = 0.f, sb = 0.f;
#pragma unroll
                for (int ww = 0; ww < 8; ++ww) { sa += red[(ww * 16 + 4 * g4 + j) * 64 + ln]; if (MODE == 3) sb += red[8192 + (ww * 16 + 4 * g4 + j) * 64 + ln]; }
                v[j] = sa; v2[j] = sb; }
            const int crow_ = rb * 32 + rr, row = NLAT + crow_, col = cb * 32 + 8 * g4 + 4 * hh;
            if (MODE == 4) {
                const f32x4 b_ = pe0, gt = pe1;
                f32x4 x; x[0] = b_[0] + gt[0] * v[0]; x[1] = b_[1] + gt[1] * v[1]; x[2] = b_[2] + gt[2] * v[2]; x[3] = b_[3] + gt[3] * v[3];
                *(f32x4*)(p.xout + (size_t)crow_ * D + col) = x;
                ss = (x[0] * x[0] + x[1] * x[1]) + (x[2] * x[2] + x[3] * x[3]);
                if (p.csn) { const f32x4 c_ = pe2; u32x2 o; o.x = cvt_pk_bf16(x[0] * c_[0], x[1] * c_[1]); o.y = cvt_pk_bf16(x[2] * c_[2], x[3] * c_[3]); *(u32x2*)(p.xs + (size_t)row * D + col) = o; }
            } else {
                const float rs = pe_rs;
                if (MODE == 3) {
                    const f32x4 bg = pe0, bu = pe1;
                    u32x2 o; o.x = cvt_pk_bf16(siluf_(v[0] * rs + bg[0]) * (v2[0] * rs + bu[0]), siluf_(v[1] * rs + bg[1]) * (v2[1] * rs + bu[1]));
                    o.y = cvt_pk_bf16(siluf_(v[2] * rs + bg[2]) * (v2[2] * rs + bu[2]), siluf_(v[3] * rs + bg[3]) * (v2[3] * rs + bu[3]));
                    *(u32x2*)(p.O + (size_t)row * p.ldo + col) = o;
                } else {
                    const f32x4 bv = pe0;
                    float y[4];
#pragma unroll
                    for (int j = 0; j < 4; ++j) y[j] = v[j] * rs + bv[j];
                    if (MODE == 0 && (col < 1024 || col >= 4096)) {
#pragma unroll
                        for (int j = 0; j < 4; ++j) y[j] = siluf_(y[j]); }
                    if (MODE == 1 && col >= 5120) { if (col < 5184) *(f32x4*)(p.DT + (size_t)row * 64 + (col - 5120)) = (f32x4){y[0], y[1], y[2], y[3]}; }
                    else {
                        u32x2 o; o.x = cvt_pk_bf16(y[0], y[1]); o.y = cvt_pk_bf16(y[2], y[3]);
                        *(u32x2*)(p.O + (size_t)row * p.ldo + col) = o;
                        if (MODE == 1 && col >= 2048) { const int rm = row & 63, tk = row >> 6;
                            if (rm >= 62 && tk + 1 < 260) *(u32x2*)(p.HALO + ((size_t)(tk + 1) * 4 + (rm - 62)) * SSM_CD + (col - 2048)) = o;
                            if (rm < 2 && tk >= 1) *(u32x2*)(p.HALO + ((size_t)(tk - 1) * 4 + 2 + rm) * SSM_CD + (col - 2048)) = o; }
                    }
                }
            }
        }
        if (p.dbg) STAMPX(83);
        if (MODE == 4) {
            ss += __shfl_xor(ss, 32);
            if (F.tid < 256 && (F.tid & 63) < 32) ssq[(F.tid >> 6) * 32 + (F.tid & 31)] = ss;
            __syncthreads();
            if (F.tid < 32) WSF(WS_CSS)[(rb * 32 + F.tid) * 32 + cb] = (ssq[F.tid] + ssq[32 + F.tid]) + (ssq[64 + F.tid] + ssq[96 + F.tid]);
        }
    }
    if (p.dbg) STAMPX(84);
    __syncthreads();
    if (p.dbg) STAMPX(85);
}

__device__ __forceinline__ void transpose_item(const float* W, int K, int Nsrc, bf16_t* WT, int dst_row0, int src_col0, int kb, LAS float* scr, int lane, const float* ksc) {
    const int k0 = 64 * kb;
    f32x4 v[8];
    if (src_col0 >= 0) {
        const float* wp = W + (size_t)(k0 + (lane >> 3)) * Nsrc + src_col0 + 4 * (lane & 7);
#pragma unroll
        for (int i = 0; i < 8; ++i) v[i] = *(const f32x4*)(wp + (size_t)(8 * i) * Nsrc);
        if (ksc) {
#pragma unroll
            for (int i = 0; i < 8; ++i) v[i] = v[i] * ksc[k0 + (lane >> 3) + 8 * i]; }
    } else {
#pragma unroll
        for (int i = 0; i < 8; ++i) v[i] = (f32x4){0.f, 0.f, 0.f, 0.f};
    }
#pragma unroll
    for (int i = 0; i < 8; ++i) { LAS float* d = scr + ((lane >> 3) + 8 * i) * 33 + 4 * (lane & 7); d[0] = v[i][0]; d[1] = v[i][1]; d[2] = v[i][2]; d[3] = v[i][3]; }
    asm volatile("s_waitcnt lgkmcnt(0)" ::: "memory");
    const int c = lane & 7;
#pragma unroll
    for (int j = 0; j < 4; ++j) { const int n = (lane >> 3) + 8 * j; const LAS float* s = scr + (8 * c) * 33 + n;
        u32x4 o; o.x = pk2(s[0 * 33], s[1 * 33]); o.y = pk2(s[2 * 33], s[3 * 33]); o.z = pk2(s[4 * 33], s[5 * 33]); o.w = pk2(s[6 * 33], s[7 * 33]);
        *(u32x4*)(WT + (size_t)(dst_row0 + n) * K + k0 + 8 * c) = o; }
    asm volatile("s_waitcnt lgkmcnt(0)" ::: "memory");
}
struct ConvJob { int in_idx; size_t src_off; int K, Nsrc, Ndst, mode; size_t dst; };
__device__ __forceinline__ void phase_p0a(Frame& F) {
    {
        LAS float* sv = (LAS float*)F.lds;
        LAS float* red = sv + 2048;
        for (int i = F.tid; i < 2048; i += NTHR) { const float x = (i < 1024) ? F.in[1][i] : F.in[3][i - 1024]; sv[i] = siluf_(x); }
        __syncthreads();
        for (int task = F.bid; task < 256; task += F.G) {
            const int layer = task >> 6, cg_ = task & 63, krow = F.tid >> 5, c4 = F.tid & 31;
            f32x4 aL = {0.f, 0.f, 0.f, 0.f}, aC = {0.f, 0.f, 0.f, 0.f};
            if (c4 < 24) {
                const float* wp = F.in[4] + (size_t)layer * 1024 * 6144 + cg_ * 96 + c4 * 4;
#pragma unroll 8
                for (int j = 0; j < 64; ++j) { const int k = krow + 16 * j; const f32x4 w = *(const f32x4*)(wp + (size_t)k * 6144); aL += w * sv[k]; aC += w * sv[1024 + k]; }
                LAS float* r = red + (krow * 24 + c4) * 8;
                r[0] = aL[0]; r[1] = aL[1]; r[2] = aL[2]; r[3] = aL[3]; r[4] = aC[0]; r[5] = aC[1]; r[6] = aC[2]; r[7] = aC[3];
            }
            __syncthreads();
            if (F.tid < 192) { const int var = F.tid / 96, cc = F.tid % 96; float s = 0.f;
#pragma unroll
                for (int kr = 0; kr < 16; ++kr) s += red[(kr * 24 + (cc >> 2)) * 8 + var * 4 + (cc & 3)];
                const int n = cg_ * 96 + cc; WSF(WS_MODS)[((size_t)layer * 2 + var) * 6144 + n] = s + F.in[5][layer * 6144 + n]; }
            __syncthreads();
        }
    }
    {
        const int gt = F.bid * NTHR + F.tid, GT = F.G * NTHR;
        for (int i = gt; i < 2048; i += GT) {
            const int dir = i >> 10, d = i & 1023; float v[5], mx = -1e30f;
#pragma unroll
            for (int j = 0; j < 5; ++j) { v[j] = F.in[11][(dir * 5 + j) * 1024 + d]; mx = fmaxf(mx, v[j]); }
            float s = 0.f;
#pragma unroll
            for (int j = 0; j < 5; ++j) { v[j] = __expf(v[j] - mx); s += v[j]; }
            WSF(WS_LB)[i] = v[0] / s;
        }
        for (int i = gt; i < 4096; i += GT) {
            const int pos = i >> 4, f = i & 15;
            const float inv = powf(10000.0f, -(float)(2 * f) / 32.0f); const float ang = (float)pos * inv;
            const double rev = (double)ang * 0.15915494309189533577; const float fr_ = (float)(rev - floor(rev));
            WSF(WS_ROPE)[i] = __builtin_amdgcn_cosf(fr_); WSF(WS_ROPE)[4096 + i] = __builtin_amdgcn_sinf(fr_);
        }
    }
    {
        LAS float* scr = (LAS float*)(F.lds + F.wave * 8704);
        const int gw = F.bid * NWAVES + F.wave, NGW = F.G * NWAVES;
        constexpr int NJ = 19;
        const ConvJob jobs[NJ] = {
            {10, 0, 1024, HG_N, HG_N, 0, WS_W_HGIN}, {13, 0, 1024, 1024, 1024, 0, WS_W_HGOUT},
            {14, 0, 1024, SSM_N, SSM_NP, 0, WS_W_SSMIN}, {21, 0, 2048, 1024, 1024, 0, WS_W_SSMOUT},
            {22, 0, 256, 256, 256, 0, WS_W_POOL}, {22, 65536, 256, 256, 256, 0, WS_W_POOL + 131072}, {22, 131072, 256, 256, 256, 0, WS_W_POOL + 262144}, {22, 196608, 256, 256, 256, 0, WS_W_POOL + 393216},
            {24, 0, 1024, ATT_N, ATT_N, 0, WS_W_QKV}, {26, 0, 1024, 1024, 1024, 0, WS_W_ATTOUT},
            {7, 0, 1024, FH2, FH2, 1, WS_W_FFNIN}, {7, (size_t)1024 * FH2, 1024, FH2, FH2, 1, WS_W_FFNIN + (size_t)FH2 * 1024 * 2},
            {7, (size_t)2 * 1024 * FH2, 1024, FH2, FH2, 1, WS_W_FFNIN + (size_t)2 * FH2 * 1024 * 2}, {7, (size_t)3 * 1024 * FH2, 1024, FH2, FH2, 1, WS_W_FFNIN + (size_t)3 * FH2 * 1024 * 2},
            {8, 0, FH, 1024, 1024, 0, WS_W_FFNOUT}, {8, (size_t)FH * 1024, FH, 1024, 1024, 0, WS_W_FFNOUT + (size_t)1024 * FH * 2},
            {8, (size_t)2 * FH * 1024, FH, 1024, 1024, 0, WS_W_FFNOUT + (size_t)2 * 1024 * FH * 2}, {8, (size_t)3 * FH * 1024, FH, 1024, 1024, 0, WS_W_FFNOUT + (size_t)3 * 1024 * FH * 2},
            {0, 0, 0, 0, 0, 0, 0}};
        int total = 0;
#pragma unroll
        for (int j = 0; j < NJ - 1; ++j) total += (jobs[j].Ndst / 32) * (jobs[j].K / 64);
        for (int it = gw; it < total; it += NGW) {
            int r = it, j = 0;
#pragma unroll
            for (int jj = 0; jj < NJ - 1; ++jj) { const int n = (jobs[jj].Ndst / 32) * (jobs[jj].K / 64); if (j == jj && r >= n) { r -= n; j = jj + 1; } }
            int in_idx = 0, K = 0, Nsrc = 0, Ndst = 0, mode = 0; size_t so = 0, dst = 0;
#pragma unroll
            for (int jj = 0; jj < NJ - 1; ++jj) if (j == jj) { in_idx = jobs[jj].in_idx; so = jobs[jj].src_off; K = jobs[jj].K; Nsrc = jobs[jj].Nsrc; Ndst = jobs[jj].Ndst; mode = jobs[jj].mode; dst = jobs[jj].dst; }
            const int nblk = Ndst / 32, kb = r / nblk, nb = r % nblk; const int drow = nb * 32;
            int scol;
            if (mode == 1) { const int pn = drow >> 8, w = drow & 255; scol = (w < 128) ? (pn * 128 + w) : (FH + pn * 128 + (w - 128)); }
            else scol = (drow < Nsrc) ? drow : -1;
            transpose_item(F.in[in_idx] + so, K, Nsrc, WSB(dst), drow, scol, kb, scr, F.lane, (in_idx == 21) ? F.in[20] : (const float*)nullptr);
        }
    }
}

__device__ __forceinline__ void phase_p0b(Frame& F) {
    const int gt = F.bid * NTHR + F.tid, GT = F.G * NTHR;
    const float* mods = WSF(WS_MODS);
    for (int i = gt; i < 4 * 2 * 2 * 1024; i += GT) {
        const int k = i & 1023, var = (i >> 10) & 1, nrm = (i >> 11) & 1, layer = i >> 12;
        const float sc = mods[((size_t)layer * 2 + var) * 6144 + (nrm ? 4 : 1) * 1024 + k];
        WSF(WS_CS)[i] = F.in[6][(layer * 2 + nrm) * 1024 + k] * (1.0f + sc);
        float g = mods[((size_t)layer * 2 + var) * 6144 + (nrm ? 5 : 2) * 1024 + k];
        if (layer == 2 && nrm == 0) g *= F.in[23][k];
        WSF(WS_GATE)[i] = g;
    }
    const int gw = F.bid * NWAVES + F.wave, NGW = F.G * NWAVES;
    {
        constexpr int R0 = HG_N, R1 = SSM_NP, R3 = ATT_N, RF = 4 * FH2, RT = R0 + R1 + R3 + RF;
        for (int it = gw * 4; it < RT; it += NGW * 4) {
            int r = it, layer, which, n; const bf16_t* wt;
            if (r < R0) { layer = 0; which = 0; n = r; wt = WSB(WS_W_HGIN) + (size_t)n * D; }
            else if ((r -= R0) < R1) { layer = 1; which = 0; n = r; wt = WSB(WS_W_SSMIN) + (size_t)n * D; }
            else if ((r -= R1) < R3) { layer = 3; which = 0; n = r; wt = WSB(WS_W_QKV) + (size_t)n * D; }
            else { r -= R3; layer = r / FH2; which = 1; n = r % FH2; wt = WSB(WS_W_FFNIN) + ((size_t)layer * FH2 + n) * D; }
            u32x4 w[4][2];
#pragma unroll
            for (int q = 0; q < 4; ++q)
#pragma unroll
                for (int h = 0; h < 2; ++h) w[q][h] = *(const u32x4*)(wt + (size_t)q * D + h * 512 + F.lane * 8);
            float aL[4] = {0.f, 0.f, 0.f, 0.f}, aC[4] = {0.f, 0.f, 0.f, 0.f};
#pragma unroll
            for (int h = 0; h < 2; ++h) {
                const int k0 = h * 512 + F.lane * 8;
                const float* sL = mods + ((size_t)layer * 2 + 0) * 6144 + (which ? 3 : 0) * 1024 + k0; const float* sC = sL + 6144;
                const f32x4 l0 = *(const f32x4*)sL, l1 = *(const f32x4*)(sL + 4), c0 = *(const f32x4*)sC, c1 = *(const f32x4*)(sC + 4);
#pragma unroll
                for (int q = 0; q < 4; ++q) { const u32x4 ww = w[q][h];
                    const float w0 = lo_bf(ww.x), w1 = hi_bf(ww.x), w2 = lo_bf(ww.y), w3 = hi_bf(ww.y), w4 = lo_bf(ww.z), w5 = hi_bf(ww.z), w6 = lo_bf(ww.w), w7 = hi_bf(ww.w);
                    aL[q] += w0 * l0[0] + w1 * l0[1] + w2 * l0[2] + w3 * l0[3] + w4 * l1[0] + w5 * l1[1] + w6 * l1[2] + w7 * l1[3];
                    aC[q] += w0 * c0[0] + w1 * c0[1] + w2 * c0[2] + w3 * c0[3] + w4 * c1[0] + w5 * c1[1] + w6 * c1[2] + w7 * c1[3]; }
            }
#pragma unroll
            for (int q = 0; q < 4; ++q) { aL[q] = wave_sum(aL[q]); aC[q] = wave_sum(aC[q]); }
            if (F.lane == 0) { float* bp = WSF(which ? WS_BIAS3 : WS_BIAS1) + (size_t)layer * 2 * FH2 + n;
#pragma unroll
                for (int q = 0; q < 4; ++q) { bp[q] = aL[q]; bp[FH2 + q] = aC[q]; } }
        }
    }
    for (int row2 = gw * 2; row2 < MALL; row2 += NGW * 2) {
        f32x4 x[2][4];
#pragma unroll
        for (int q = 0; q < 2; ++q) { const int row = row2 + q; const float* xr = (row >= NLAT) ? F.in[2] + (size_t)(row - NLAT) * D : F.in[0] + (size_t)row * D;
#pragma unroll
            for (int j = 0; j < 2; ++j) { x[q][2 * j] = *(const f32x4*)(xr + j * 512 + F.lane * 8); x[q][2 * j + 1] = *(const f32x4*)(xr + j * 512 + F.lane * 8 + 4); } }
#pragma unroll
        for (int q = 0; q < 2; ++q) {
            const int row = row2 + q, var = row >= NLAT; float ss = 0.f;
#pragma unroll
            for (int j = 0; j < 2; ++j) {
                const int k = j * 512 + F.lane * 8; u32x4 w;
#pragma unroll
                for (int e = 0; e < 2; ++e) { const f32x4 xv = x[q][2 * j + e];
                    const f32x4 nw = *(const f32x4*)(F.in[6] + k + 4 * e); const f32x4 sc = *(const f32x4*)(mods + (size_t)var * 6144 + 1024 + k + 4 * e);
                    ss += (xv[0] * xv[0] + xv[1] * xv[1]) + (xv[2] * xv[2] + xv[3] * xv[3]);
                    const f32x4 y = xv * (nw * (sc + 1.0f));
                    if (e == 0) { w.x = pk2(y[0], y[1]); w.y = pk2(y[2], y[3]); } else { w.z = pk2(y[0], y[1]); w.w = pk2(y[2], y[3]); } }
                *(u32x4*)(WSB(WS_XSA) + (size_t)row * D + k) = w;
            }
            ss = wave_sum(ss);
            if (var) { if (F.lane < 32) WSF(WS_CSS)[(row - NLAT) * 32 + F.lane] = (F.lane == 0) ? ss : 0.f; }
            else if (F.lane < 16) WSF(WS_SLOTS)[(size_t)row * 16 + F.lane] = (F.lane == 0) ? ss : 0.f;
        }
    }
}

__device__ __forceinline__ int tc_row0(int tc) { return tc < 256 ? tc * 64 : NLAT + (tc - 256) * 64; }
__device__ __forceinline__ int tc_pf(int tc) { return tc < 256 ? 4 + tc : tc - 256; }
__device__ __forceinline__ int tc_pb(int tc) { return tc < 256 ? 4 + 255 - tc : 3 - (tc - 256); }
__device__ __forceinline__ bf16_t* hg_state(const Frame& F, int dir, int h, int p) {
    return (h < 5) ? (bf16_t*)(F.ws + WS_ST) + ((size_t)(dir * 5 + h) * 260 + p) * 16384 : (bf16_t*)F.out + ((size_t)(dir * 3 + (h - 5)) * 260 + p) * 16384;
}
constexpr int HG_VT = 0, HG_QR = 18432, HG_KR = 53248, HG_QI = 88064, HG_ATT = 122880, HG_SEG = 140288, HG_RED = 144384;
constexpr int HG_PITCH = 272, HG_VPITCH = 144;
static_assert(HG_RED + 1024 <= MISC_OFF, "HGRN LDS map");
struct HgPrep { float k0[16], k1[16], c0[16], c1[16], off0, off1, tot0, tot1, ref0, ref1; };
__device__ __forceinline__ void hg_prep(const Frame& F, const bf16_t* P, int row0, int h, int dir, int seg, int cp, HgPrep& R) {
    const float lb0 = WSF(WS_LB)[dir * 1024 + h * 128 + 2 * cp], lb1 = WSF(WS_LB)[dir * 1024 + h * 128 + 2 * cp + 1];
    unsigned zw[16];
#pragma unroll
    for (int i = 0; i < 16; ++i) { const int si = seg * 16 + i, tok = dir ? 63 - si : si; zw[i] = *(const unsigned*)(P + (size_t)(row0 + tok) * PLD + 1024 + dir * 1024 + h * 128 + 2 * cp); }
    float a0 = 0.f, a1 = 0.f;
#pragma unroll
    for (int i = 0; i < 16; ++i) {
        const float s0 = sigmoidf_(lo_bf(zw[i])), s1 = sigmoidf_(hi_bf(zw[i]));
        a0 += __logf(lb0 + (1.f - lb0) * s0); a1 += __logf(lb1 + (1.f - lb1) * s1);
        R.c0[i] = a0; R.c1[i] = a1; R.k0[i] = (1.f - lb0) * (1.f - s0); R.k1[i] = (1.f - lb1) * (1.f - s1);
    }
    LAS float* sg = (LAS float*)(F.lds + HG_SEG) + (dir * 4) * 128 + 2 * cp;
    sg[seg * 128] = a0; sg[seg * 128 + 1] = a1;
    __syncthreads();
    float o0 = 0.f, o1 = 0.f, t0 = 0.f, t1 = 0.f;
#pragma unroll
    for (int s_ = 0; s_ < 4; ++s_) { const float x0 = sg[s_ * 128], x1 = sg[s_ * 128 + 1]; if (s_ < seg) { o0 += x0; o1 += x1; } t0 += x0; t1 += x1; }
    R.off0 = o0; R.off1 = o1; R.tot0 = t0; R.tot1 = t1; R.ref0 = sg[0] + sg[128]; R.ref1 = sg[1] + sg[129];
}
__device__ __forceinline__ void hg_prep_z(const Frame& F, const unsigned (&zw)[16], int h, int dir, int seg, int cp, HgPrep& R) {
    const float lb0 = WSF(WS_LB)[dir * 1024 + h * 128 + 2 * cp], lb1 = WSF(WS_LB)[dir * 1024 + h * 128 + 2 * cp + 1];
    float a0 = 0.f, a1 = 0.f;
#pragma unroll
    for (int i = 0; i < 16; ++i) {
        const float s0 = sigmoidf_(lo_bf(zw[i])), s1 = sigmoidf_(hi_bf(zw[i]));
        a0 += __logf(lb0 + (1.f - lb0) * s0); a1 += __logf(lb1 + (1.f - lb1) * s1);
        R.c0[i] = a0; R.c1[i] = a1; R.k0[i] = (1.f - lb0) * (1.f - s0); R.k1[i] = (1.f - lb1) * (1.f - s1);
    }
    LAS float* sg = (LAS float*)(F.lds + HG_SEG) + (dir * 4) * 128 + 2 * cp;
    sg[seg * 128] = a0; sg[seg * 128 + 1] = a1;
    __syncthreads();
    float o0 = 0.f, o1 = 0.f, t0 = 0.f, t1 = 0.f;
#pragma unroll
    for (int s_ = 0; s_ < 4; ++s_) { const float x0 = sg[s_ * 128], x1 = sg[s_ * 128 + 1]; if (s_ < seg) { o0 += x0; o1 += x1; } t0 += x0; t1 += x1; }
    R.off0 = o0; R.off1 = o1; R.tot0 = t0; R.tot1 = t1; R.ref0 = sg[0] + sg[128]; R.ref1 = sg[1] + sg[129];
}
__device__ __forceinline__ void hg_stage_vt_v(const Frame& F, const unsigned (&vw)[16], int seg, int cp) {
    u32x4 a, b, c, d;
    a.x = (vw[0] & 0xffffu) | (vw[1] << 16); a.y = (vw[2] & 0xffffu) | (vw[3] << 16); a.z = (vw[4] & 0xffffu) | (vw[5] << 16); a.w = (vw[6] & 0xffffu) | (vw[7] << 16);
    b.x = (vw[8] & 0xffffu) | (vw[9] << 16); b.y = (vw[10] & 0xffffu) | (vw[11] << 16); b.z = (vw[12] & 0xffffu) | (vw[13] << 16); b.w = (vw[14] & 0xffffu) | (vw[15] << 16);
    c.x = (vw[0] >> 16) | (vw[1] & 0xffff0000u); c.y = (vw[2] >> 16) | (vw[3] & 0xffff0000u); c.z = (vw[4] >> 16) | (vw[5] & 0xffff0000u); c.w = (vw[6] >> 16) | (vw[7] & 0xffff0000u);
    d.x = (vw[8] >> 16) | (vw[9] & 0xffff0000u); d.y = (vw[10] >> 16) | (vw[11] & 0xffff0000u); d.z = (vw[12] >> 16) | (vw[13] & 0xffff0000u); d.w = (vw[14] >> 16) | (vw[15] & 0xffff0000u);
    LAS unsigned char* r0 = F.lds + HG_VT + (2 * cp) * HG_VPITCH + seg * 32;
    *(LAS u32x4*)r0 = a; *(LAS u32x4*)(r0 + 16) = b; *(LAS u32x4*)(r0 + HG_VPITCH) = c; *(LAS u32x4*)(r0 + HG_VPITCH + 16) = d;
}
__device__ __forceinline__ void hg_stage_vt(const Frame& F, const bf16_t* P, int row0, int h, int seg, int cp) {
    unsigned vw[16];
#pragma unroll
    for (int i = 0; i < 16; ++i) vw[i] = *(const unsigned*)(P + (size_t)(row0 + seg * 16 + i) * PLD + 3072 + h * 128 + 2 * cp);
    u32x4 a, b, c, d;
    a.x = (vw[0] & 0xffffu) | (vw[1] << 16); a.y = (vw[2] & 0xffffu) | (vw[3] << 16); a.z = (vw[4] & 0xffffu) | (vw[5] << 16); a.w = (vw[6] & 0xffffu) | (vw[7] << 16);
    b.x = (vw[8] & 0xffffu) | (vw[9] << 16); b.y = (vw[10] & 0xffffu) | (vw[11] << 16); b.z = (vw[12] & 0xffffu) | (vw[13] << 16); b.w = (vw[14] & 0xffffu) | (vw[15] << 16);
    c.x = (vw[0] >> 16) | (vw[1] & 0xffff0000u); c.y = (vw[2] >> 16) | (vw[3] & 0xffff0000u); c.z = (vw[4] >> 16) | (vw[5] & 0xffff0000u); c.w = (vw[6] >> 16) | (vw[7] & 0xffff0000u);
    d.x = (vw[8] >> 16) | (vw[9] & 0xffff0000u); d.y = (vw[10] >> 16) | (vw[11] & 0xffff0000u); d.z = (vw[12] >> 16) | (vw[13] & 0xffff0000u); d.w = (vw[14] >> 16) | (vw[15] & 0xffff0000u);
    LAS unsigned char* r0 = F.lds + HG_VT + (2 * cp) * HG_VPITCH + seg * 32;
    *(LAS u32x4*)r0 = a; *(LAS u32x4*)(r0 + 16) = b; *(LAS u32x4*)(r0 + HG_VPITCH) = c; *(LAS u32x4*)(r0 + HG_VPITCH + 16) = d;
}
__device__ __forceinline__ void phase_hg_a(Frame& F) {
    const bf16_t* P = WSB(WS_P);
    const int dir = F.wave >> 2, seg = F.wave & 3, cp = F.lane, r = F.lane & 31, hf = F.lane >> 5;
    constexpr int HG_KD = HG_QR;
    for (int u = F.bid; u < 260 * 8; u += F.G) {
        const int tc = u >> 3, h = u & 7, row0 = tc_row0(tc), p = dir ? tc_pb(tc) : tc_pf(tc);
        __syncthreads();
        HgPrep R; hg_prep(F, P, row0, h, dir, seg, cp, R);
        if (dir == 0) hg_stage_vt(F, P, row0, h, seg, cp);
        {
            float e0[16], e1[16];
#pragma unroll
            for (int i = 0; i < 16; ++i) { e0[i] = R.k0[i] * __expf(R.tot0 - R.off0 - R.c0[i]); e1[i] = R.k1[i] * __expf(R.tot1 - R.off1 - R.c1[i]); }
            u32x4 a, b, c, d;
            if (dir == 0) {
                a.x = pk2(e0[0], e0[1]); a.y = pk2(e0[2], e0[3]); a.z = pk2(e0[4], e0[5]); a.w = pk2(e0[6], e0[7]); b.x = pk2(e0[8], e0[9]); b.y = pk2(e0[10], e0[11]); b.z = pk2(e0[12], e0[13]); b.w = pk2(e0[14], e0[15]);
                c.x = pk2(e1[0], e1[1]); c.y = pk2(e1[2], e1[3]); c.z = pk2(e1[4], e1[5]); c.w = pk2(e1[6], e1[7]); d.x = pk2(e1[8], e1[9]); d.y = pk2(e1[10], e1[11]); d.z = pk2(e1[12], e1[13]); d.w = pk2(e1[14], e1[15]);
            } else {
                a.x = pk2(e0[15], e0[14]); a.y = pk2(e0[13], e0[12]); a.z = pk2(e0[11], e0[10]); a.w = pk2(e0[9], e0[8]); b.x = pk2(e0[7], e0[6]); b.y = pk2(e0[5], e0[4]); b.z = pk2(e0[3], e0[2]); b.w = pk2(e0[1], e0[0]);
                c.x = pk2(e1[15], e1[14]); c.y = pk2(e1[13], e1[12]); c.z = pk2(e1[11], e1[10]); c.w = pk2(e1[9], e1[8]); d.x = pk2(e1[7], e1[6]); d.y = pk2(e1[5], e1[4]); d.z = pk2(e1[3], e1[2]); d.w = pk2(e1[1], e1[0]);
            }
            const int tok_lo = dir ? 48 - 16 * seg : 16 * seg;
            LAS unsigned char* r0 = F.lds + HG_KD + (dir * 128 + 2 * cp) * HG_VPITCH + tok_lo * 2;
            *(LAS u32x4*)r0 = a; *(LAS u32x4*)(r0 + 16) = b; *(LAS u32x4*)(r0 + HG_VPITCH) = c; *(LAS u32x4*)(r0 + HG_VPITCH + 16) = d;
            if (seg == 0) { float* dp = WSF(WS_DT) + ((size_t)(dir * 8 + h) * 260 + p) * 128 + 2 * cp; dp[0] = __expf(R.tot0); dp[1] = __expf(R.tot1); }
        }
        __syncthreads();
        f32x16 acc[4];
#pragma unroll
        for (int j = 0; j < 4; ++j)
#pragma unroll
            for (int i = 0; i < 16; ++i) acc[j][i] = 0.f;
#pragma unroll
        for (int ks = 0; ks < 4; ++ks) {
            const bf16x8 a = *(const LAS bf16x8*)(F.lds + HG_KD + (dir * 128 + seg * 32 + r) * HG_VPITCH + (ks * 16 + hf * 8) * 2);
#pragma unroll
            for (int j = 0; j < 4; ++j) { const bf16x8 b = *(const LAS bf16x8*)(F.lds + HG_VT + (j * 32 + r) * HG_VPITCH + (ks * 16 + hf * 8) * 2); acc[j] = MFMA32(a, b, acc[j]); }
        }
        bf16_t* st = hg_state(F, dir, h, p);
#pragma unroll
        for (int j = 0; j < 4; ++j)
#pragma unroll
            for (int g = 0; g < 4; ++g) { u32x2 w; w.x = cvt_pk_bf16(acc[j][4 * g], acc[j][4 * g + 1]); w.y = cvt_pk_bf16(acc[j][4 * g + 2], acc[j][4 * g + 3]);
                *(u32x2*)(st + ((size_t)((j * 8 + seg * 2 + (g >> 1)) * 64 + (g & 1) * 32 + r)) * 8 + 4 * hf) = w; }
    }
}
__device__ __forceinline__ void phase_hg_b(Frame& F) {
    for (int idx = F.bid * NTHR + F.tid; idx < 2 * 8 * 8192; idx += F.G * NTHR) {
        const int e2 = idx & 8191, h = (idx >> 13) & 7, dir = idx >> 16;
        const int eo = e2 * 2, dk = ((eo >> 9) & 7) * 16 + ((eo >> 8) & 1) * 8 + (eo & 7);
        unsigned* sp = (unsigned*)(hg_state(F, dir, h, 0) + eo);
        const f32x2* dp = (const f32x2*)(WSF(WS_DT) + ((size_t)(dir * 8 + h) * 260) * 128 + dk);
        float s0 = 0.f, s1 = 0.f;
        for (int p = 0; p < 260; p += 20) {
            unsigned x[20]; f32x2 d[20];
#pragma unroll
            for (int j = 0; j < 20; ++j) { x[j] = sp[(size_t)(p + j) * 8192]; d[j] = dp[(size_t)(p + j) * 64]; }
#pragma unroll
            for (int j = 0; j < 20; ++j) { sp[(size_t)(p + j) * 8192] = cvt_pk_bf16(s0, s1); s0 = d[j].x * s0 + lo_bf(x[j]); s1 = d[j].y * s1 + hi_bf(x[j]); }
        }
    }
}
__device__ __forceinline__ void phase_hg_c(Frame& F) {
    const bf16_t* P = WSB(WS_P); bf16_t* O = WSB(WS_XSA);
    const int dir = F.wave >> 2, seg = F.wave & 3, cp = F.lane, r = F.lane & 31, hf = F.lane >> 5;
    unsigned zw[16], qw_[16], vw[16];
#define HGC_LOAD(uu) do { const int tc_ = (uu) >> 3, h_ = (uu) & 7, row0_ = tc_row0(tc_); \
        _Pragma("unroll") for (int i = 0; i < 16; ++i) { const int si = seg * 16 + i, tok = dir ? 63 - si : si; const bf16_t* pr_ = P + (size_t)(row0_ + tok) * PLD + h_ * 128 + 2 * cp; \
            zw[i] = *(const unsigned*)(pr_ + 1024 + dir * 1024); qw_[i] = *(const unsigned*)pr_; } \
        if (dir == 0) { _Pragma("unroll") for (int i = 0; i < 16; ++i) vw[i] = *(const unsigned*)(P + (size_t)(row0_ + seg * 16 + i) * PLD + 3072 + h_ * 128 + 2 * cp); } } while (0)
    if (F.bid < 260 * 8) HGC_LOAD(F.bid);
    for (int u = F.bid; u < 260 * 8; u += F.G) {
        const int tc = u >> 3, h = u & 7, row0 = tc_row0(tc);
        const int tb2 = F.wave >> 2, jb = F.wave & 3;
        bf16x8 sf[16];
        {
            const bf16_t* s0p = hg_state(F, 0, h, tc_pf(tc)) + (size_t)(jb * 8 * 64 + F.lane) * 8;
            const bf16_t* s1p = hg_state(F, 1, h, tc_pb(tc)) + (size_t)(jb * 8 * 64 + F.lane) * 8;
#pragma unroll
            for (int ks = 0; ks < 8; ++ks) { sf[ks] = *(const bf16x8*)(s0p + ks * 512); sf[8 + ks] = *(const bf16x8*)(s1p + ks * 512); }
        }
        __syncthreads();
        HgPrep R; hg_prep_z(F, zw, h, dir, seg, cp, R);
        if (dir == 0) hg_stage_vt_v(F, vw, seg, cp);
        {
            const float eref0 = __expf(R.ref0), eref1 = __expf(R.ref1);
#pragma unroll
            for (int i = 0; i < 16; ++i) {
                const int si = seg * 16 + i, tok = dir ? 63 - si : si;
                const unsigned qw = qw_[i];
                const float q0 = lo_bf(qw), q1 = hi_bf(qw);
                const float a0 = R.off0 + R.c0[i] - R.ref0, a1 = R.off1 + R.c1[i] - R.ref1;
                const int lo = (dir * 64 + tok) * HG_PITCH + 4 * cp;
                const float qr0 = q0 * __expf(a0), qr1 = q1 * __expf(a1);
                *(LAS unsigned*)(F.lds + HG_QR + lo) = cvt_pk_bf16(qr0, qr1);
                *(LAS unsigned*)(F.lds + HG_KR + lo) = cvt_pk_bf16(R.k0[i] * __expf(-a0), R.k1[i] * __expf(-a1));
                *(LAS unsigned*)(F.lds + HG_QI + lo) = cvt_pk_bf16(qr0 * eref0, qr1 * eref1);
            }
        }
        __syncthreads();
        { const int un = u + F.G; if (un < 260 * 8) HGC_LOAD(un); }
        {
            const int tb = (F.wave >> 1) & 1, sb = F.wave & 1;
            f32x16 acc;
#pragma unroll
            for (int i = 0; i < 16; ++i) acc[i] = 0.f;
#pragma unroll
            for (int ks = 0; ks < 8; ++ks) {
                const bf16x8 a = *(const LAS bf16x8*)(F.lds + HG_KR + (dir * 64 + sb * 32 + r) * HG_PITCH + (ks * 16 + hf * 8) * 2);
                const bf16x8 b = *(const LAS bf16x8*)(F.lds + HG_QR + (dir * 64 + tb * 32 + r) * HG_PITCH + (ks * 16 + hf * 8) * 2);
                acc = MFMA32(a, b, acc);
            }
            const int t = tb * 32 + r;
#pragma unroll
            for (int g = 0; g < 4; ++g) {
                const int s0 = sb * 32 + 8 * g + 4 * hf; float v[4];
#pragma unroll
                for (int j = 0; j < 4; ++j) { const int s_ = s0 + j; const bool keep = dir ? (s_ >= t) : (s_ <= t); v[j] = keep ? acc[4 * g + j] : 0.f; }
                u32x2 w; w.x = pk2(v[0], v[1]); w.y = pk2(v[2], v[3]);
                *(LAS u32x2*)(F.lds + HG_ATT + t * HG_PITCH + (dir * 64 + s0) * 2) = w;
            }
        }
        __syncthreads();
        f32x16 o;
#pragma unroll
        for (int i = 0; i < 16; ++i) o[i] = 0.f;
#pragma unroll
        for (int ks = 0; ks < 8; ++ks) {
            const bf16x8 a = *(const LAS bf16x8*)(F.lds + HG_VT + (jb * 32 + r) * HG_VPITCH + ((ks & 3) * 16 + hf * 8) * 2);
            const bf16x8 b = *(const LAS bf16x8*)(F.lds + HG_ATT + (tb2 * 32 + r) * HG_PITCH + (ks * 16 + hf * 8) * 2);
            o = MFMA32(a, b, o);
        }
#pragma unroll
        for (int ks = 0; ks < 16; ++ks) {
            const bf16x8 b = *(const LAS bf16x8*)(F.lds + HG_QI + ((ks >> 3) * 64 + tb2 * 32 + r) * HG_PITCH + ((ks & 7) * 16 + hf * 8) * 2);
            o = MFMA32(sf[ks], b, o);
        }
        float ss = 0.f;
#pragma unroll
        for (int i = 0; i < 16; ++i) ss += o[i] * o[i];
        ss += __shfl_xor(ss, 32);
        LAS float* red = (LAS float*)(F.lds + HG_RED);
        if (hf == 0) red[(tb2 * 4 + jb) * 32 + r] = ss;
        __syncthreads();
        const float tot = red[(tb2 * 4 + 0) * 32 + r] + red[(tb2 * 4 + 1) * 32 + r] + red[(tb2 * 4 + 2) * 32 + r] + red[(tb2 * 4 + 3) * 32 + r];
        const float rn = rsqrtf(tot * (1.0f / 128.0f) + EPS);
        const int row = row0 + tb2 * 32 + r;
#pragma unroll
        for (int g = 0; g < 4; ++g) {
            const int dv = jb * 32 + 8 * g + 4 * hf;
            const u32x2 gw = *(const u32x2*)(P + (size_t)row * PLD + 4096 + h * 128 + dv);
            const f32x4 nw = *(const f32x4*)(F.in[12] + dv);
            u32x2 w; w.x = pk2(o[4 * g] * rn * nw[0] * lo_bf(gw.x), o[4 * g + 1] * rn * nw[1] * hi_bf(gw.x));
            w.y = pk2(o[4 * g + 2] * rn * nw[2] * lo_bf(gw.y), o[4 * g + 3] * rn * nw[3] * hi_bf(gw.y));
            *(u32x2*)(O + (size_t)row * D + h * 128 + dv) = w;
        }
    }
}


constexpr int AT_K = 0, AT_V = 2 * 9216, AT_PITCH = 144;
__device__ __forceinline__ void phase_att(Frame& F) {
    const bf16_t* QKV = WSB(WS_P); bf16_t* O = WSB(WS_XSA);
    const int r = F.lane & 31, hf = F.lane >> 5, g = F.wave >> 1, th = F.wave & 1;
    const int kkey = F.tid >> 3, kc = F.tid & 7, vkey = F.tid & 63, vdg = F.tid >> 6;
    for (int u = F.vcu; u < 1024; u += F.G) {
        const int kvh = u & 3, t0 = (u >> 2) * 64, qh = kvh * 4 + g, t = t0 + 32 * th + r;
        bf16x8 qf[4];
#pragma unroll
        for (int ks = 0; ks < 4; ++ks) qf[ks] = *(const bf16x8*)(QKV + (size_t)t * QK_LD + qh * 64 + ks * 16 + hf * 8);
        int jfirst = 0, jlast = 4;
        if (t0 - 128 < 0) jfirst = (128 - t0) >> 6;
        if (t0 + 191 >= NLAT) jlast = 4 - ((t0 + 192 - NLAT) >> 6);
        const int ntl = jlast - jfirst + 1, nt = ntl + 4;
        const bf16_t* kbase = QKV + 1024 + kvh * 64;
        u32x4 kreg, vreg;
#define AT_LOAD(it) do { const int s0_ = ((it) < ntl) ? (t0 - 128 + 64 * (jfirst + (it))) : (NLAT + 64 * ((it) - ntl)); \
            kreg = *(const u32x4*)(kbase + (size_t)(s0_ + kkey) * QK_LD + 8 * kc); vreg = *(const u32x4*)(kbase + (size_t)(s0_ + vkey) * QK_LD + 256 + 8 * vdg); } while (0)
#define AT_WRITE(b) do { *(LAS u32x4*)(F.lds + AT_K + (b) * 9216 + kkey * AT_PITCH + 16 * kc) = kreg; \
            LAS unsigned short* vp_ = (LAS unsigned short*)(F.lds + AT_V + (b) * 9216 + (8 * vdg) * AT_PITCH + vkey * 2); \
            vp_[0] = (unsigned short)(vreg.x & 0xffffu); vp_[AT_PITCH / 2] = (unsigned short)(vreg.x >> 16); vp_[2 * (AT_PITCH / 2)] = (unsigned short)(vreg.y & 0xffffu); vp_[3 * (AT_PITCH / 2)] = (unsigned short)(vreg.y >> 16); \
            vp_[4 * (AT_PITCH / 2)] = (unsigned short)(vreg.z & 0xffffu); vp_[5 * (AT_PITCH / 2)] = (unsigned short)(vreg.z >> 16); vp_[6 * (AT_PITCH / 2)] = (unsigned short)(vreg.w & 0xffffu); vp_[7 * (AT_PITCH / 2)] = (unsigned short)(vreg.w >> 16); } while (0)
        AT_LOAD(0); AT_WRITE(0);
        __syncthreads();
        float m = F.in[25][qh] * 1.4426950408889634f, l = 1.0f;
        f32x16 o0, o1;
#pragma unroll
        for (int i = 0; i < 16; ++i) { o0[i] = 0.f; o1[i] = 0.f; }
        for (int it = 0; it < nt; ++it) {
            const int b = it & 1;
            if (it + 1 < nt) AT_LOAD(it + 1);
            f32x16 x0, x1;
#pragma unroll
            for (int i = 0; i < 16; ++i) { x0[i] = 0.f; x1[i] = 0.f; }
#pragma unroll
            for (int ks = 0; ks < 4; ++ks) {
                const bf16x8 a0 = *(const LAS bf16x8*)(F.lds + AT_K + b * 9216 + r * AT_PITCH + (ks * 16 + hf * 8) * 2);
                const bf16x8 a1 = *(const LAS bf16x8*)(F.lds + AT_K + b * 9216 + (32 + r) * AT_PITCH + (ks * 16 + hf * 8) * 2);
                x0 = MFMA32(a0, qf[ks], x0); x1 = MFMA32(a1, qf[ks], x1);
            }
            if (it < ntl) { const int j = jfirst + it;
                if (j == 0 || j == 4) { const int s0 = t0 - 128 + 64 * j;
#pragma unroll
                    for (int i = 0; i < 16; ++i) { const int sk = s0 + (i & 3) + 8 * (i >> 2) + 4 * hf; const int d0 = sk - t, d1 = sk + 32 - t;
                        if (d0 < -128 || d0 > 128) x0[i] = -1e30f; if (d1 < -128 || d1 > 128) x1[i] = -1e30f; } } }
            float mx = x0[0];
#pragma unroll
            for (int i = 0; i < 16; ++i) { mx = fmaxf(mx, x0[i]); mx = fmaxf(mx, x1[i]); }
            mx = fmaxf(mx, __shfl_xor(mx, 32));
            if (__any(mx > m + 8.0f)) {
                const float mn = fmaxf(m, mx), al = __builtin_amdgcn_exp2f(m - mn); m = mn; l *= al;
#pragma unroll
                for (int i = 0; i < 16; ++i) { o0[i] *= al; o1[i] *= al; }
            }
            float ls = 0.f;
#pragma unroll
            for (int i = 0; i < 16; ++i) { x0[i] = __builtin_amdgcn_exp2f(x0[i] - m); x1[i] = __builtin_amdgcn_exp2f(x1[i] - m); ls += x0[i] + x1[i]; }
            ls += __shfl_xor(ls, 32);
            l += ls;
#pragma unroll
            for (int kt = 0; kt < 2; ++kt)
#pragma unroll
                for (int s_ = 0; s_ < 2; ++s_) {
                    u32x4 pw;
                    if (kt == 0) { pw.x = cvt_pk_bf16(x0[8 * s_], x0[8 * s_ + 1]); pw.y = cvt_pk_bf16(x0[8 * s_ + 2], x0[8 * s_ + 3]); pw.z = cvt_pk_bf16(x0[8 * s_ + 4], x0[8 * s_ + 5]); pw.w = cvt_pk_bf16(x0[8 * s_ + 6], x0[8 * s_ + 7]); }
                    else { pw.x = cvt_pk_bf16(x1[8 * s_], x1[8 * s_ + 1]); pw.y = cvt_pk_bf16(x1[8 * s_ + 2], x1[8 * s_ + 3]); pw.z = cvt_pk_bf16(x1[8 * s_ + 4], x1[8 * s_ + 5]); pw.w = cvt_pk_bf16(x1[8 * s_ + 6], x1[8 * s_ + 7]); }
                    const bf16x8 pb = __builtin_bit_cast(bf16x8, pw);
                    const int koff = (kt * 32 + 16 * s_ + 4 * hf) * 2;
                    const LAS unsigned char* v0p = F.lds + AT_V + b * 9216 + r * AT_PITCH + koff; const LAS unsigned char* v1p = v0p + 32 * AT_PITCH;
                    u32x4 a0w, a1w; const u32x2 a00 = *(const LAS u32x2*)v0p, a01 = *(const LAS u32x2*)(v0p + 16), a10 = *(const LAS u32x2*)v1p, a11 = *(const LAS u32x2*)(v1p + 16);
                    a0w.x = a00.x; a0w.y = a00.y; a0w.z = a01.x; a0w.w = a01.y; a1w.x = a10.x; a1w.y = a10.y; a1w.z = a11.x; a1w.w = a11.y;
                    o0 = MFMA32(__builtin_bit_cast(bf16x8, a0w), pb, o0); o1 = MFMA32(__builtin_bit_cast(bf16x8, a1w), pb, o1);
                }
            if (it + 1 < nt) AT_WRITE(b ^ 1);
            __syncthreads();
        }
        const float il = 1.0f / l;
#pragma unroll
        for (int g4 = 0; g4 < 4; ++g4) {
            const int d = 8 * g4 + 4 * hf;
            u32x2 w0, w1; w0.x = cvt_pk_bf16(o0[4 * g4] * il, o0[4 * g4 + 1] * il); w0.y = cvt_pk_bf16(o0[4 * g4 + 2] * il, o0[4 * g4 + 3] * il);
            w1.x = cvt_pk_bf16(o1[4 * g4] * il, o1[4 * g4 + 1] * il); w1.y = cvt_pk_bf16(o1[4 * g4 + 2] * il, o1[4 * g4 + 3] * il);
            *(u32x2*)(O + (size_t)t * D + qh * 64 + d) = w0; *(u32x2*)(O + (size_t)t * D + qh * 64 + 32 + d) = w1;
        }
#undef AT_LOAD
#undef AT_WRITE
    }
#undef HGC_LOAD
}


constexpr size_t WS_SDEC = WS_CTL + 32768;
constexpr size_t WS_TS = WS_CTL + 24576;
__device__ __forceinline__ bf16_t* ssm_state(const Frame& F, int dir, int h, int p) { return (bf16_t*)(F.ws + WS_ST) + ((size_t)(dir * 32 + h) * 65 + p) * 8192; }
constexpr int SS_PT = 528;
constexpr int SA_BT = 0, SA_XW = 128 * SS_PT, SA_SC = SA_XW + 2 * 64 * SS_PT;
constexpr int SC_BM = 0, SC_XT = 256 * 272, SC_SC = SC_XT + 64 * SS_PT, SC_ST = SC_SC + 6144;
static_assert(SA_SC + 4096 <= MISC_OFF && SC_ST + 128 * 272 <= MISC_OFF, "Mamba LDS map");
__device__ __forceinline__ float wave_incl_scan(float v, int lane) {
#pragma unroll
    for (int o = 1; o < 64; o <<= 1) { const float t = __shfl_up(v, o); if (lane >= o) v += t; }
    return v;
}
struct SsmDt { float x[4]; };
__device__ __forceinline__ void ssm_scalars_load(const Frame& F, int r0, int h, SsmDt& R) {
    if (F.wave < 2) { const int dir = F.wave;
#pragma unroll
        for (int j = 0; j < 4; ++j) { const int i = dir ? 255 - (4 * F.lane + j) : 4 * F.lane + j; R.x[j] = WSF(WS_DT)[(size_t)(r0 + i) * 64 + dir * 32 + h]; } }
}
__device__ __forceinline__ void ssm_scalars(const Frame& F, LAS float* SC, int h, const SsmDt& R) {
    if (F.wave < 2) {
        const int dir = F.wave; const float A = -__expf(F.in[18][dir * 32 + h]), dtb = F.in[17][dir * 32 + h];
        float dt[4], c[4], run = 0.f;
#pragma unroll
        for (int j = 0; j < 4; ++j) { const float x = R.x[j] + dtb; dt[j] = (x > 20.f) ? x : log1pf(__expf(x)); run += dt[j] * A; c[j] = run; }
        const float off = wave_incl_scan(run, F.lane) - run;
#pragma unroll
        for (int j = 0; j < 4; ++j) { const int i = dir ? 255 - (4 * F.lane + j) : 4 * F.lane + j; SC[dir * 256 + i] = dt[j]; SC[512 + dir * 256 + i] = off + c[j]; }
    }
    __syncthreads();
}
__device__ __forceinline__ u32x4 pack8(const float (&v)[8]) { u32x4 w; w.x = cvt_pk_bf16(v[0], v[1]); w.y = cvt_pk_bf16(v[2], v[3]); w.z = cvt_pk_bf16(v[4], v[5]); w.w = cvt_pk_bf16(v[6], v[7]); return w; }
__device__ __forceinline__ void run_geom(int ru, int& r0, int& pf, int& pb) {
    if (ru < 64) { r0 = ru * 256; pf = 1 + ru; pb = 1 + (63 - ru); } else { r0 = NLAT; pf = 0; pb = 0; }
}
__device__ __forceinline__ void phase_ssm_conv(Frame& F) {
    bf16_t* P = WSB(WS_P); const bf16_t* HALO = WSB(WS_HALO);
    for (int u = F.bid; u < 260 * 3; u += F.G) {
        const int tk = u / 3, ch = (u % 3) * 1024 + F.tid * 2;
        const bool first = (tk == 0 || tk == 256), last = (tk == 255 || tk == 259);
        unsigned raw[68];
        raw[0] = first ? 0u : *(const unsigned*)(HALO + ((size_t)tk * 4 + 0) * SSM_CD + ch); raw[1] = first ? 0u : *(const unsigned*)(HALO + ((size_t)tk * 4 + 1) * SSM_CD + ch);
        raw[66] = last ? 0u : *(const unsigned*)(HALO + ((size_t)tk * 4 + 2) * SSM_CD + ch); raw[67] = last ? 0u : *(const unsigned*)(HALO + ((size_t)tk * 4 + 3) * SSM_CD + ch);
        bf16_t* colp = P + (size_t)tk * 64 * PLD + 2048 + ch;
#pragma unroll
        for (int i = 0; i < 64; ++i) raw[2 + i] = *(const unsigned*)(colp + (size_t)i * PLD);
        float cw0[5], cw1[5];
#pragma unroll
        for (int j = 0; j < 5; ++j) { const f32x2 w = *(const f32x2*)(F.in[15] + j * SSM_CD + ch); cw0[j] = w.x; cw1[j] = w.y; }
        const f32x2 cb = *(const f32x2*)(F.in[16] + ch);
#pragma unroll
        for (int i = 0; i < 64; ++i) {
            const float a0 = cb.x + cw0[0] * lo_bf(raw[i]) + cw0[1] * lo_bf(raw[i + 1]) + cw0[2] * lo_bf(raw[i + 2]) + cw0[3] * lo_bf(raw[i + 3]) + cw0[4] * lo_bf(raw[i + 4]);
            const float a1 = cb.y + cw1[0] * hi_bf(raw[i]) + cw1[1] * hi_bf(raw[i + 1]) + cw1[2] * hi_bf(raw[i + 2]) + cw1[3] * hi_bf(raw[i + 3]) + cw1[4] * hi_bf(raw[i + 4]);
            *(unsigned*)(colp + (size_t)i * PLD) = cvt_pk_bf16(siluf_(a0), siluf_(a1));
        }
    }
}
constexpr int SCT_N = 2048;
__device__ __forceinline__ void ssm_tables(Frame& F) {
    float* T = (float*)(F.ws + WS_XSA);
    const int gw = F.vcu * NWAVES + F.wave, NGW = F.G * NWAVES;
    for (int task = gw; task < 65 * 32 * 2; task += NGW) {
        const int u = task >> 1, dir = task & 1, ru = u >> 5, h = u & 31; int r0, pf, pb; run_geom(ru, r0, pf, pb);
        const float A = -__expf(F.in[18][dir * 32 + h]), dtb = F.in[17][dir * 32 + h];
        float xr_[4];
#pragma unroll
        for (int j = 0; j < 4; ++j) { const int i = dir ? 255 - (4 * F.lane + j) : 4 * F.lane + j; xr_[j] = WSF(WS_DT)[(size_t)(r0 + i) * 64 + dir * 32 + h]; }
        float dt[4], c[4], run = 0.f;
#pragma unroll
        for (int j = 0; j < 4; ++j) { const float x = xr_[j] + dtb; dt[j] = (x > 20.f) ? x : log1pf(__expf(x)); run += dt[j] * A; c[j] = run; }
        const float off = wave_incl_scan(run, F.lane) - run;
#pragma unroll
        for (int j = 0; j < 4; ++j) c[j] += off;
        const float cref = __shfl(c[3], (F.lane & ~7) | 7);
        const float last = __shfl(c[3], 63);
        float e[4], wgt[4];
#pragma unroll
        for (int j = 0; j < 4; ++j) { e[j] = dt[j] * __expf(cref - c[j]); wgt[j] = dt[j] * __expf(last - c[j]); }
        float* tb = T + (size_t)u * SCT_N;
        if (dir == 0) { const int i0 = 4 * F.lane;
            *(f32x4*)(tb + i0) = (f32x4){dt[0], dt[1], dt[2], dt[3]}; *(f32x4*)(tb + 512 + i0) = (f32x4){c[0], c[1], c[2], c[3]};
            *(f32x4*)(tb + 1024 + i0) = (f32x4){e[0], e[1], e[2], e[3]}; *(f32x4*)(tb + 1536 + i0) = (f32x4){wgt[0], wgt[1], wgt[2], wgt[3]};
        } else { const int i0 = 252 - 4 * F.lane;
            *(f32x4*)(tb + 256 + i0) = (f32x4){dt[3], dt[2], dt[1], dt[0]}; *(f32x4*)(tb + 768 + i0) = (f32x4){c[3], c[2], c[1], c[0]};
            *(f32x4*)(tb + 1280 + i0) = (f32x4){e[3], e[2], e[1], e[0]}; *(f32x4*)(tb + 1792 + i0) = (f32x4){wgt[3], wgt[2], wgt[1], wgt[0]};
        }
        if (F.lane == 63) WSF(WS_SDEC)[(dir * 32 + h) * 65 + (dir ? pb : pf)] = __expf(last);
    }
}
__device__ __forceinline__ void phase_ssm_a(Frame& F) {
    const bf16_t* P = WSB(WS_P); const float* T = (const float*)(F.ws + WS_XSA);
    const int r = F.lane & 31, hf = F.lane >> 5;
    for (int u = F.vcu; u < 65 * 32; u += F.G) {
        const int ru = u >> 5, h = u & 31, g = h >> 3; int r0, pf, pb; run_geom(ru, r0, pf, pb);
        const int xcp = F.tid & 31, xsg = F.tid >> 5, bcp = F.tid & 63, bsg = F.tid >> 6;
        unsigned xr[16], br[32];
        { const bf16_t* xp = P + (size_t)(r0 + xsg * 16) * PLD + 2048 + h * 64 + 2 * xcp;
#pragma unroll
          for (int i = 0; i < 16; ++i) xr[i] = *(const unsigned*)(xp + (size_t)i * PLD);
          const bf16_t* bp = P + (size_t)(r0 + bsg * 32) * PLD + 4096 + g * 128 + 2 * bcp;
#pragma unroll
          for (int i = 0; i < 32; ++i) br[i] = *(const unsigned*)(bp + (size_t)i * PLD); }
        f32x4 wfv[4], wbv[4];
        { const float* tw = T + (size_t)u * SCT_N + 1536 + xsg * 16;
#pragma unroll
          for (int q = 0; q < 4; ++q) { wfv[q] = *(const f32x4*)(tw + 4 * q); wbv[q] = *(const f32x4*)(tw + 256 + 4 * q); } }
        __syncthreads();
#pragma unroll
        for (int k8 = 0; k8 < 4; ++k8) {
            u32x4 lo, hi;
            lo.x = (br[8 * k8] & 0xffffu) | (br[8 * k8 + 1] << 16); lo.y = (br[8 * k8 + 2] & 0xffffu) | (br[8 * k8 + 3] << 16); lo.z = (br[8 * k8 + 4] & 0xffffu) | (br[8 * k8 + 5] << 16); lo.w = (br[8 * k8 + 6] & 0xffffu) | (br[8 * k8 + 7] << 16);
            hi.x = (br[8 * k8] >> 16) | (br[8 * k8 + 1] & 0xffff0000u); hi.y = (br[8 * k8 + 2] >> 16) | (br[8 * k8 + 3] & 0xffff0000u); hi.z = (br[8 * k8 + 4] >> 16) | (br[8 * k8 + 5] & 0xffff0000u); hi.w = (br[8 * k8 + 6] >> 16) | (br[8 * k8 + 7] & 0xffff0000u);
            LAS unsigned char* bp = F.lds + SA_BT + (2 * bcp) * SS_PT + (bsg * 32 + k8 * 8) * 2; *(LAS u32x4*)bp = lo; *(LAS u32x4*)(bp + SS_PT) = hi;
        }
#pragma unroll
        for (int k8 = 0; k8 < 2; ++k8) {
            float f0[8], f1[8], b0[8], b1[8];
#pragma unroll
            for (int j = 0; j < 8; ++j) { const float x0 = lo_bf(xr[k8 * 8 + j]), x1 = hi_bf(xr[k8 * 8 + j]);
                const float wf = wfv[k8 * 2 + (j >> 2)][j & 3], wb = wbv[k8 * 2 + (j >> 2)][j & 3]; f0[j] = x0 * wf; f1[j] = x1 * wf; b0[j] = x0 * wb; b1[j] = x1 * wb; }
            LAS unsigned char* xp = F.lds + SA_XW + (2 * xcp) * SS_PT + (xsg * 16 + k8 * 8) * 2;
            *(LAS u32x4*)xp = pack8(f0); *(LAS u32x4*)(xp + SS_PT) = pack8(f1); *(LAS u32x4*)(xp + 64 * SS_PT) = pack8(b0); *(LAS u32x4*)(xp + 65 * SS_PT) = pack8(b1);
        }
        __syncthreads();
        const int dir = F.wave >> 2, pt = (F.wave >> 1) & 1, nt0 = 2 * (F.wave & 1);
        f32x16 acc0, acc1;
#pragma unroll
        for (int i = 0; i < 16; ++i) { acc0[i] = 0.f; acc1[i] = 0.f; }
#pragma unroll 4
        for (int ks = 0; ks < 16; ++ks) {
            const bf16x8 b = *(const LAS bf16x8*)(F.lds + SA_XW + (dir * 64 + pt * 32 + r) * SS_PT + (ks * 16 + hf * 8) * 2);
            const bf16x8 a0 = *(const LAS bf16x8*)(F.lds + SA_BT + (nt0 * 32 + r) * SS_PT + (ks * 16 + hf * 8) * 2);
            const bf16x8 a1 = *(const LAS bf16x8*)(F.lds + SA_BT + ((nt0 + 1) * 32 + r) * SS_PT + (ks * 16 + hf * 8) * 2);
            acc0 = MFMA32(a0, b, acc0); acc1 = MFMA32(a1, b, acc1);
        }
        bf16_t* st = ssm_state(F, dir, h, dir ? pb : pf) + (size_t)(pt * 32 + r) * 128;
#pragma unroll
        for (int g4 = 0; g4 < 4; ++g4) { u32x2 w0, w1; w0.x = cvt_pk_bf16(acc0[4 * g4], acc0[4 * g4 + 1]); w0.y = cvt_pk_bf16(acc0[4 * g4 + 2], acc0[4 * g4 + 3]);
            w1.x = cvt_pk_bf16(acc1[4 * g4], acc1[4 * g4 + 1]); w1.y = cvt_pk_bf16(acc1[4 * g4 + 2], acc1[4 * g4 + 3]);
            *(u32x2*)(st + nt0 * 32 + 8 * g4 + 4 * hf) = w0; *(u32x2*)(st + (nt0 + 1) * 32 + 8 * g4 + 4 * hf) = w1; }
    }
}
__device__ __forceinline__ void phase_ssm_b(Frame& F) {
    for (int idx = F.bid * NTHR + F.tid; idx < 2 * 32 * 4096; idx += F.G * NTHR) {
        const int e2 = idx & 4095, hh = idx >> 12;
        unsigned* sp = (unsigned*)((bf16_t*)(F.ws + WS_ST) + (size_t)hh * 65 * 8192) + e2;
        const float* dp = WSF(WS_SDEC) + hh * 65;
        float s0 = 0.f, s1 = 0.f;
        for (int p = 0; p < 65; p += 13) {
            unsigned x[13]; float d[13];
#pragma unroll
            for (int j = 0; j < 13; ++j) { x[j] = sp[(size_t)(p + j) * 4096]; d[j] = dp[p + j]; }
#pragma unroll
            for (int j = 0; j < 13; ++j) { sp[(size_t)(p + j) * 4096] = cvt_pk_bf16(s0, s1); s0 = d[j] * s0 + lo_bf(x[j]); s1 = d[j] * s1 + hi_bf(x[j]); }
        }
    }
}
__device__ __forceinline__ void phase_ssm_c(Frame& F, bool dry = false) {
    bf16_t* P = WSB(WS_P); LAS float* SC = (LAS float*)(F.lds + SC_SC); const float* T = (const float*)(F.ws + WS_XSA);
    const int r = F.lane & 31, hf = F.lane >> 5, w = F.wave;
    for (int u = F.vcu; u < 65 * 32; u += F.G) {
        const int ru = u >> 5, h = u & 31, g = h >> 3; int r0, pf, pb; run_geom(ru, r0, pf, pb);
        const int ti = 32 * w + r, trow = r0 + ti;
        f32x4 scv = {0.f, 0.f, 0.f, 0.f}; if (F.tid < 384) scv = *(const f32x4*)(T + (size_t)u * SCT_N + 4 * F.tid);
        bf16x8 cf[8];
#pragma unroll
        for (int ks = 0; ks < 8; ++ks) cf[ks] = *(const bf16x8*)(P + (size_t)trow * PLD + 4608 + g * 128 + ks * 16 + hf * 8);
        const int xcp = F.tid & 31, xsg = F.tid >> 5;
        unsigned xr[16];
        { const bf16_t* xp = P + (size_t)(r0 + xsg * 16) * PLD + 2048 + h * 64 + 2 * xcp;
#pragma unroll
          for (int i = 0; i < 16; ++i) xr[i] = *(const unsigned*)(xp + (size_t)i * PLD); }
        u32x4 bm[8];
#pragma unroll
        for (int k = 0; k < 8; ++k) { const int idx = F.tid + 512 * k, row = idx >> 4, c16 = idx & 15; bm[k] = *(const u32x4*)(P + (size_t)(r0 + row) * PLD + 4096 + g * 128 + c16 * 8); }
        u32x4 sv[4];
#pragma unroll
        for (int k = 0; k < 4; ++k) { const int idx = F.tid + 512 * k, dir = idx >> 10, e = idx & 1023; sv[k] = *(const u32x4*)(ssm_state(F, dir, h, dir ? pb : pf) + e * 8); }
        bf16_t* zp = P + (size_t)trow * PLD + h * 64;
        u32x2 zv[8];
#pragma unroll
        for (int g4 = 0; g4 < 4; ++g4) { zv[2 * g4] = *(const u32x2*)(zp + 8 * g4 + 4 * hf); zv[2 * g4 + 1] = *(const u32x2*)(zp + 32 + 8 * g4 + 4 * hf); }
        __syncthreads();
        if (F.tid < 384) *(LAS f32x4*)(SC + 4 * F.tid) = scv;
#pragma unroll
        for (int k = 0; k < 8; ++k) { const int idx = F.tid + 512 * k, row = idx >> 4, c16 = idx & 15; *(LAS u32x4*)(F.lds + SC_BM + row * 272 + c16 * 16) = bm[k]; }
#pragma unroll
        for (int k = 0; k < 4; ++k) { const int idx = F.tid + 512 * k, dir = idx >> 10, e = idx & 1023; *(LAS u32x4*)(F.lds + SC_ST + (dir * 64 + (e >> 4)) * 272 + (e & 15) * 16) = sv[k]; }
#pragma unroll
        for (int k8 = 0; k8 < 2; ++k8) {
            u32x4 lo, hi;
            lo.x = (xr[8 * k8] & 0xffffu) | (xr[8 * k8 + 1] << 16); lo.y = (xr[8 * k8 + 2] & 0xffffu) | (xr[8 * k8 + 3] << 16); lo.z = (xr[8 * k8 + 4] & 0xffffu) | (xr[8 * k8 + 5] << 16); lo.w = (xr[8 * k8 + 6] & 0xffffu) | (xr[8 * k8 + 7] << 16);
            hi.x = (xr[8 * k8] >> 16) | (xr[8 * k8 + 1] & 0xffff0000u); hi.y = (xr[8 * k8 + 2] >> 16) | (xr[8 * k8 + 3] & 0xffff0000u); hi.z = (xr[8 * k8 + 4] >> 16) | (xr[8 * k8 + 5] & 0xffff0000u); hi.w = (xr[8 * k8 + 6] >> 16) | (xr[8 * k8 + 7] & 0xffff0000u);
            LAS unsigned char* xp = F.lds + SC_XT + (2 * xcp) * SS_PT + (xsg * 16 + k8 * 8) * 2; *(LAS u32x4*)xp = lo; *(LAS u32x4*)(xp + SS_PT) = hi;
        }
        __syncthreads();
        const float cft = SC[512 + ti], cbt = SC[768 + ti];
        f32x16 y0, y1;
#pragma unroll
        for (int i = 0; i < 16; ++i) { y0[i] = 0.f; y1[i] = 0.f; }
#pragma unroll 1
        for (int sb = 0; sb < 8; ++sb) {
            f32x16 x;
#pragma unroll
            for (int i = 0; i < 16; ++i) x[i] = 0.f;
#pragma unroll
            for (int ks = 0; ks < 8; ++ks) { const bf16x8 a = *(const LAS bf16x8*)(F.lds + SC_BM + (sb * 32 + r) * 272 + (ks * 16 + hf * 8) * 2); x = MFMA32(a, cf[ks], x); }
            if (sb == w) {
#pragma unroll
                for (int g4 = 0; g4 < 4; ++g4) {
                    const int sl = sb * 32 + 8 * g4 + 4 * hf;
                    const f32x4 dtf = *(const LAS f32x4*)(SC + sl), dtb = *(const LAS f32x4*)(SC + 256 + sl), cfs = *(const LAS f32x4*)(SC + 512 + sl), cbs = *(const LAS f32x4*)(SC + 768 + sl);
#pragma unroll
                    for (int j = 0; j < 4; ++j) { const int s_ = sl + j; float m = 0.f;
                        if (s_ <= ti) m += __expf(cft - cfs[j]) * dtf[j];
                        if (s_ >= ti) m += __expf(cbt - cbs[j]) * dtb[j];
                        x[4 * g4 + j] *= m; }
                }
            } else {
                const bool fwd = sb < w;
                const float fac = fwd ? __expf(cft - SC[512 + sb * 32 + 31]) : __expf(cbt - SC[768 + sb * 32]);
                const LAS float* E = SC + (fwd ? 1024 : 1280) + sb * 32 + 4 * hf;
#pragma unroll
                for (int g4 = 0; g4 < 4; ++g4) { const f32x4 e4 = *(const LAS f32x4*)(E + 8 * g4);
#pragma unroll
                    for (int j = 0; j < 4; ++j) x[4 * g4 + j] *= fac * e4[j]; }
            }
#pragma unroll
            for (int s2 = 0; s2 < 2; ++s2) {
                u32x4 pw; pw.x = cvt_pk_bf16(x[8 * s2], x[8 * s2 + 1]); pw.y = cvt_pk_bf16(x[8 * s2 + 2], x[8 * s2 + 3]); pw.z = cvt_pk_bf16(x[8 * s2 + 4], x[8 * s2 + 5]); pw.w = cvt_pk_bf16(x[8 * s2 + 6], x[8 * s2 + 7]);
                const bf16x8 pb_ = __builtin_bit_cast(bf16x8, pw);
                const LAS unsigned char* a0p = F.lds + SC_XT + r * SS_PT + (sb * 32 + 16 * s2 + 4 * hf) * 2; const LAS unsigned char* a1p = a0p + 32 * SS_PT;
                const u32x2 a00 = *(const LAS u32x2*)a0p, a01 = *(const LAS u32x2*)(a0p + 16), a10 = *(const LAS u32x2*)a1p, a11 = *(const LAS u32x2*)(a1p + 16);
                u32x4 a0w, a1w; a0w.x = a00.x; a0w.y = a00.y; a0w.z = a01.x; a0w.w = a01.y; a1w.x = a10.x; a1w.y = a10.y; a1w.z = a11.x; a1w.w = a11.y;
                y0 = MFMA32(__builtin_bit_cast(bf16x8, a0w), pb_, y0); y1 = MFMA32(__builtin_bit_cast(bf16x8, a1w), pb_, y1);
            }
        }
#pragma unroll
        for (int dir = 0; dir < 2; ++dir) {
            const float e = __expf(dir ? cbt : cft);
#pragma unroll
            for (int pt = 0; pt < 2; ++pt) {
                f32x16 yd;
#pragma unroll
                for (int i = 0; i < 16; ++i) yd[i] = 0.f;
#pragma unroll
                for (int ks = 0; ks < 8; ++ks) { const bf16x8 sa = *(const LAS bf16x8*)(F.lds + SC_ST + (dir * 64 + pt * 32 + r) * 272 + (ks * 16 + hf * 8) * 2); yd = MFMA32(sa, cf[ks], yd); }
                if (pt == 0) {
#pragma unroll
                    for (int i = 0; i < 16; ++i) y0[i] += e * yd[i];
                } else {
#pragma unroll
                    for (int i = 0; i < 16; ++i) y1[i] += e * yd[i];
                }
            }
        }
        const float Dk = F.in[19][h];
        bf16_t* zo = dry ? WSB(WS_HALO) + ((size_t)(u & 255) * 256 + ti) * 64 : zp; float ssq_ = 0.f;
#pragma unroll
        for (int g4 = 0; g4 < 4; ++g4) {
            const int p0 = 8 * g4 + 4 * hf;
            const u32x2 z0 = zv[2 * g4], z1 = zv[2 * g4 + 1];
            float xa[4], xb[4];
#pragma unroll
            for (int j = 0; j < 4; ++j) { xa[j] = bf2f(*(const LAS unsigned short*)(F.lds + SC_XT + (p0 + j) * SS_PT + ti * 2)); xb[j] = bf2f(*(const LAS unsigned short*)(F.lds + SC_XT + (32 + p0 + j) * SS_PT + ti * 2)); }
            float va[4], vb[4];
            va[0] = (y0[4 * g4] + Dk * xa[0]) * siluf_(lo_bf(z0.x)); va[1] = (y0[4 * g4 + 1] + Dk * xa[1]) * siluf_(hi_bf(z0.x));
            va[2] = (y0[4 * g4 + 2] + Dk * xa[2]) * siluf_(lo_bf(z0.y)); va[3] = (y0[4 * g4 + 3] + Dk * xa[3]) * siluf_(hi_bf(z0.y));
            vb[0] = (y1[4 * g4] + Dk * xb[0]) * siluf_(lo_bf(z1.x)); vb[1] = (y1[4 * g4 + 1] + Dk * xb[1]) * siluf_(hi_bf(z1.x));
            vb[2] = (y1[4 * g4 + 2] + Dk * xb[2]) * siluf_(lo_bf(z1.y)); vb[3] = (y1[4 * g4 + 3] + Dk * xb[3]) * siluf_(hi_bf(z1.y));
            ssq_ += (va[0] * va[0] + va[1] * va[1]) + (va[2] * va[2] + va[3] * va[3]) + (vb[0] * vb[0] + vb[1] * vb[1]) + (vb[2] * vb[2] + vb[3] * vb[3]);
            u32x2 o0, o1; o0.x = cvt_pk_bf16(va[0], va[1]); o0.y = cvt_pk_bf16(va[2], va[3]); o1.x = cvt_pk_bf16(vb[0], vb[1]); o1.y = cvt_pk_bf16(vb[2], vb[3]);
            *(u32x2*)(zo + p0) = o0; *(u32x2*)(zo + 32 + p0) = o1;
        }
        ssq_ += __shfl_xor(ssq_, 32);
        if (!dry && hf == 0) WSF(WS_SSQ)[(size_t)trow * 32 + h] = ssq_;
    }
}
__device__ __forceinline__ void phase_ssm_d(Frame& F) {
    bf16_t* P = WSB(WS_P);
    const int gw = F.bid * NWAVES + F.wave, NGW = F.G * NWAVES;
    for (int it = gw; it < MALL * 4; it += NGW) {
        const int row = it >> 2, g = it & 3; const int c = g * 512 + F.lane * 8;
        const u32x4 yv = *(const u32x4*)(P + (size_t)row * PLD + c);
        float y[8] = {lo_bf(yv.x), hi_bf(yv.x), lo_bf(yv.y), hi_bf(yv.y), lo_bf(yv.z), hi_bf(yv.z), lo_bf(yv.w), hi_bf(yv.w)}; float ss = 0.f;
#pragma unroll
        for (int j = 0; j < 8; ++j) ss += y[j] * y[j];
        ss = wave_sum(ss); const float rn = rsqrtf(ss * (1.0f / 512.0f) + EPS);
        u32x4 o; o.x = cvt_pk_bf16(y[0] * rn, y[1] * rn); o.y = cvt_pk_bf16(y[2] * rn, y[3] * rn); o.z = cvt_pk_bf16(y[4] * rn, y[5] * rn); o.w = cvt_pk_bf16(y[6] * rn, y[7] * rn);
        *(u32x4*)(P + (size_t)row * PLD + c) = o;
    }
}

template <int WIN> __device__ __forceinline__ void pool_unit(const bf16_t* XS, bf16_t* DL, const LAS float* rsd, int t0, int s0, int s1, int c) {
    constexpr int HB = WIN / 2, KLO = 8 - HB, KHI = 8 + 16 + HB - 1;
    unsigned raw[32];
#pragma unroll
    for (int k = KLO; k < KHI; ++k) { const int rr = t0 - 8 + k; const int rc = rr < s0 ? s0 : (rr >= s1 ? s1 - 1 : rr); raw[k] = *(const unsigned*)(XS + (size_t)rc * D + c); }
    float p0[33], p1[33], h0[32], h1[32];
    p0[KLO] = 0.f; p1[KLO] = 0.f;
#pragma unroll
    for (int k = KLO; k < KHI; ++k) { const float rr = rsd[k]; h0[k] = rr * lo_bf(raw[k]); h1[k] = rr * hi_bf(raw[k]); p0[k + 1] = p0[k] + h0[k]; p1[k + 1] = p1[k] + h1[k]; }
#pragma unroll
    for (int j = 0; j < 16; ++j) {
        const int t = t0 + j; int lo = t - HB, hi = t + WIN - HB; lo = lo < s0 ? s0 : lo; hi = hi > s1 ? s1 : hi;
        const float inv = 1.0f / (float)(hi - lo);
        const float a0 = (p0[8 + j + WIN - HB] - p0[8 + j - HB]) * inv - h0[8 + j], a1 = (p1[8 + j + WIN - HB] - p1[8 + j - HB]) * inv - h1[8 + j];
        *(unsigned*)(DL + (size_t)t * D + c) = cvt_pk_bf16(a0, a1);
    }
}
__device__ __forceinline__ void phase_pool_delta(Frame& F) {
    LAS float* rsd = (LAS float*)F.lds;
    const bf16_t* XS = WSB(WS_XSA); bf16_t* DL = WSB(WS_P);
    const int c = F.tid * 2, gi = F.tid >> 7;
    for (int u = F.bid; u < MALL / 16; u += F.G) {
        const int t0 = u * 16, s0 = (t0 >= NLAT) ? NLAT : 0, s1 = (t0 >= NLAT) ? MALL : NLAT;
        __syncthreads();
        if (F.tid < 32) { const int rr = t0 - 8 + F.tid; float v = 0.f;
            if (rr >= s0 && rr < s1 && rr >= NLAT) v = ctx_rstd(F, rr - NLAT);
            else if (rr >= s0 && rr < s1) { const float* sp = WSF(WS_SLOTS) + (size_t)rr * 16; const f32x4 a = *(const f32x4*)sp, b_ = *(const f32x4*)(sp + 4), c_ = *(const f32x4*)(sp + 8), d = *(const f32x4*)(sp + 12);
                const float t = ((a[0] + a[1]) + (a[2] + a[3])) + ((b_[0] + b_[1]) + (b_[2] + b_[3])) + ((c_[0] + c_[1]) + (c_[2] + c_[3])) + ((d[0] + d[1]) + (d[2] + d[3]));
                v = rsqrtf(t * (1.0f / 1024.0f) + EPS); }
            rsd[F.tid] = v; }
        __syncthreads();
        if (gi == 0) pool_unit<2>(XS, DL, rsd, t0, s0, s1, c); else if (gi == 1) pool_unit<4>(XS, DL, rsd, t0, s0, s1, c);
        else if (gi == 2) pool_unit<8>(XS, DL, rsd, t0, s0, s1, c); else pool_unit<16>(XS, DL, rsd, t0, s0, s1, c);
    }
}
__device__ __forceinline__ void phase_final(Frame& F) {
    const int gw = F.bid * NWAVES + F.wave, NGW = F.G * NWAVES;
    for (int row = gw; row < NLAT; row += NGW) {
        float t = (F.lane < 16) ? WSF(WS_SLOTS)[(size_t)row * 16 + F.lane] : 0.f; t = wave_sum(t);
        const float r = rsqrtf(t * (1.0f / 1024.0f) + EPS);
        float* xr = F.out + (size_t)row * D; const _Float16* xi = (const _Float16*)(F.ws + WS_XSB) + (size_t)row * D;
#pragma unroll
        for (int j = 0; j < 2; ++j) { const int k = j * 512 + F.lane * 8; const f32x8 x = __builtin_convertvector(*(const h16x8*)(xi + k), f32x8);
            const f32x4 w0 = *(const f32x4*)(F.in[9] + k), w1 = *(const f32x4*)(F.in[9] + k + 4);
            *(f32x4*)(xr + k) = (f32x4){x[0], x[1], x[2], x[3]} * r * w0; *(f32x4*)(xr + k + 4) = (f32x4){x[4], x[5], x[6], x[7]} * r * w1; }
    }
}

enum { PH_P0A = 0, PH_P0B, PH_L0_G1, PH_L0_MA, PH_L0_MB, PH_L0_MC, PH_L0_G2, PH_L0_G3, PH_L0_G4,
       PH_L1_G1, PH_L1_CV, PH_L1_MA, PH_L1_MB, PH_L1_MC, PH_L1_MD, PH_L1_G2, PH_L1_G3, PH_L1_G4,
       PH_L2_DELTA, PH_L2_G2, PH_L2_G3, PH_L2_G4,
       PH_L3_G1, PH_L3_ATT, PH_L3_G2, PH_L3_G3, PH_L3_G4, PH_FINAL, NPHASE };
__global__ void __launch_bounds__(NTHR, 2) fwd_kernel(Args args) {
    extern __shared__ __attribute__((aligned(16))) unsigned char lds_raw[];
    Frame F; F.lds = (LAS unsigned char*)lds_raw; F.tid = threadIdx.x; F.lane = F.tid & 63; F.wave = __builtin_amdgcn_readfirstlane(F.tid >> 6);
    F.G = gridDim.x; F.bid = blockIdx.x; F.vcu = (F.G % 8 == 0) ? (F.bid % 8) * (F.G / 8) + F.bid / 8 : F.bid; F.in = args.in; F.out = args.out; F.ws = args.ws;
    volatile LAS unsigned* MISC = (volatile LAS unsigned*)(F.lds + MISC_OFF);
    for (int u = F.tid; u < 128; u += NTHR) ((LAS unsigned*)(F.lds + MISC_OFF))[u] = 0u;
    __syncthreads();
    const int lo = args.ph_lo, hi = args.ph_hi;
#if MK_ONE_LAUNCH
    XcdBarrier bar = xcd_barrier_post((unsigned*)(F.ws + WS_CTL), MISC + 8);
    if (lo < 0) cg::this_grid().sync();
    int n_ts = 0;
#define STAMP() do { STAMPX(n_ts); ++n_ts; } while (0)
    STAMP();
#define SEAM() do { xcd_barrier(bar); STAMP(); } while (0)
#else
    (void)MISC;
#define SEAM() do { } while (0)
#endif
#define IN(k) (lo <= (k) && (k) < hi)
#ifndef PHASE_MASK
#define PHASE_MASK 0xFFFFFFFFull
#endif
#ifndef DUP_MASK
#define DUP_MASK 0ull
#endif
#define PH(k, ...) do { if constexpr (((PHASE_MASK) >> (k)) & 1ull) { if (IN(k)) { __VA_ARGS__; if constexpr (((DUP_MASK) >> (k)) & 1ull) { __syncthreads(); __VA_ARGS__; } if (IN((k) + 1)) SEAM(); } } } while (0)
#define PH_EMPTY(k) do { } while (0)
    LAS unsigned char* ring = F.lds;
    const int c_ = F.bid;
#define RUN_G1(k, epi, Wt, nN, CMODE, cpar) PH(k, { Gemm g{WSB(WS_XSA), Wt, D, D, D, 0}; StaticOrder S; S.init(64, nN, F.G, c_); const int heavy_ = (64 * (nN)) % F.G; pg8::gemm_phase(ring, g, S, epi); ctx_gemm<CMODE, 8>(F, cpar, heavy_); })
    const float* XF = (const float*)(F.ws + WS_XSB);
#define RUN_G2(k, layer, BH_, Aptr, lda_, K_, Wt_, apn_, ldb_, nMr_, blat_, bctx_, xsout_) PH(k, { \
        EpiResid<BH_, true> e{blat_, F.out, WSF(WS_GATE) + ((size_t)(layer) * 2 + 0) * 2 * 1024, WSF(WS_CS) + ((size_t)(layer) * 2 + 1) * 2 * 1024, xsout_, WSF(WS_SLOTS)}; \
        Gemm g{Aptr, Wt_, lda_, ldb_, K_, apn_, 1 + (layer)}; StaticOrder S; S.init(64, 4, F.G, c_); \
        if (F.G == 256) { EpiResidLds<BH_, true> el{e.base, e.out, e.gate, e.csn, e.xs, e.slots}; pg8::gemm_phase(ring, g, S, el); } else pg8::gemm_phase(ring, g, S, e); STAMPX(34 + 4 * (1 + (layer))); \
        if (nMr_ == 65) { CtxP cp{Aptr, lda_, apn_, Wt_, ldb_, K_, 32, nullptr, nullptr, 0, nullptr, nullptr, bctx_, WSF(WS_XCTX), WSF(WS_GATE) + ((size_t)(layer) * 2 + 0) * 2 * 1024, WSF(WS_CS) + ((size_t)(layer) * 2 + 1) * 2 * 1024, xsout_, (layer) == 0}; ctx_gemm<4, (K_) / 128>(F, cp, 0); } STAMPX(35 + 4 * (1 + (layer))); })
#define RUN_G3(k, layer, nMr_, xsin_) PH(k, { \
        EpiG1<3> e{WSF(WS_SLOTS), WSF(WS_BIAS3) + (size_t)(layer) * 2 * FH2, FH2, WSB(WS_P), nullptr, nullptr}; \
        Gemm g{xsin_, WSB(WS_W_FFNIN) + (size_t)(layer) * FH2 * D, D, D, D, 0}; StaticOrder S; S.init(64, FH2 / 256, F.G, c_); pg8::gemm_phase(ring, g, S, e); \
        if (nMr_ == 65) { CtxP cp{xsin_, D, 0, WSB(WS_W_FFNIN) + (size_t)(layer) * FH2 * D, D, D, FH / 32, WSF(WS_BIAS3) + (size_t)(layer) * 2 * FH2 + FH2, WSB(WS_P), FH, nullptr, nullptr, nullptr, nullptr, nullptr, nullptr, nullptr}; ctx_gemm<3, 8>(F, cp, (64 * (FH2 / 256)) % F.G); } })
#define RUN_G4(k, layer, OH_, outp_, nMr_) PH(k, { \
        EpiResid<true, OH_> e{F.out, outp_, WSF(WS_GATE) + ((size_t)(layer) * 2 + 1) * 2 * 1024, ((layer) < 3) ? WSF(WS_CS) + ((size_t)((layer) + 1) * 2 + 0) * 2 * 1024 : (const float*)nullptr, WSB(WS_XSA), WSF(WS_SLOTS)}; \
        Gemm g{WSB(WS_P), WSB(WS_W_FFNOUT) + (size_t)(layer) * D * FH, FH, FH, FH, 0, 5 + (layer)}; StaticOrder S; S.init(64, 4, F.G, c_); \
        if (F.G == 256) { EpiResidLds<true, OH_> el{e.base, e.out, e.gate, e.csn, e.xs, e.slots}; pg8::gemm_phase(ring, g, S, el); } else pg8::gemm_phase(ring, g, S, e); STAMPX(34 + 4 * (5 + (layer))); \
        if (nMr_ == 65) { CtxP cp{WSB(WS_P), FH, 0, WSB(WS_W_FFNOUT) + (size_t)(layer) * D * FH, FH, FH, 32, nullptr, nullptr, 0, nullptr, nullptr, WSF(WS_XCTX), WSF(WS_XCTX), WSF(WS_GATE) + ((size_t)(layer) * 2 + 1) * 2 * 1024, ((layer) < 3) ? WSF(WS_CS) + ((size_t)((layer) + 1) * 2 + 0) * 2 * 1024 : (const float*)nullptr, WSB(WS_XSA)}; ctx_gemm<4, FH / 128>(F, cp, 0); } STAMPX(35 + 4 * (5 + (layer))); })

    PH(PH_P0A, phase_p0a(F));
    PH(PH_P0B, phase_p0b(F));
    { EpiG1<0> e{WSF(WS_SLOTS), WSF(WS_BIAS1), FH2, WSB(WS_P), nullptr, nullptr}; CtxP cp{WSB(WS_XSA), D, 0, WSB(WS_W_HGIN), D, D, HG_N / 32, WSF(WS_BIAS1) + FH2, WSB(WS_P), PLD, nullptr, nullptr, nullptr, nullptr, nullptr, nullptr, nullptr}; RUN_G1(PH_L0_G1, e, WSB(WS_W_HGIN), HG_N / 256, 0, cp); }
    PH(PH_L0_MA, phase_hg_a(F));
    PH(PH_L0_MB, phase_hg_b(F));
    PH(PH_L0_MC, phase_hg_c(F));
    RUN_G2(PH_L0_G2, 0, false, WSB(WS_XSA), D, D, WSB(WS_W_HGOUT), 0, D, 65, F.in[0], F.in[2], WSB(WS_XSB));
    RUN_G3(PH_L0_G3, 0, 65, WSB(WS_XSB));
    RUN_G4(PH_L0_G4, 0, true, (void*)F.out, 65);
    { EpiG1<1> e{WSF(WS_SLOTS), WSF(WS_BIAS1) + (size_t)1 * 2 * FH2, FH2, WSB(WS_P), WSF(WS_DT), WSB(WS_HALO)}; CtxP cp{WSB(WS_XSA), D, 0, WSB(WS_W_SSMIN), D, D, SSM_NP / 32, WSF(WS_BIAS1) + (size_t)1 * 2 * FH2 + FH2, WSB(WS_P), PLD, WSF(WS_DT), WSB(WS_HALO), nullptr, nullptr, nullptr, nullptr, nullptr}; RUN_G1(PH_L1_G1, e, WSB(WS_W_SSMIN), SSM_NP / 256, 1, cp); }
    PH(PH_L1_CV, phase_ssm_conv(F); ssm_tables(F));
    PH(PH_L1_MA, phase_ssm_a(F));
    PH(PH_L1_MB, phase_ssm_b(F));
    PH(PH_L1_MC, phase_ssm_c(F));
    if (F.G != 256) PH(PH_L1_MD, phase_ssm_d(F));
    PH(PH_L1_G2, {
        const float* gate_ = WSF(WS_GATE) + ((size_t)1 * 2 + 0) * 2 * 1024; const float* cs_ = WSF(WS_CS) + ((size_t)1 * 2 + 1) * 2 * 1024;
        const bool fuse_ = (F.G == 256);
        Gemm g{WSB(WS_P), WSB(WS_W_SSMOUT), PLD, SSM_DI, SSM_DI, 0, 2}; StaticOrder S; S.init(64, 4, F.G, c_);
        if (fuse_) {
            pg8::Unit u0; S.next(0, u0);
            if (F.tid < 256) {
                const float* sp = WSF(WS_SSQ) + (size_t)(u0.pm * BM + F.tid) * 32; float rg[4];
                _Pragma("unroll") for (int gq = 0; gq < 4; ++gq) { const f32x4 a = *(const f32x4*)(sp + 8 * gq), b_ = *(const f32x4*)(sp + 8 * gq + 4);
                    rg[gq] = rsqrtf((((a[0] + a[1]) + (a[2] + a[3])) + ((b_[0] + b_[1]) + (b_[2] + b_[3]))) * (1.0f / 512.0f) + EPS); }
                *(LAS f32x4*)(F.lds + RQ_OFF + F.tid * 16) = (f32x4){rg[0] / rg[1], rg[1] / rg[2], rg[2] / rg[3], rg[3]};
            }
            __syncthreads();
            EpiResidLds<true, true, true> el{(const void*)F.out, (void*)F.out, gate_, cs_, WSB(WS_XSA), WSF(WS_SLOTS)}; pg8::gemm_phase(ring, g, S, el);
        } else { EpiResid<true, true> e{(const void*)F.out, (void*)F.out, gate_, cs_, WSB(WS_XSA), WSF(WS_SLOTS)}; pg8::gemm_phase(ring, g, S, e); }
        { CtxP cp{WSB(WS_P), PLD, 0, WSB(WS_W_SSMOUT), SSM_DI, SSM_DI, 32, nullptr, nullptr, 0, nullptr, nullptr, WSF(WS_XCTX), WSF(WS_XCTX), gate_, cs_, WSB(WS_XSA), 0, fuse_ ? WSF(WS_SSQ) : (const float*)nullptr}; ctx_gemm<4, SSM_DI / 128>(F, cp, 0); }
    });
    RUN_G3(PH_L1_G3, 1, 65, WSB(WS_XSA));
    RUN_G4(PH_L1_G4, 1, true, (void*)F.out, 65);
    PH(PH_L2_DELTA, phase_pool_delta(F));
    RUN_G2(PH_L2_G2, 2, true, WSB(WS_P), D, 256, WSB(WS_W_POOL), 256, 256, 65, F.out, WSF(WS_XCTX), WSB(WS_XSB));
    RUN_G3(PH_L2_G3, 2, 65, WSB(WS_XSB));
    RUN_G4(PH_L2_G4, 2, true, (void*)F.out, 65);
    { EpiQKV e{WSF(WS_SLOTS), WSF(WS_BIAS1) + (size_t)3 * 2 * FH2, FH2, WSB(WS_P), WSF(WS_ROPE)}; CtxP cp{WSB(WS_XSA), D, 0, WSB(WS_W_QKV), D, D, ATT_N / 32, WSF(WS_BIAS1) + (size_t)3 * 2 * FH2 + FH2, WSB(WS_P), QK_LD, nullptr, nullptr, nullptr, nullptr, nullptr, nullptr, nullptr}; RUN_G1(PH_L3_G1, e, WSB(WS_W_QKV), ATT_N / 256, 2, cp); }
    PH(PH_L3_ATT, phase_att(F));
    RUN_G2(PH_L3_G2, 3, true, WSB(WS_XSA), D, D, WSB(WS_W_ATTOUT), 0, D, 64, F.out, WSF(WS_XCTX), WSB(WS_XSB));
    RUN_G3(PH_L3_G3, 3, 64, WSB(WS_XSB));
    RUN_G4(PH_L3_G4, 3, true, (void*)(F.ws + WS_XSB), 64);
    PH(PH_FINAL, phase_final(F));
    if (PA_I >= 0 || PB_I >= 0) {
        __syncthreads();
        if (PB_I >= 0) { const float eb = (float)(g_ts[PB_J < 0 ? 0 : PB_J] - g_ts[PB_I < 0 ? 0 : PB_I]) * 1e-5f;
            if (F.bid == 0) for (int row = 1 + F.wave; row <= 1024; row += 8) { float* xr = F.out + (size_t)row * D;
                for (int j = 0; j < 16; ++j) xr[j * 64 + F.lane] += eb; } }
        if (PA_I >= 0 && F.bid == 0 && F.tid == 0) { __builtin_amdgcn_s_waitcnt(0); F.out[0] += (float)(g_ts[PA_J < 0 ? 0 : PA_J] - g_ts[PA_I < 0 ? 0 : PA_I]) * 2e-5f * PA_FINE; }
    }
#undef IN
#undef PH
#undef SEAM
}

extern "C" void kernel_launch(void* const* d_in, const int* in_sizes, int n_in, void* d_out, int out_size, void* d_ws, size_t ws_size, hipStream_t stream) {
    static int grid = 0;
    if (grid == 0) {
        if (n_in != 27 || out_size != NLAT * D || ws_size < WS_END) { fprintf(stderr, "kernel_launch: unexpected shapes (n_in %d out %d ws %zu need %zu)\n", n_in, out_size, ws_size, (size_t)WS_END); grid = -1; return; }
        int dev = 0, cus = 0, per_cu = 0;
        hipGetDevice(&dev); hipDeviceGetAttribute(&cus, hipDeviceAttributeMultiprocessorCount, dev);
        if (hipFuncSetAttribute((const void*)fwd_kernel, hipFuncAttributeMaxDynamicSharedMemorySize, LDS_BYTES) != hipSuccess) { fprintf(stderr, "hipFuncSetAttribute failed\n"); grid = -1; return; }
        hipOccupancyMaxActiveBlocksPerMultiprocessor(&per_cu, (const void*)fwd_kernel, NTHR, LDS_BYTES);
        (void)hipGetLastError();
        if (per_cu < 1) { fprintf(stderr, "occupancy query says %d\n", per_cu); grid = -1; return; }
        grid = cus;
    }
    if (grid < 0) return;
    hipMemsetAsync((char*)d_ws + WS_CTL, 0, CTL_BYTES, stream);
    Args a{};
    for (int i = 0; i < 27; ++i) a.in[i] = (const float*)d_in[i];
    a.out = (float*)d_out; a.ws = (unsigned char*)d_ws;
    a.ph_lo = 0; a.ph_hi = NPHASE;
    void* kargs[] = {&a};
    hipError_t e = hipLaunchCooperativeKernel((const void*)fwd_kernel, dim3(grid), dim3(NTHR), kargs, LDS_BYTES, stream);
    if (e != hipSuccess) fprintf(stderr, "cooperative launch failed: %s\n", hipGetErrorString(e));
}
```

```cpp
#include <hip/hip_runtime.h>
#include <hip/hip_cooperative_groups.h>
#include <cstdio>
#include <cstdint>
namespace cg = cooperative_groups;

#ifndef MK_ONE_LAUNCH
#define MK_ONE_LAUNCH 1
#endif

#define LAS __attribute__((address_space(3)))
typedef unsigned short bf16_t;
typedef short bf16x8 __attribute__((ext_vector_type(8)));
typedef float f32x4 __attribute__((ext_vector_type(4)));
typedef float f32x2 __attribute__((ext_vector_type(2)));
typedef unsigned u32x4 __attribute__((ext_vector_type(4)));
typedef unsigned u32x2 __attribute__((ext_vector_type(2)));
typedef float f32x16 __attribute__((ext_vector_type(16)));
#define MFMA32(a, b, c) __builtin_amdgcn_mfma_f32_32x32x16_bf16((a), (b), (c), 0, 0, 0)

constexpr int D = 1024, NLAT = 16384, NCTX = 256, MALL = NLAT + NCTX, DEPTH = 4;
constexpr int FH = 2816, FH2 = 5632;
constexpr int HG_N = 5120;
constexpr int SSM_N = 5184, SSM_NP = 5376;
constexpr int SSM_DI = 2048, SSM_CD = 3072;
constexpr int ATT_N = 1536, QK_LD = 1536;
constexpr int PLD = 5120;
constexpr float EPS = 1e-6f;
constexpr int NWAVES = 8, NTHR = 512;
constexpr int LDS_BYTES = 147456, MISC_OFF = LDS_BYTES - 512;

constexpr size_t al256(size_t x) { return (x + 255) & ~(size_t)255; }
constexpr size_t WS_CTL = 0, CTL_BYTES = 131072;
constexpr size_t WS_MODS = WS_CTL + CTL_BYTES;
constexpr size_t WS_CS = WS_MODS + (size_t)4 * 2 * 6144 * 4;
constexpr size_t WS_GATE = WS_CS + (size_t)4 * 2 * 2 * 1024 * 4;
constexpr size_t WS_BIAS1 = WS_GATE + (size_t)4 * 2 * 2 * 1024 * 4;
constexpr size_t WS_BIAS3 = WS_BIAS1 + (size_t)4 * 2 * FH2 * 4;
constexpr size_t WS_LB = WS_BIAS3 + (size_t)4 * 2 * FH2 * 4;
constexpr size_t WS_ROPE = WS_LB + 2 * 1024 * 4;
constexpr size_t WS_SLOTS = WS_ROPE + 2 * 256 * 16 * 4;
constexpr size_t WS_XCTX = WS_SLOTS + (size_t)MALL * 16 * 4;
constexpr size_t WS_DT = WS_XCTX + (size_t)NCTX * D * 4;
constexpr size_t WS_W_HGIN = al256(WS_DT + (size_t)MALL * 64 * 4);
constexpr size_t WS_W_HGOUT = WS_W_HGIN + (size_t)HG_N * D * 2;
constexpr size_t WS_W_SSMIN = WS_W_HGOUT + (size_t)D * D * 2;
constexpr size_t WS_W_SSMOUT = WS_W_SSMIN + (size_t)SSM_NP * D * 2;
constexpr size_t WS_W_POOL = WS_W_SSMOUT + (size_t)D * SSM_DI * 2;
constexpr size_t WS_W_QKV = WS_W_POOL + (size_t)4 * 256 * 256 * 2;
constexpr size_t WS_W_ATTOUT = WS_W_QKV + (size_t)ATT_N * D * 2;
constexpr size_t WS_W_FFNIN = WS_W_ATTOUT + (size_t)D * D * 2;
constexpr size_t WS_W_FFNOUT = WS_W_FFNIN + (size_t)4 * FH2 * D * 2;
constexpr size_t WS_XSA = WS_W_FFNOUT + (size_t)4 * D * FH * 2;
constexpr size_t WS_P = WS_XSA + (size_t)MALL * D * 2;
constexpr size_t P_BYTES = (size_t)MALL * PLD * 2;
constexpr size_t WS_XSB = WS_P + (size_t)96 * 1024 * 1024;
constexpr size_t WS_ST = WS_P + P_BYTES;
constexpr size_t ST_BYTES = (size_t)2 * 5 * 260 * 128 * 128 * 2;
constexpr size_t WS_HALO = WS_ST + (size_t)72 * 1024 * 1024;
constexpr size_t WS_SSQ = WS_ST + (size_t)79 * 1024 * 1024;
constexpr size_t WS_END = WS_ST + ST_BYTES;
static_assert(WS_HALO + (size_t)260 * 4 * 3072 * 2 <= WS_SSQ && WS_SSQ + (size_t)MALL * 32 * 4 <= WS_END && (size_t)2 * 32 * 65 * 8192 * 2 <= (size_t)72 * 1024 * 1024, "halo buffer");
static_assert(WS_END <= (size_t)402653184, "workspace map exceeds 4 x largest input");
static_assert((size_t)MALL * FH * 2 <= (size_t)96 * 1024 * 1024 && WS_XSB + (size_t)NLAT * D * 4 <= WS_ST, "H / XS_B / final f32 X overlay inside P");

__device__ __forceinline__ float bf2f(bf16_t b) { return __uint_as_float(((unsigned)b) << 16); }
__device__ __forceinline__ unsigned f2bf(float f) { unsigned u = __float_as_uint(f); return (u + 0x7fffu + ((u >> 16) & 1u)) >> 16; }
__device__ __forceinline__ unsigned pk2(float lo, float hi) { return f2bf(lo) | (f2bf(hi) << 16); }
typedef __bf16 bf16v2_t __attribute__((ext_vector_type(2)));
__device__ __forceinline__ unsigned cvt_pk_bf16(float lo, float hi) { const f32x2 f = {lo, hi}; return __builtin_bit_cast(unsigned, __builtin_convertvector(f, bf16v2_t)); }
__device__ __forceinline__ float sigmoidf_(float x) { return __builtin_amdgcn_rcpf(1.0f + __expf(-x)); }
__device__ __forceinline__ float siluf_(float x) { return x * sigmoidf_(x); }
__device__ __forceinline__ float lo_bf(unsigned w) { return __uint_as_float(w << 16); }
__device__ __forceinline__ float hi_bf(unsigned w) { return __uint_as_float(w & 0xffff0000u); }
__device__ __forceinline__ float wave_sum(float v) {
#pragma unroll
    for (int o = 1; o < 64; o <<= 1) v += __shfl_xor(v, o);
    return v;
}

#define XB_TMO      128
#define XB_XCNT(j)  (256  + 64 * (j))
#define XB_XSUB(j)  (1280 + 64 * (j))
#define XB_XGEN(j)  (2304 + 64 * (j))
#define XB_TOP      3328
#define XB_TOPGEN   3392
#define XCD_BAR_WORDS 3456
#define XB_SPIN_CAP (1u << 22)
__device__ __forceinline__ unsigned xb_ld(unsigned* p)              { return __hip_atomic_load(p, __ATOMIC_RELAXED, __HIP_MEMORY_SCOPE_AGENT); }
__device__ __forceinline__ unsigned xb_add(unsigned* p, unsigned v) { return __hip_atomic_fetch_add(p, v, __ATOMIC_RELAXED, __HIP_MEMORY_SCOPE_AGENT); }
__device__ __forceinline__ unsigned xb_xcc_id() { return (unsigned)__builtin_amdgcn_s_getreg((3 << 11) | 20) & 0xFu; }
#define XB_SPIN(cond, bar) do { unsigned _sp = 0; while (cond) { __builtin_amdgcn_s_sleep(1); \
    if ((++_sp & 255u) == 0u) { if (xb_ld(&(bar)[XB_TMO])) break; if (_sp > XB_SPIN_CAP) { atomicAdd(&(bar)[XB_TMO], 1u); break; } } } } while (0)
struct XcdBarrier { unsigned* bar; unsigned x; volatile LAS unsigned* st; };
__device__ __forceinline__ XcdBarrier xcd_barrier_post(unsigned* bar, volatile LAS unsigned* st) {
    XcdBarrier b; b.bar = bar; b.x = xb_xcc_id(); b.st = st;
    if (threadIdx.x == 0) (void)xb_add(&bar[XB_XCNT(b.x)], 1u);
    return b;
}
__device__ __forceinline__ void xcd_barrier_complete(unsigned* bar, unsigned x, unsigned& nloc, unsigned& nx) {
    const unsigned G = gridDim.x * gridDim.y * gridDim.z;
    unsigned sum, cnt, mine, sp = 0u;
    for (;;) {
        sum = 0u; cnt = 0u; mine = 0u;
#pragma unroll
        for (unsigned j = 0; j < 16; ++j) { const unsigned c = xb_ld(&bar[XB_XCNT(j)]); sum += c; cnt += (c > 0u) ? 1u : 0u; mine = (j == x) ? c : mine; }
        if (sum == G) break;
        __builtin_amdgcn_s_sleep(1);
        if ((++sp & 255u) == 0u) { if (xb_ld(&bar[XB_TMO])) break; if (sp > XB_SPIN_CAP) { atomicAdd(&bar[XB_TMO], 1u); break; } }
    }
    nloc = mine > 0u ? mine : 1u; nx = cnt > 0u ? cnt : 1u;
}
__device__ __forceinline__ void xcd_barrier(const XcdBarrier& b) {
    asm volatile("s_waitcnt vmcnt(0)" ::: "memory");
    __syncthreads();
    if (threadIdx.x == 0) {
        unsigned* bar = b.bar;
        __builtin_amdgcn_s_waitcnt(0);
        unsigned nloc = b.st[0], nx = b.st[1];
        if (nloc == 0u) { xcd_barrier_complete(bar, b.x, nloc, nx); b.st[0] = nloc; b.st[1] = nx; }
        const unsigned old = xb_add(&bar[XB_XSUB(b.x)], 1u);
        const unsigned gen = old / nloc;
        if (old + 1u == (gen + 1u) * nloc) {
            __builtin_amdgcn_fence(__ATOMIC_RELEASE, "agent");
            asm volatile("s_waitcnt vmcnt(0)" ::: "memory");
            const unsigned og = xb_add(&bar[XB_TOP], 1u);
            const unsigned tg = og / nx;
            if (og + 1u == (tg + 1u) * nx) xb_add(&bar[XB_TOPGEN], 1u);
            else XB_SPIN(xb_ld(&bar[XB_TOPGEN]) == tg, bar);
            __builtin_amdgcn_fence(__ATOMIC_ACQUIRE, "agent");
            xb_add(&bar[XB_XGEN(b.x)], 1u);
            asm volatile("s_waitcnt vmcnt(0)" ::: "memory");
        } else {
            XB_SPIN(xb_ld(&bar[XB_XGEN(b.x)]) == gen, bar);
            __builtin_amdgcn_fence(__ATOMIC_ACQUIRE, "agent");
            asm volatile("s_waitcnt vmcnt(0)" ::: "memory");
        }
    }
    __syncthreads();
}

#ifndef PA_I
#define PA_I -1
#define PA_J -1
#endif
#ifndef PA_FINE
#define PA_FINE 1.0f
#endif
#ifndef PB_I
#define PB_I -1
#define PB_J -1
#endif
__device__ unsigned long long g_ts[96];
#define STAMPX(i) do { if ((PA_I >= 0 || PB_I >= 0) && blockIdx.x == 0 && threadIdx.x == 0) g_ts[(i)] = __builtin_amdgcn_s_memrealtime(); } while (0)
namespace pg8 {
constexpr int BM = 256, BK = 64, HALF = 128, HTB = HALF * BK * 2, STAGE_BYTES = 8 * HTB, NXCD = 8, WGM = 8;
__host__ __device__ __forceinline__ int lds_byte(int r, int c) { const int st = (r >> 4) * 2 + (c >> 5), rr = r & 15, cc = c & 31, ob = rr * 64 + cc * 2; return st * 1024 + (ob ^ (((ob >> 9) & 1) << 5)); }
__host__ __device__ __forceinline__ void stage_rc(int b, int& R, int& C) { const int st = b / 1024, sb = b % 1024, swz = sb ^ (((sb >> 9) & 1) << 5); R = (st >> 1) * 16 + swz / 64; C = (st & 1) * 32 + (swz % 64) / 2; }
__host__ __device__ __forceinline__ int perm32(int rho) { const int n = rho >> 4, i = rho & 15; return 8 * (i >> 2) + 4 * n + (i & 3); }
struct Unit { int pm, pn; };
struct Gemm { const bf16_t* A; const bf16_t* Bt; int lda, ldb, K, a_pn_step; int stamp = 0; };
struct StaticOrder {
    int nM, nN, nwg, G, c;
    __device__ __forceinline__ void init(int nM_, int nN_, int G_, int c_) { nM = nM_; nN = nN_; nwg = nM * nN; G = G_; c = c_; }
    __device__ __forceinline__ bool next(int i, Unit& u) const {
        const long L = (long)i * G + c; if (L >= nwg) return false;
        int wgid = (int)L; { const int q = nwg / NXCD, r = nwg % NXCD, xcd = wgid % NXCD, off = wgid / NXCD; wgid = (xcd < r ? xcd * (q + 1) : r * (q + 1) + (xcd - r) * q) + off; }
        const int nig = WGM * nN, gid = wgid / nig, fm = gid * WGM, gsz = (nM - fm) < WGM ? (nM - fm) : WGM;
        u.pm = fm + ((wgid % nig) % gsz); u.pn = (wgid % nig) / gsz; return true;
    }
};

template <class Epi, bool ALIGN_EPI = true, bool SP2 = true>
__device__ __forceinline__ void gemm_phase(LAS unsigned char* lds, const Gemm g, const StaticOrder& S, const Epi& E) {
    const int tid = threadIdx.x, wid = __builtin_amdgcn_readfirstlane(tid >> 6), lane = tid & 63, wr = wid >> 2, wc = wid & 3, fr = lane & 15, fq = lane >> 4;
    const int nt = g.K / BK;
    unsigned voffA[2], voffB[2];
#pragma unroll
    for (int i = 0; i < 2; ++i) { int R, C; stage_rc(tid * 16 + i * 8192, R, C); const int Rb = Epi::PERM ? ((R & ~31) + perm32(R & 31)) : R;
        voffA[i] = (unsigned)(R * g.lda + C) * 2u; voffB[i] = (unsigned)(Rb * g.ldb + C) * 2u; }
    const size_t kstep = (size_t)(BK * 2);
    const size_t hstepA = (size_t)HALF * g.lda * 2, hstepB = (size_t)HALF * g.ldb * 2;
    const unsigned ldsw = (unsigned)wid * 1024u;
    const int aoff = lds_byte(wr * 64 + fr, fq * 8), boff = lds_byte(wc * 32 + fr, fq * 8);
#define PG8_SA(b, h) (((b) * 2 + (h)) * HTB)
#define PG8_SB(b, h) ((4 + (b) * 2 + (h)) * HTB)
#define PG8_STAGE(bufoff, gbase, voff) do { _Pragma("unroll") for (int _i = 0; _i < 2; ++_i) \
        __builtin_amdgcn_global_load_lds((const unsigned*)((const char*)(gbase) + (voff)[_i]), (LAS unsigned*)(lds + (bufoff) + ldsw + _i * 8192), 16, 0, 0); } while (0)
#define PG8_LDA(dst, b, h) do { _Pragma("unroll") for (int m = 0; m < 4; ++m) _Pragma("unroll") for (int k = 0; k < 2; ++k) dst[m][k] = *(const LAS bf16x8*)(lds + PG8_SA(b, h) + aoff + m * 2048 + k * 1024); } while (0)
#define PG8_LDB(dst, b, h) do { _Pragma("unroll") for (int n = 0; n < 2; ++n) _Pragma("unroll") for (int k = 0; k < 2; ++k) dst[n][k] = *(const LAS bf16x8*)(lds + PG8_SB(b, h) + boff + n * 2048 + k * 1024); } while (0)
#define PG8_MMA(ai, bj, At, Bt) do { __builtin_amdgcn_s_setprio(1); _Pragma("unroll") for (int m = 0; m < 4; ++m) _Pragma("unroll") for (int n = 0; n < 2; ++n) _Pragma("unroll") for (int k = 0; k < 2; ++k) \
        acc[ai][bj][m][n] = __builtin_amdgcn_mfma_f32_16x16x32_bf16(Bt[n][k], At[m][k], acc[ai][bj][m][n], 0, 0, 0); __builtin_amdgcn_s_setprio(0); } while (0)
#define PG8_WAIT_V(n) asm volatile("s_waitcnt vmcnt(" #n ")" ::: "memory")
#define PG8_WAIT_L(n) asm volatile("s_waitcnt lgkmcnt(" #n ")" ::: "memory")
#define PG8_BAR __builtin_amdgcn_s_barrier()
#define PG8_SCHED __builtin_amdgcn_sched_barrier(0)
    Unit cur, nxt; int ui = 0;
    if (!S.next(0, cur)) return;
    f32x4 acc[2][2][4][2];
#pragma unroll
    for (int a = 0; a < 2; ++a)
#pragma unroll
        for (int b = 0; b < 2; ++b)
#pragma unroll
            for (int m = 0; m < 4; ++m)
#pragma unroll
                for (int n = 0; n < 2; ++n) acc[a][b][m][n] = (f32x4){0.f, 0.f, 0.f, 0.f};
    bf16x8 At[4][2], B0[2][2], B1[2][2];
    const char* cA = (const char*)g.A + ((size_t)cur.pm * BM * g.lda + (size_t)cur.pn * g.a_pn_step) * 2; const char* cB = (const char*)g.Bt + (size_t)cur.pn * BM * g.ldb * 2;
    if constexpr (SP2) {
        PG8_STAGE(PG8_SB(0, 0), cB, voffB); PG8_STAGE(PG8_SB(0, 1), cB + hstepB, voffB); PG8_STAGE(PG8_SA(0, 0), cA, voffA); PG8_STAGE(PG8_SA(0, 1), cA + hstepA, voffA);
        if (wr == 1) PG8_BAR;
        PG8_WAIT_V(2); PG8_BAR;
        PG8_STAGE(PG8_SB(1, 0), cB + kstep, voffB); PG8_STAGE(PG8_SA(1, 0), cA + kstep, voffA); PG8_STAGE(PG8_SB(1, 1), cB + hstepB + kstep, voffB);
        PG8_WAIT_V(6); PG8_BAR;
    } else {
        PG8_STAGE(PG8_SB(0, 0), cB, voffB); PG8_STAGE(PG8_SA(0, 0), cA, voffA); PG8_STAGE(PG8_SB(0, 1), cB + hstepB, voffB); PG8_STAGE(PG8_SA(0, 1), cA + hstepA, voffA);
        if (wr == 1) PG8_BAR;
        PG8_WAIT_V(4); PG8_BAR;
        PG8_STAGE(PG8_SB(1, 0), cB + kstep, voffB); PG8_STAGE(PG8_SA(1, 0), cA + kstep, voffA); PG8_STAGE(PG8_SB(1, 1), cB + hstepB + kstep, voffB);
        PG8_WAIT_V(6); PG8_BAR;
    }
    for (;;) {
        const bool has_next = S.next(ui + 1, nxt);
        const char* nA = has_next ? (const char*)g.A + ((size_t)nxt.pm * BM * g.lda + (size_t)nxt.pn * g.a_pn_step) * 2 : cA; const char* nB = has_next ? (const char*)g.Bt + (size_t)nxt.pn * BM * g.ldb * 2 : cB;
        for (int t = 0; t < nt; t += 2) {
            if constexpr (Epi::KSCALE) { if (t != 0 && (t & 7) == 0) E.kscale(acc, t >> 3, wr, fr, lds); }
            const bool last = (t == nt - 2);
            const char* a1 = cA + (size_t)(t + 1) * kstep;
            const char* a2 = last ? nA : cA + (size_t)(t + 2) * kstep; const char* b2 = last ? nB : cB + (size_t)(t + 2) * kstep;
            const char* a3 = a2 + kstep; const char* b3 = b2 + kstep;
            if constexpr (SP2) {
            PG8_LDB(B0, 0, 0); PG8_LDB(B1, 0, 1); PG8_SCHED; PG8_LDA(At, 0, 0); PG8_STAGE(PG8_SA(1, 1), a1 + hstepA, voffA);
            PG8_WAIT_V(8); PG8_WAIT_L(0); PG8_BAR; PG8_MMA(0, 0, At, B0); PG8_MMA(0, 1, At, B1); PG8_BAR; PG8_SCHED;
            PG8_LDA(At, 0, 1); PG8_STAGE(PG8_SB(0, 0), b2, voffB); PG8_STAGE(PG8_SB(0, 1), b2 + hstepB, voffB); PG8_STAGE(PG8_SA(0, 0), a2, voffA);
            PG8_WAIT_V(8); PG8_WAIT_L(0); PG8_BAR; PG8_MMA(1, 0, At, B0); PG8_MMA(1, 1, At, B1); PG8_BAR; PG8_SCHED;
            PG8_LDB(B0, 1, 0); PG8_LDB(B1, 1, 1); PG8_SCHED; PG8_LDA(At, 1, 0); PG8_STAGE(PG8_SA(0, 1), a2 + hstepA, voffA);
            PG8_WAIT_V(8); PG8_WAIT_L(0); PG8_BAR; PG8_MMA(0, 0, At, B0); PG8_MMA(0, 1, At, B1); PG8_BAR; PG8_SCHED;
            PG8_LDA(At, 1, 1); PG8_STAGE(PG8_SB(1, 0), b3, voffB); PG8_STAGE(PG8_SB(1, 1), b3 + hstepB, voffB); PG8_STAGE(PG8_SA(1, 0), a3, voffA);
            PG8_WAIT_V(8); PG8_WAIT_L(0); PG8_BAR; PG8_MMA(1, 0, At, B0); PG8_MMA(1, 1, At, B1); PG8_BAR; PG8_SCHED;
            } else {
            PG8_LDB(B0, 0, 0); PG8_SCHED; PG8_LDA(At, 0, 0); PG8_STAGE(PG8_SA(1, 1), a1 + hstepA, voffA);
            PG8_WAIT_L(8); PG8_BAR; PG8_WAIT_L(0); PG8_MMA(0, 0, At, B0); PG8_BAR; PG8_SCHED;
            PG8_LDB(B1, 0, 1); PG8_STAGE(PG8_SB(0, 0), b2, voffB);
            PG8_BAR; PG8_WAIT_L(0); PG8_MMA(0, 1, At, B1); PG8_BAR;
            PG8_LDA(At, 0, 1); PG8_STAGE(PG8_SA(0, 0), a2, voffA);
            PG8_BAR; PG8_WAIT_L(0); PG8_MMA(1, 0, At, B0); PG8_BAR; PG8_SCHED;
            PG8_STAGE(PG8_SB(0, 1), b2 + hstepB, voffB);
            PG8_WAIT_V(6); PG8_BAR; PG8_MMA(1, 1, At, B1); PG8_BAR;
            PG8_LDB(B0, 1, 0); PG8_SCHED; PG8_LDA(At, 1, 0); PG8_STAGE(PG8_SA(0, 1), a2 + hstepA, voffA);
            PG8_WAIT_L(8); PG8_BAR; PG8_WAIT_L(0); PG8_MMA(0, 0, At, B0); PG8_BAR; PG8_SCHED;
            PG8_LDB(B1, 1, 1); PG8_STAGE(PG8_SB(1, 0), b3, voffB);
            PG8_BAR; PG8_WAIT_L(0); PG8_MMA(0, 1, At, B1); PG8_BAR;
            PG8_LDA(At, 1, 1); PG8_STAGE(PG8_SA(1, 0), a3, voffA);
            PG8_BAR; PG8_WAIT_L(0); PG8_MMA(1, 0, At, B0); PG8_BAR; PG8_SCHED;
            PG8_STAGE(PG8_SB(1, 1), b3 + hstepB, voffB);
            PG8_WAIT_V(6); PG8_BAR; PG8_MMA(1, 1, At, B1); PG8_BAR;
            }
        }
        if (ui == 0) STAMPX(32 + 4 * g.stamp);
        if constexpr (ALIGN_EPI) { if (wr == 0) PG8_BAR; }
        if constexpr (!Epi::AFTER_DRAIN) { E(acc, cur, wr, wc, fr, fq); if (ui == 0) STAMPX(33 + 4 * g.stamp); }
        if (!has_next) break;
#pragma unroll
        for (int a = 0; a < 2; ++a)
#pragma unroll
            for (int b = 0; b < 2; ++b)
#pragma unroll
                for (int m = 0; m < 4; ++m)
#pragma unroll
                    for (int n = 0; n < 2; ++n) acc[a][b][m][n] = (f32x4){0.f, 0.f, 0.f, 0.f};
        cur = nxt; cA = nA; cB = nB; ++ui;
        if constexpr (ALIGN_EPI) { if (wr == 1) PG8_BAR; }
    }
    PG8_WAIT_V(0);
    if constexpr (!ALIGN_EPI) { if (wr == 0) PG8_BAR; }
    PG8_BAR;
    if constexpr (Epi::AFTER_DRAIN) { E.fused(acc, cur, wr, wc, fr, fq, lds, wid, lane); STAMPX(33 + 4 * g.stamp); }
#undef PG8_SA
#undef PG8_SB
#undef PG8_STAGE
#undef PG8_LDA
#undef PG8_LDB
#undef PG8_MMA
#undef PG8_WAIT_V
#undef PG8_WAIT_L
#undef PG8_BAR
#undef PG8_SCHED
}
}
using pg8::Unit; using pg8::Gemm; using pg8::StaticOrder; using pg8::HALF; using pg8::BM;

__device__ __forceinline__ void load_rstd(const float* slots, int row0, int fq, float (&rs)[2][4]) {
#pragma unroll
    for (int ai = 0; ai < 2; ++ai)
#pragma unroll
        for (int m = 0; m < 4; ++m) {
            const f32x4 s = *(const f32x4*)(slots + (size_t)(row0 + ai * HALF + m * 16) * 16 + 4 * fq);
            float t = (s.x + s.y) + (s.z + s.w); t += __shfl_xor(t, 16); t += __shfl_xor(t, 32);
            rs[ai][m] = rsqrtf(t * (1.0f / 1024.0f) + EPS);
        }
}
template <int MODE> struct EpiG1 {
    static constexpr bool PERM = true, AFTER_DRAIN = false, KSCALE = false;
    const float* slots; const float* bias; int bias_ld;
    bf16_t* O; float* DT; bf16_t* HALO;
    __device__ __forceinline__ void operator()(const f32x4 (&acc)[2][2][4][2], const Unit& u, int wr, int wc, int fr, int fq) const {
        const int row0 = u.pm * BM + wr * 64 + fr; const int var = (u.pm >= 64) ? 1 : 0;
        float rs[2][4]; load_rstd(slots, row0, fq, rs);
        const int cl = wc * 32 + 8 * fq;
        const float* bp = bias + (size_t)var * bias_ld + u.pn * BM + cl;
        f32x4 bv[2][2];
#pragma unroll
        for (int bj = 0; bj < 2; ++bj)
#pragma unroll
            for (int n = 0; n < 2; ++n) bv[bj][n] = *(const f32x4*)(bp + bj * HALF + 4 * n);
#pragma unroll
        for (int ai = 0; ai < 2; ++ai)
#pragma unroll
            for (int m = 0; m < 4; ++m) {
                const int row = row0 + ai * HALF + m * 16; const float r = rs[ai][m];
                if constexpr (MODE == 3) {
                    f32x4 g0 = acc[ai][0][m][0] * r + bv[0][0], g1 = acc[ai][0][m][1] * r + bv[0][1];
                    f32x4 u0 = acc[ai][1][m][0] * r + bv[1][0], u1 = acc[ai][1][m][1] * r + bv[1][1];
                    u32x4 w;
                    w.x = cvt_pk_bf16(siluf_(g0[0]) * u0[0], siluf_(g0[1]) * u0[1]); w.y = cvt_pk_bf16(siluf_(g0[2]) * u0[2], siluf_(g0[3]) * u0[3]);
                    w.z = cvt_pk_bf16(siluf_(g1[0]) * u1[0], siluf_(g1[1]) * u1[1]); w.w = cvt_pk_bf16(siluf_(g1[2]) * u1[2], siluf_(g1[3]) * u1[3]);
                    *(u32x4*)(O + (size_t)row * FH + u.pn * HALF + cl) = w;
                } else {
#pragma unroll
                    for (int bj = 0; bj < 2; ++bj) {
                        f32x4 v0 = acc[ai][bj][m][0] * r + bv[bj][0], v1 = acc[ai][bj][m][1] * r + bv[bj][1];
                        const int col = u.pn * BM + bj * HALF + cl;
                        if constexpr (MODE == 0) {
                            if (u.pn < 4 || u.pn >= 16) {
#pragma unroll
                                for (int j = 0; j < 4; ++j) { v0[j] = siluf_(v0[j]); v1[j] = siluf_(v1[j]); } }
                            u32x4 w; w.x = cvt_pk_bf16(v0[0], v0[1]); w.y = cvt_pk_bf16(v0[2], v0[3]); w.z = cvt_pk_bf16(v1[0], v1[1]); w.w = cvt_pk_bf16(v1[2], v1[3]);
                            *(u32x4*)(O + (size_t)row * PLD + col) = w;
                        } else if constexpr (MODE == 1) {
                            if (u.pn < 20) {
                                u32x4 w; w.x = cvt_pk_bf16(v0[0], v0[1]); w.y = cvt_pk_bf16(v0[2], v0[3]); w.z = cvt_pk_bf16(v1[0], v1[1]); w.w = cvt_pk_bf16(v1[2], v1[3]);
                                *(u32x4*)(O + (size_t)row * PLD + col) = w;
                                if (u.pn >= 8) {
                                    const int rm = row & 63, tk = row >> 6;
                                    if (rm >= 62 && tk + 1 < 260) *(u32x4*)(HALO + ((size_t)(tk + 1) * 4 + (rm - 62)) * SSM_CD + (col - 2048)) = w;
                                    if (rm < 2 && tk >= 1) *(u32x4*)(HALO + ((size_t)(tk - 1) * 4 + 2 + rm) * SSM_CD + (col - 2048)) = w;
                                }
                            } else if (bj == 0 && wc < 2) {
                                float* dp = DT + (size_t)row * 64 + cl; *(f32x4*)dp = v0; *(f32x4*)(dp + 4) = v1;
                            }
                        }
                    }
                }
            }
    }
};
struct EpiQKV {
    static constexpr bool PERM = true, AFTER_DRAIN = false, KSCALE = false;
    const float* slots; const float* bias; int bias_ld; bf16_t* O; const float* rope;
    __device__ __forceinline__ void operator()(const f32x4 (&acc)[2][2][4][2], const Unit& u, int wr, int wc, int fr, int fq) const {
        const int row0 = u.pm * BM + wr * 64 + fr; const int var = (u.pm >= 64) ? 1 : 0;
        float rs[2][4]; load_rstd(slots, row0, fq, rs);
        const int cl = wc * 32 + 8 * fq;
        const float* bp = bias + (size_t)var * bias_ld + u.pn * BM + cl;
        f32x4 bv[2][2];
#pragma unroll
        for (int bj = 0; bj < 2; ++bj)
#pragma unroll
            for (int n = 0; n < 2; ++n) bv[bj][n] = *(const f32x4*)(bp + bj * HALF + 4 * n);
        const float qs = (u.pn < 4) ? 0.125f * 1.4426950408889634f : 1.0f;     const float sg = (fq < 2) ? -1.f : 1.f; const bool do_rope = (var == 0) && (u.pn < 5);
        bf16_t* op = O + (size_t)row0 * QK_LD + u.pn * BM + cl;
#pragma unroll
        for (int ai = 0; ai < 2; ++ai)
#pragma unroll
            for (int m = 0; m < 4; ++m) { const int row = row0 + ai * HALF + m * 16; const float r = rs[ai][m];
                f32x4 c0 = {1.f, 1.f, 1.f, 1.f}, c1 = c0, s0 = {0.f, 0.f, 0.f, 0.f}, s1 = s0;
                if (do_rope) { const int pos = (wc & 1) ? (row & 63) : (row >> 6); const float* cp = rope + pos * 16 + 8 * (fq & 1);
                    c0 = *(const f32x4*)cp; c1 = *(const f32x4*)(cp + 4); s0 = *(const f32x4*)(cp + 4096) * sg; s1 = *(const f32x4*)(cp + 4100) * sg; }
#pragma unroll
                for (int bj = 0; bj < 2; ++bj) { f32x4 v0 = acc[ai][bj][m][0] * r + bv[bj][0], v1 = acc[ai][bj][m][1] * r + bv[bj][1];
                    f32x4 p0, p1;
#pragma unroll
                    for (int j = 0; j < 4; ++j) { p0[j] = __shfl_xor(v0[j], 32); p1[j] = __shfl_xor(v1[j], 32); }
                    v0 = (v0 * c0 + p0 * s0) * qs; v1 = (v1 * c1 + p1 * s1) * qs;
                    u32x4 w; w.x = cvt_pk_bf16(v0[0], v0[1]); w.y = cvt_pk_bf16(v0[2], v0[3]); w.z = cvt_pk_bf16(v1[0], v1[1]); w.w = cvt_pk_bf16(v1[2], v1[3]);
                    *(u32x4*)(op + (size_t)(ai * HALF + m * 16) * QK_LD + bj * HALF) = w; }
                asm volatile("" ::: "memory"); }
    }
};
typedef _Float16 h16x4 __attribute__((ext_vector_type(4)));
typedef _Float16 h16x8 __attribute__((ext_vector_type(8)));
typedef float f32x8 __attribute__((ext_vector_type(8)));
template <bool BH, bool OH> struct EpiResid {
    static constexpr bool PERM = false, AFTER_DRAIN = false, KSCALE = false;
    const void* base; void* out;
    const float* gate; const float* csn; bf16_t* xs; float* slots;
    __device__ __forceinline__ void operator()(const f32x4 (&acc)[2][2][4][2], const Unit& u, int wr, int wc, int fr, int fq) const {
        const int row0 = u.pm * BM + wr * 64 + fr, col0 = u.pn * BM + wc * 32 + 4 * fq;
        f32x4 gv[2][2], cv[2][2];
#pragma unroll
        for (int bj = 0; bj < 2; ++bj)
#pragma unroll
            for (int n = 0; n < 2; ++n) { gv[bj][n] = *(const f32x4*)(gate + col0 + bj * HALF + n * 16);
                cv[bj][n] = csn ? *(const f32x4*)(csn + col0 + bj * HALF + n * 16) : (f32x4){0.f, 0.f, 0.f, 0.f}; }
#pragma unroll
        for (int ai = 0; ai < 2; ++ai)
#pragma unroll
            for (int m = 0; m < 4; ++m) {
                const int row = row0 + ai * HALF + m * 16; const size_t off = (size_t)row * D + col0; float ss = 0.f;
#pragma unroll
                for (int bj = 0; bj < 2; ++bj)
#pragma unroll
                    for (int n = 0; n < 2; ++n) {
                        f32x4 b;
                        if constexpr (BH) b = __builtin_convertvector(*(const h16x4*)((const _Float16*)base + off + bj * HALF + n * 16), f32x4);
                        else b = *(const f32x4*)((const float*)base + off + bj * HALF + n * 16);
                        const f32x4 x = b + gv[bj][n] * acc[ai][bj][m][n];
                        if constexpr (OH) *(h16x4*)((_Float16*)out + off + bj * HALF + n * 16) = __builtin_convertvector(x, h16x4);
                        else *(f32x4*)((float*)out + off + bj * HALF + n * 16) = x;
                        ss += (x[0] * x[0] + x[1] * x[1]) + (x[2] * x[2] + x[3] * x[3]);
                        if (csn) { const f32x4 y = x * cv[bj][n]; u32x2 w; w.x = cvt_pk_bf16(y[0], y[1]); w.y = cvt_pk_bf16(y[2], y[3]); *(u32x2*)(xs + off + bj * HALF + n * 16) = w; }
                    }
                ss += __shfl_xor(ss, 16); ss += __shfl_xor(ss, 32);
                if (fq == 0) slots[(size_t)row * 16 + u.pn * 4 + wc] = ss;
            }
    }
};

constexpr int RQ_OFF = 133120;
template <bool BH, bool OH, bool KS = false> struct EpiResidLds {
    static constexpr bool PERM = false, AFTER_DRAIN = true, KSCALE = KS;
    __device__ __forceinline__ void kscale(f32x4 (&acc)[2][2][4][2], int g, int wr, int fr, LAS unsigned char* lds) const {
        const LAS float* RQ = (const LAS float*)(lds + RQ_OFF);
#pragma unroll
        for (int ai = 0; ai < 2; ++ai)
#pragma unroll
            for (int m = 0; m < 4; ++m) { const float q = RQ[(ai * HALF + wr * 64 + m * 16 + fr) * 4 + (g - 1)];
#pragma unroll
                for (int bj = 0; bj < 2; ++bj)
#pragma unroll
                    for (int n = 0; n < 2; ++n) acc[ai][bj][m][n] = acc[ai][bj][m][n] * q; }
    }
    const void* base; void* out;
    const float* gate; const float* csn; bf16_t* xs; float* slots;
    __device__ __forceinline__ void fused(const f32x4 (&acc)[2][2][4][2], const Unit& u, int wr, int wc, int fr, int fq, LAS unsigned char* lds, int wid, int lane) const {
        constexpr int PITCH = 1040;
        const int hl = lane & 31, hw = lane >> 5;
        const int colg = u.pn * BM + 8 * hl;
        const f32x4 gv0 = *(const f32x4*)(gate + colg), gv1 = *(const f32x4*)(gate + colg + 4);
        const f32x4 cv0 = csn ? *(const f32x4*)(csn + colg) : (f32x4){0.f, 0.f, 0.f, 0.f}, cv1 = csn ? *(const f32x4*)(csn + colg + 4) : (f32x4){0.f, 0.f, 0.f, 0.f};
        h16x8 bh[BH ? 16 : 1]; f32x4 bf[BH ? 1 : 16];
        if constexpr (BH) {
#pragma unroll
            for (int q = 0; q < 16; ++q) bh[q] = *(const h16x8*)((const _Float16*)base + (size_t)(u.pm * BM + (q >> 3) * HALF + wid * 16 + 2 * (q & 7) + hw) * D + colg);
        }
#pragma unroll
        for (int ai = 0; ai < 2; ++ai) {
            if constexpr (!BH) {
#pragma unroll
                for (int q = 0; q < 8; ++q) { const float* bp_ = (const float*)base + (size_t)(u.pm * BM + ai * HALF + wid * 16 + 2 * q + hw) * D + colg; bf[2 * q] = *(const f32x4*)bp_; bf[2 * q + 1] = *(const f32x4*)(bp_ + 4); }
            }
#pragma unroll
            for (int m = 0; m < 4; ++m)
#pragma unroll
                for (int bj = 0; bj < 2; ++bj)
#pragma unroll
                    for (int n = 0; n < 2; ++n) *(LAS f32x4*)(lds + (wr * 64 + m * 16 + fr) * PITCH + (bj * HALF + wc * 32 + n * 16 + fq * 4) * 4) = acc[ai][bj][m][n];
            __syncthreads();
#pragma unroll
            for (int st = 0; st < 8; ++st) {
                const int lr = wid * 16 + 2 * st + hw, row = u.pm * BM + ai * HALF + lr; const size_t off = (size_t)row * D + colg;
                f32x4 a0 = *(const LAS f32x4*)(lds + lr * PITCH + hl * 32), a1 = *(const LAS f32x4*)(lds + lr * PITCH + hl * 32 + 16);
                if constexpr (KS) { const float q_ = ((const LAS float*)(lds + RQ_OFF))[(ai * HALF + lr) * 4 + 3]; a0 = a0 * q_; a1 = a1 * q_; }
                f32x4 b0, b1;
                if constexpr (BH) { const f32x8 bb = __builtin_convertvector(bh[ai * 8 + st], f32x8); b0 = (f32x4){bb[0], bb[1], bb[2], bb[3]}; b1 = (f32x4){bb[4], bb[5], bb[6], bb[7]}; }
                else { b0 = bf[2 * st]; b1 = bf[2 * st + 1]; }
                const f32x4 x0 = b0 + gv0 * a0, x1 = b1 + gv1 * a1;
                if constexpr (OH) { const h16x4 l_ = __builtin_convertvector(x0, h16x4), h_ = __builtin_convertvector(x1, h16x4);
                    *(h16x8*)((_Float16*)out + off) = (h16x8){l_[0], l_[1], l_[2], l_[3], h_[0], h_[1], h_[2], h_[3]}; }
                else { *(f32x4*)((float*)out + off) = x0; *(f32x4*)((float*)out + off + 4) = x1; }
                if (csn) { const f32x4 y0 = x0 * cv0, y1 = x1 * cv1; u32x4 w; w.x = cvt_pk_bf16(y0[0], y0[1]); w.y = cvt_pk_bf16(y0[2], y0[3]); w.z = cvt_pk_bf16(y1[0], y1[1]); w.w = cvt_pk_bf16(y1[2], y1[3]); *(u32x4*)(xs + off) = w; }
                float ss = ((x0[0] * x0[0] + x0[1] * x0[1]) + (x0[2] * x0[2] + x0[3] * x0[3])) + ((x1[0] * x1[0] + x1[1] * x1[1]) + (x1[2] * x1[2] + x1[3] * x1[3]));
#pragma unroll
                for (int o = 1; o < 32; o <<= 1) ss += __shfl_xor(ss, o);
                if (hl < 4) slots[(size_t)row * 16 + u.pn * 4 + hl] = (hl == 0) ? ss : 0.f;
            }
            __syncthreads();
        }
    }
};

struct Args { const float* in[27]; float* out; unsigned char* ws; int ph_lo, ph_hi; };
struct Frame {
    LAS unsigned char* lds; int tid, lane, wave, G, bid, vcu;
    const float* const* in; float* out; unsigned char* ws;
};
#define WSF(off) ((float*)(F.ws + (off)))
#define WSB(off) ((bf16_t*)(F.ws + (off)))


constexpr size_t WS_CSS = WS_CTL + 65536;
__device__ __forceinline__ float ctx_rstd(const Frame& F, int crow_) {
    const float* p = WSF(WS_CSS) + crow_ * 32; float t = 0.f;
#pragma unroll
    for (int j = 0; j < 8; ++j) { const f32x4 v = *(const f32x4*)(p + 4 * j); t += (v[0] + v[1]) + (v[2] + v[3]); }
    return rsqrtf(t * (1.0f / 1024.0f) + EPS);
}
struct CtxP { const bf16_t* A; int lda, a_grp_step; const bf16_t* Wt; int ldb, K, ncb; const float* bias; bf16_t* O; int ldo; float* DT; bf16_t* HALO;
              const float* base; float* xout; const float* gate; const float* csn; bf16_t* xs; int dbg = 0; const float* ssq = nullptr; };
template <int MODE, int NKS> __device__ __forceinline__ void ctx_gemm(Frame& F, const CtxP p, int heavy) {
    const int r = F.lane & 31, hf = F.lane >> 5, w = F.wave;
    if (F.bid < heavy) return;
    const int t0_ = F.bid - heavy, tstep_ = F.G - heavy;
    constexpr int nks = NKS; const int kslice = NKS * 16;
    LAS float* red = (LAS float*)F.lds;
    LAS float* ssq = (LAS float*)(F.lds + 65536);
    if (p.dbg) STAMPX(80);
    for (int t = t0_; t < p.ncb * 8; t += tstep_) {
        const int cb = t >> 3, rb = t & 7;
        const bf16_t* ap = p.A + (size_t)(NLAT + rb * 32 + r) * p.lda + (cb >> 3) * p.a_grp_step + w * kslice + hf * 8;
        int wrow = cb * 32 + r; if (MODE == 3) wrow = 256 * (cb >> 2) + 32 * (cb & 3) + r;
        const bf16_t* bp = p.Wt + (size_t)wrow * p.ldb + w * kslice + hf * 8;
        f32x16 acc, acc2;
#pragma unroll
        for (int i = 0; i < 16; ++i) { acc[i] = 0.f; acc2[i] = 0.f; }
        const int e_ln = F.tid & 63, e_g4 = (F.tid >> 6) & 3, e_rr = e_ln & 31, e_hh = e_ln >> 5;
        const int e_crow = rb * 32 + e_rr, e_col = cb * 32 + 8 * e_g4 + 4 * e_hh;
        f32x4 pe0 = {0.f, 0.f, 0.f, 0.f}, pe1 = pe0, pe2 = pe0; float pe_rs = 0.f;
        if (F.tid < 256) {
            if (MODE == 4) { pe0 = *(const f32x4*)(p.base + (size_t)e_crow * D + e_col); pe1 = *(const f32x4*)(p.gate + D + e_col); if (p.csn) pe2 = *(const f32x4*)(p.csn + D + e_col); }
            else { pe_rs = ctx_rstd(F, e_crow);
                if (MODE == 3) { const int brow = 256 * (cb >> 2) + 32 * (cb & 3) + 8 * e_g4 + 4 * e_hh; pe0 = *(const f32x4*)(p.bias + brow); pe1 = *(const f32x4*)(p.bias + brow + 128); }
                else pe0 = *(const f32x4*)(p.bias + e_col); }
        }
        constexpr int KB = (NKS > 16) ? (NKS + 1) / 2 : 8;
#pragma unroll
        for (int k0 = 0; k0 < nks; k0 += KB) {
            bf16x8 a[KB], b[KB], b2[KB];
#pragma unroll
            for (int j = 0; j < KB; ++j) if (k0 + j < nks) { a[j] = *(const bf16x8*)(ap + (k0 + j) * 16); b[j] = *(const bf16x8*)(bp + (k0 + j) * 16); if (MODE == 3) b2[j] = *(const bf16x8*)(bp + (size_t)128 * p.ldb + (k0 + j) * 16); }
#pragma unroll
            for (int j = 0; j < KB; ++j) if (k0 + j < nks) { acc = MFMA32(b[j], a[j], acc); if (MODE == 3) acc2 = MFMA32(b2[j], a[j], acc2); }
            if (nks > KB) asm volatile("" ::: "memory");
        }
        if (p.dbg) STAMPX(81);
        if (MODE == 4 && p.ssq) { const float* sp_ = p.ssq + (size_t)(NLAT + rb * 32 + r) * 32 + (w >> 1) * 8; const f32x4 s0_ = *(const f32x4*)sp_, s1_ = *(const f32x4*)(sp_ + 4);
            const float rg = rsqrtf((((s0_[0] + s0_[1]) + (s0_[2] + s0_[3])) + ((s1_[0] + s1_[1]) + (s1_[2] + s1_[3]))) * (1.0f / 512.0f) + EPS);
#pragma unroll
            for (int i = 0; i < 16; ++i) acc[i] *= rg; }
        __syncthreads();
#pragma unroll
        for (int i = 0; i < 16; ++i) { red[(w * 16 + i) * 64 + F.lane] = acc[i]; if (MODE == 3) red[8192 + (w * 16 + i) * 64 + F.lane] = acc2[i]; }
        __syncthreads();
        if (p.dbg) STAMPX(82);
        float ss = 0.f;
        if (F.tid < 256) {
            const int ln = F.tid & 63, g4 = F.tid >> 6, rr = ln & 31, hh = ln >> 5;
            float v[4], v2[4];
#pragma unroll
            for (int j = 0; j < 4; ++j) { float sa = 0.f, sb = 0.f;
#pragma unroll
                for (int ww = 0; ww < 8; ++ww) { sa += red[(ww * 16 + 4 * g4 + j) * 64 + ln]; if (MODE == 3) sb += red[8192 + (ww * 16 + 4 * g4 + j) * 64 + ln]; }
                v[j] = sa; v2[j] = sb; }
            const int crow_ = rb * 32 + rr, row = NLAT + crow_, col = cb * 32 + 8 * g4 + 4 * hh;
            if (MODE == 4) {
                const f32x4 b_ = pe0, gt = pe1;
                f32x4 x; x[0] = b_[0] + gt[0] * v[0]; x[1] = b_[1] + gt[1] * v[1]; x[2] = b_[2] + gt[2] * v[2]; x[3] = b_[3] + gt[3] * v[3];
                *(f32x4*)(p.xout + (size_t)crow_ * D + col) = x;
                ss = (x[0] * x[0] + x[1] * x[1]) + (x[2] * x[2] + x[3] * x[3]);
                if (p.csn) { const f32x4 c_ = pe2; u32x2 o; o.x = cvt_pk_bf16(x[0] * c_[0], x[1] * c_[1]); o.y = cvt_pk_bf16(x[2] * c_[2], x[3] * c_[3]); *(u32x2*)(p.xs + (size_t)row * D + col) = o; }
            } else {
                const float rs = pe_rs;
                if (MODE == 3) {
                    const f32x4 bg = pe0, bu = pe1;
                    u32x2 o; o.x = cvt_pk_bf16(siluf_(v[0] * rs + bg[0]) * (v2[0] * rs + bu[0]), siluf_(v[1] * rs + bg[1]) * (v2[1] * rs + bu[1]));
                    o.y = cvt_pk_bf16(siluf_(v[2] * rs + bg[2]) * (v2[2] * rs + bu[2]), siluf_(v[3] * rs + bg[3]) * (v2[3] * rs + bu[3]));
                    *(u32x2*)(p.O + (size_t)row * p.ldo + col) = o;
                } else {
                    const f32x4 bv = pe0;
                    float y[4];
#pragma unroll
                    for (int j = 0; j < 4; ++j) y[j] = v[j] * rs + bv[j];
                    if (MODE == 0 && (col < 1024 || col >= 4096)) {
#pragma unroll
                        for (int j = 0; j < 4; ++j) y[j] = siluf_(y[j]); }
                    if (MODE == 1 && col >= 5120) { if (col < 5184) *(f32x4*)(p.DT + (size_t)row * 64 + (col - 5120)) = (f32x4){y[0], y[1], y[2], y[3]}; }
                    else {
                        u32x2 o; o.x = cvt_pk_bf16(y[0], y[1]); o.y = cvt_pk_bf16(y[2], y[3]);
                        *(u32x2*)(p.O + (size_t)row * p.ldo + col) = o;
                        if (MODE == 1 && col >= 2048) { const int rm = row & 63, tk = row >> 6;
                            if (rm >= 62 && tk + 1 < 260) *(u32x2*)(p.HALO + ((size_t)(tk + 1) * 4 + (rm - 62)) * SSM_CD + (col - 2048)) = o;
                            if (rm < 2 && tk >= 1) *(u32x2*)(p.HALO + ((size_t)(tk - 1) * 4 + 2 + rm) * SSM_CD + (col - 2048)) = o; }
                    }
                }
            }
        }
        if (p.dbg) STAMPX(83);
        if (MODE == 4) {
            ss += __shfl_xor(ss, 32);
            if (F.tid < 256 && (F.tid & 63) < 32) ssq[(F.tid >> 6) * 32 + (F.tid & 31)] = ss;
            __syncthreads();
            if (F.tid < 32) WSF(WS_CSS)[(rb * 32 + F.tid) * 32 + cb] = (ssq[F.tid] + ssq[32 + F.tid]) + (ssq[64 + F.tid] + ssq[96 + F.tid]);
        }
    }
    if (p.dbg) STAMPX(84);
    __syncthreads();
    if (p.dbg) STAMPX(85);
}

__device__ __forceinline__ void transpose_item(const float* W, int K, int Nsrc, bf16_t* WT, int dst_row0, int src_col0, int kb, LAS float* scr, int lane, const float* ksc) {
    const int k0 = 64 * kb;
    f32x4 v[8];
    if (src_col0 >= 0) {
        const float* wp = W + (size_t)(k0 + (lane >> 3)) * Nsrc + src_col0 + 4 * (lane & 7);
#pragma unroll
        for (int i = 0; i < 8; ++i) v[i] = *(const f32x4*)(wp + (size_t)(8 * i) * Nsrc);
        if (ksc) {
#pragma unroll
            for (int i = 0; i < 8; ++i) v[i] = v[i] * ksc[k0 + (lane >> 3) + 8 * i]; }
    } else {
#pragma unroll
        for (int i = 0; i < 8; ++i) v[i] = (f32x4){0.f, 0.f, 0.f, 0.f};
    }
#pragma unroll
    for (int i = 0; i < 8; ++i) { LAS float* d = scr + ((lane >> 3) + 8 * i) * 33 + 4 * (lane & 7); d[0] = v[i][0]; d[1] = v[i][1]; d[2] = v[i][2]; d[3] = v[i][3]; }
    asm volatile("s_waitcnt lgkmcnt(0)" ::: "memory");
    const int c = lane & 7;
#pragma unroll
    for (int j = 0; j < 4; ++j) { const int n = (lane >> 3) + 8 * j; const LAS float* s = scr + (8 * c) * 33 + n;
        u32x4 o; o.x = pk2(s[0 * 33], s[1 * 33]); o.y = pk2(s[2 * 33], s[3 * 33]); o.z = pk2(s[4 * 33], s[5 * 33]); o.w = pk2(s[6 * 33], s[7 * 33]);
        *(u32x4*)(WT + (size_t)(dst_row0 + n) * K + k0 + 8 * c) = o; }
    asm volatile("s_waitcnt lgkmcnt(0)" ::: "memory");
}
struct ConvJob { int in_idx; size_t src_off; int K, Nsrc, Ndst, mode; size_t dst; };
__device__ __forceinline__ void phase_p0a(Frame& F) {
    {
        LAS float* sv = (LAS float*)F.lds;
        LAS float* red = sv + 2048;
        for (int i = F.tid; i < 2048; i += NTHR) { const float x = (i < 1024) ? F.in[1][i] : F.in[3][i - 1024]; sv[i] = siluf_(x); }
        __syncthreads();
        for (int task = F.bid; task < 256; task += F.G) {
            const int layer = task >> 6, cg_ = task & 63, krow = F.tid >> 5, c4 = F.tid & 31;
            f32x4 aL = {0.f, 0.f, 0.f, 0.f}, aC = {0.f, 0.f, 0.f, 0.f};
            if (c4 < 24) {
                const float* wp = F.in[4] + (size_t)layer * 1024 * 6144 + cg_ * 96 + c4 * 4;
#pragma unroll 8
                for (int j = 0; j < 64; ++j) { const int k = krow + 16 * j; const f32x4 w = *(const f32x4*)(wp + (size_t)k * 6144); aL += w * sv[k]; aC += w * sv[1024 + k]; }
                LAS float* r = red + (krow * 24 + c4) * 8;
                r[0] = aL[0]; r[1] = aL[1]; r[2] = aL[2]; r[3] = aL[3]; r[4] = aC[0]; r[5] = aC[1]; r[6] = aC[2]; r[7] = aC[3];
            }
            __syncthreads();
            if (F.tid < 192) { const int var = F.tid / 96, cc = F.tid % 96; float s = 0.f;
#pragma unroll
                for (int kr = 0; kr < 16; ++kr) s += red[(kr * 24 + (cc >> 2)) * 8 + var * 4 + (cc & 3)];
                const int n = cg_ * 96 + cc; WSF(WS_MODS)[((size_t)layer * 2 + var) * 6144 + n] = s + F.in[5][layer * 6144 + n]; }
            __syncthreads();
        }
    }
    {
        const int gt = F.bid * NTHR + F.tid, GT = F.G * NTHR;
        for (int i = gt; i < 2048; i += GT) {
            const int dir = i >> 10, d = i & 1023; float v[5], mx = -1e30f;
#pragma unroll
            for (int j = 0; j < 5; ++j) { v[j] = F.in[11][(dir * 5 + j) * 1024 + d]; mx = fmaxf(mx, v[j]); }
            float s = 0.f;
#pragma unroll
            for (int j = 0; j < 5; ++j) { v[j] = __expf(v[j] - mx); s += v[j]; }
            WSF(WS_LB)[i] = v[0] / s;
        }
        for (int i = gt; i < 4096; i += GT) {
            const int pos = i >> 4, f = i & 15;
            const float inv = powf(10000.0f, -(float)(2 * f) / 32.0f); const float ang = (float)pos * inv;
            const double rev = (double)ang * 0.15915494309189533577; const float fr_ = (float)(rev - floor(rev));
            WSF(WS_ROPE)[i] = __builtin_amdgcn_cosf(fr_); WSF(WS_ROPE)[4096 + i] = __builtin_amdgcn_sinf(fr_);
        }
    }
    {
        LAS float* scr = (LAS float*)(F.lds + F.wave * 8704);
        const int gw = F.bid * NWAVES + F.wave, NGW = F.G * NWAVES;
        constexpr int NJ = 19;
        const ConvJob jobs[NJ] = {
            {10, 0, 1024, HG_N, HG_N, 0, WS_W_HGIN}, {13, 0, 1024, 1024, 1024, 0, WS_W_HGOUT},
            {14, 0, 1024, SSM_N, SSM_NP, 0, WS_W_SSMIN}, {21, 0, 2048, 1024, 1024, 0, WS_W_SSMOUT},
            {22, 0, 256, 256, 256, 0, WS_W_POOL}, {22, 65536, 256, 256, 256, 0, WS_W_POOL + 131072}, {22, 131072, 256, 256, 256, 0, WS_W_POOL + 262144}, {22, 196608, 256, 256, 256, 0, WS_W_POOL + 393216},
            {24, 0, 1024, ATT_N, ATT_N, 0, WS_W_QKV}, {26, 0, 1024, 1024, 1024, 0, WS_W_ATTOUT},
            {7, 0, 1024, FH2, FH2, 1, WS_W_FFNIN}, {7, (size_t)1024 * FH2, 1024, FH2, FH2, 1, WS_W_FFNIN + (size_t)FH2 * 1024 * 2},
            {7, (size_t)2 * 1024 * FH2, 1024, FH2, FH2, 1, WS_W_FFNIN + (size_t)2 * FH2 * 1024 * 2}, {7, (size_t)3 * 1024 * FH2, 1024, FH2, FH2, 1, WS_W_FFNIN + (size_t)3 * FH2 * 1024 * 2},
            {8, 0, FH, 1024, 1024, 0, WS_W_FFNOUT}, {8, (size_t)FH * 1024, FH, 1024, 1024, 0, WS_W_FFNOUT + (size_t)1024 * FH * 2},
            {8, (size_t)2 * FH * 1024, FH, 1024, 1024, 0, WS_W_FFNOUT + (size_t)2 * 1024 * FH * 2}, {8, (size_t)3 * FH * 1024, FH, 1024, 1024, 0, WS_W_FFNOUT + (size_t)3 * 1024 * FH * 2},
            {0, 0, 0, 0, 0, 0, 0}};
        int total = 0;
#pragma unroll
        for (int j = 0; j < NJ - 1; ++j) total += (jobs[j].Ndst / 32) * (jobs[j].K / 64);
        for (int it = gw; it < total; it += NGW) {
            int r = it, j = 0;
#pragma unroll
            for (int jj = 0; jj < NJ - 1; ++jj) { const int n = (jobs[jj].Ndst / 32) * (jobs[jj].K / 64); if (j == jj && r >= n) { r -= n; j = jj + 1; } }
            int in_idx = 0, K = 0, Nsrc = 0, Ndst = 0, mode = 0; size_t so = 0, dst = 0;
#pragma unroll
            for (int jj = 0; jj < NJ - 1; ++jj) if (j == jj) { in_idx = jobs[jj].in_idx; so = jobs[jj].src_off; K = jobs[jj].K; Nsrc = jobs[jj].Nsrc; Ndst = jobs[jj].Ndst; mode = jobs[jj].mode; dst = jobs[jj].dst; }
            const int nblk = Ndst / 32, kb = r / nblk, nb = r % nblk; const int drow = nb * 32;
            int scol;
            if (mode == 1) { const int pn = drow >> 8, w = drow & 255; scol = (w < 128) ? (pn * 128 + w) : (FH + pn * 128 + (w - 128)); }
            else scol = (drow < Nsrc) ? drow : -1;
            transpose_item(F.in[in_idx] + so, K, Nsrc, WSB(dst), drow, scol, kb, scr, F.lane, (in_idx == 21) ? F.in[20] : (const float*)nullptr);
        }
    }
}

__device__ __forceinline__ void phase_p0b(Frame& F) {
    const int gt = F.bid * NTHR + F.tid, GT = F.G * NTHR;
    const float* mods = WSF(WS_MODS);
    for (int i = gt; i < 4 * 2 * 2 * 1024; i += GT) {
        const int k = i & 1023, var = (i >> 10) & 1, nrm = (i >> 11) & 1, layer = i >> 12;
        const float sc = mods[((size_t)layer * 2 + var) * 6144 + (nrm ? 4 : 1) * 1024 + k];
        WSF(WS_CS)[i] = F.in[6][(layer * 2 + nrm) * 1024 + k] * (1.0f + sc);
        float g = mods[((size_t)layer * 2 + var) * 6144 + (nrm ? 5 : 2) * 1024 + k];
        if (layer == 2 && nrm == 0) g *= F.in[23][k];
        WSF(WS_GATE)[i] = g;
    }
    const int gw = F.bid * NWAVES + F.wave, NGW = F.G * NWAVES;
    {
        constexpr int R0 = HG_N, R1 = SSM_NP, R3 = ATT_N, RF = 4 * FH2, RT = R0 + R1 + R3 + RF;
        for (int it = gw * 4; it < RT; it += NGW * 4) {
            int r = it, layer, which, n; const bf16_t* wt;
            if (r < R0) { layer = 0; which = 0; n = r; wt = WSB(WS_W_HGIN) + (size_t)n * D; }
            else if ((r -= R0) < R1) { layer = 1; which = 0; n = r; wt = WSB(WS_W_SSMIN) + (size_t)n * D; }
            else if ((r -= R1) < R3) { layer = 3; which = 0; n = r; wt = WSB(WS_W_QKV) + (size_t)n * D; }
            else { r -= R3; layer = r / FH2; which = 1; n = r % FH2; wt = WSB(WS_W_FFNIN) + ((size_t)layer * FH2 + n) * D; }
            u32x4 w[4][2];
#pragma unroll
            for (int q = 0; q < 4; ++q)
#pragma unroll
                for (int h = 0; h < 2; ++h) w[q][h] = *(const u32x4*)(wt + (size_t)q * D + h * 512 + F.lane * 8);
            float aL[4] = {0.f, 0.f, 0.f, 0.f}, aC[4] = {0.f, 0.f, 0.f, 0.f};
#pragma unroll
            for (int h = 0; h < 2; ++h) {
                const int k0 = h * 512 + F.lane * 8;
                const float* sL = mods + ((size_t)layer * 2 + 0) * 6144 + (which ? 3 : 0) * 1024 + k0; const float* sC = sL + 6144;
                const f32x4 l0 = *(const f32x4*)sL, l1 = *(const f32x4*)(sL + 4), c0 = *(const f32x4*)sC, c1 = *(const f32x4*)(sC + 4);
#pragma unroll
                for (int q = 0; q < 4; ++q) { const u32x4 ww = w[q][h];
                    const float w0 = lo_bf(ww.x), w1 = hi_bf(ww.x), w2 = lo_bf(ww.y), w3 = hi_bf(ww.y), w4 = lo_bf(ww.z), w5 = hi_bf(ww.z), w6 = lo_bf(ww.w), w7 = hi_bf(ww.w);
                    aL[q] += w0 * l0[0] + w1 * l0[1] + w2 * l0[2] + w3 * l0[3] + w4 * l1[0] + w5 * l1[1] + w6 * l1[2] + w7 * l1[3];
                    aC[q] += w0 * c0[0] + w1 * c0[1] + w2 * c0[2] + w3 * c0[3] + w4 * c1[0] + w5 * c1[1] + w6 * c1[2] + w7 * c1[3]; }
            }
#pragma unroll
            for (int q = 0; q < 4; ++q) { aL[q] = wave_sum(aL[q]); aC[q] = wave_sum(aC[q]); }
            if (F.lane == 0) { float* bp = WSF(which ? WS_BIAS3 : WS_BIAS1) + (size_t)layer * 2 * FH2 + n;
#pragma unroll
                for (int q = 0; q < 4; ++q) { bp[q] = aL[q]; bp[FH2 + q] = aC[q]; } }
        }
    }
    for (int row2 = gw * 2; row2 < MALL; row2 += NGW * 2) {
        f32x4 x[2][4];
#pragma unroll
        for (int q = 0; q < 2; ++q) { const int row = row2 + q; const float* xr = (row >= NLAT) ? F.in[2] + (size_t)(row - NLAT) * D : F.in[0] + (size_t)row * D;
#pragma unroll
            for (int j = 0; j < 2; ++j) { x[q][2 * j] = *(const f32x4*)(xr + j * 512 + F.lane * 8); x[q][2 * j + 1] = *(const f32x4*)(xr + j * 512 + F.lane * 8 + 4); } }
#pragma unroll
        for (int q = 0; q < 2; ++q) {
            const int row = row2 + q, var = row >= NLAT; float ss = 0.f;
#pragma unroll
            for (int j = 0; j < 2; ++j) {
                const int k = j * 512 + F.lane * 8; u32x4 w;
#pragma unroll
                for (int e = 0; e < 2; ++e) { const f32x4 xv = x[q][2 * j + e];
                    const f32x4 nw = *(const f32x4*)(F.in[6] + k + 4 * e); const f32x4 sc = *(const f32x4*)(mods + (size_t)var * 6144 + 1024 + k + 4 * e);
                    ss += (xv[0] * xv[0] + xv[1] * xv[1]) + (xv[2] * xv[2] + xv[3] * xv[3]);
                    const f32x4 y = xv * (nw * (sc + 1.0f));
                    if (e == 0) { w.x = pk2(y[0], y[1]); w.y = pk2(y[2], y[3]); } else { w.z = pk2(y[0], y[1]); w.w = pk2(y[2], y[3]); } }
                *(u32x4*)(WSB(WS_XSA) + (size_t)row * D + k) = w;
            }
            ss = wave_sum(ss);
            if (var) { if (F.lane < 32) WSF(WS_CSS)[(row - NLAT) * 32 + F.lane] = (F.lane == 0) ? ss : 0.f; }
            else if (F.lane < 16) WSF(WS_SLOTS)[(size_t)row * 16 + F.lane] = (F.lane == 0) ? ss : 0.f;
        }
    }
}

__device__ __forceinline__ int tc_row0(int tc) { return tc < 256 ? tc * 64 : NLAT + (tc - 256) * 64; }
__device__ __forceinline__ int tc_pf(int tc) { return tc < 256 ? 4 + tc : tc - 256; }
__device__ __forceinline__ int tc_pb(int tc) { return tc < 256 ? 4 + 255 - tc : 3 - (tc - 256); }
__device__ __forceinline__ bf16_t* hg_state(const Frame& F, int dir, int h, int p) {
    return (h < 5) ? (bf16_t*)(F.ws + WS_ST) + ((size_t)(dir * 5 + h) * 260 + p) * 16384 : (bf16_t*)F.out + ((size_t)(dir * 3 + (h - 5)) * 260 + p) * 16384;
}
constexpr int HG_VT = 0, HG_QR = 18432, HG_KR = 53248, HG_QI = 88064, HG_ATT = 122880, HG_SEG = 140288, HG_RED = 144384;
constexpr int HG_PITCH = 272, HG_VPITCH = 144;
static_assert(HG_RED + 1024 <= MISC_OFF, "HGRN LDS map");
struct HgPrep { float k0[16], k1[16], c0[16], c1[16], off0, off1, tot0, tot1, ref0, ref1; };
__device__ __forceinline__ void hg_prep(const Frame& F, const bf16_t* P, int row0, int h, int dir, int seg, int cp, HgPrep& R) {
    const float lb0 = WSF(WS_LB)[dir * 1024 + h * 128 + 2 * cp], lb1 = WSF(WS_LB)[dir * 1024 + h * 128 + 2 * cp + 1];
    unsigned zw[16];
#pragma unroll
    for (int i = 0; i < 16; ++i) { const int si = seg * 16 + i, tok = dir ? 63 - si : si; zw[i] = *(const unsigned*)(P + (size_t)(row0 + tok) * PLD + 1024 + dir * 1024 + h * 128 + 2 * cp); }
    float a0 = 0.f, a1 = 0.f;
#pragma unroll
    for (int i = 0; i < 16; ++i) {
        const float s0 = sigmoidf_(lo_bf(zw[i])), s1 = sigmoidf_(hi_bf(zw[i]));
        a0 += __logf(lb0 + (1.f - lb0) * s0); a1 += __logf(lb1 + (1.f - lb1) * s1);
        R.c0[i] = a0; R.c1[i] = a1; R.k0[i] = (1.f - lb0) * (1.f - s0); R.k1[i] = (1.f - lb1) * (1.f - s1);
    }
    LAS float* sg = (LAS float*)(F.lds + HG_SEG) + (dir * 4) * 128 + 2 * cp;
    sg[seg * 128] = a0; sg[seg * 128 + 1] = a1;
    __syncthreads();
    float o0 = 0.f, o1 = 0.f, t0 = 0.f, t1 = 0.f;
#pragma unroll
    for (int s_ = 0; s_ < 4; ++s_) { const float x0 = sg[s_ * 128], x1 = sg[s_ * 128 + 1]; if (s_ < seg) { o0 += x0; o1 += x1; } t0 += x0; t1 += x1; }
    R.off0 = o0; R.off1 = o1; R.tot0 = t0; R.tot1 = t1; R.ref0 = sg[0] + sg[128]; R.ref1 = sg[1] + sg[129];
}
__device__ __forceinline__ void hg_prep_z(const Frame& F, const unsigned (&zw)[16], int h, int dir, int seg, int cp, HgPrep& R) {
    const float lb0 = WSF(WS_LB)[dir * 1024 + h * 128 + 2 * cp], lb1 = WSF(WS_LB)[dir * 1024 + h * 128 + 2 * cp + 1];
    float p0 = 1.f, p1 = 1.f;
#pragma unroll
    for (int i = 0; i < 16; ++i) {
        const float s0 = sigmoidf_(lo_bf(zw[i])), s1 = sigmoidf_(hi_bf(zw[i]));
        p0 *= lb0 + (1.f - lb0) * s0; p1 *= lb1 + (1.f - lb1) * s1;
        R.c0[i] = p0; R.c1[i] = p1; R.k0[i] = (1.f - lb0) * (1.f - s0); R.k1[i] = (1.f - lb1) * (1.f - s1);
    }
    const float a0 = __logf(p0), a1 = __logf(p1);
    LAS float* sg = (LAS float*)(F.lds + HG_SEG) + (dir * 4) * 128 + 2 * cp;
    sg[seg * 128] = a0; sg[seg * 128 + 1] = a1;
    __syncthreads();
    float o0 = 0.f, o1 = 0.f, t0 = 0.f, t1 = 0.f;
#pragma unroll
    for (int s_ = 0; s_ < 4; ++s_) { const float x0 = sg[s_ * 128], x1 = sg[s_ * 128 + 1]; if (s_ < seg) { o0 += x0; o1 += x1; } t0 += x0; t1 += x1; }
    R.off0 = o0; R.off1 = o1; R.tot0 = t0; R.tot1 = t1; R.ref0 = sg[0] + sg[128]; R.ref1 = sg[1] + sg[129];
}
__device__ __forceinline__ void hg_stage_vt_v(const Frame& F, const unsigned (&vw)[16], int seg, int cp) {
    u32x4 a, b, c, d;
    a.x = (vw[0] & 0xffffu) | (vw[1] << 16); a.y = (vw[2] & 0xffffu) | (vw[3] << 16); a.z = (vw[4] & 0xffffu) | (vw[5] << 16); a.w = (vw[6] & 0xffffu) | (vw[7] << 16);
    b.x = (vw[8] & 0xffffu) | (vw[9] << 16); b.y = (vw[10] & 0xffffu) | (vw[11] << 16); b.z = (vw[12] & 0xffffu) | (vw[13] << 16); b.w = (vw[14] & 0xffffu) | (vw[15] << 16);
    c.x = (vw[0] >> 16) | (vw[1] & 0xffff0000u); c.y = (vw[2] >> 16) | (vw[3] & 0xffff0000u); c.z = (vw[4] >> 16) | (vw[5] & 0xffff0000u); c.w = (vw[6] >> 16) | (vw[7] & 0xffff0000u);
    d.x = (vw[8] >> 16) | (vw[9] & 0xffff0000u); d.y = (vw[10] >> 16) | (vw[11] & 0xffff0000u); d.z = (vw[12] >> 16) | (vw[13] & 0xffff0000u); d.w = (vw[14] >> 16) | (vw[15] & 0xffff0000u);
    LAS unsigned char* r0 = F.lds + HG_VT + (2 * cp) * HG_VPITCH + seg * 32;
    *(LAS u32x4*)r0 = a; *(LAS u32x4*)(r0 + 16) = b; *(LAS u32x4*)(r0 + HG_VPITCH) = c; *(LAS u32x4*)(r0 + HG_VPITCH + 16) = d;
}
__device__ __forceinline__ void hg_stage_vt(const Frame& F, const bf16_t* P, int row0, int h, int seg, int cp) {
    unsigned vw[16];
#pragma unroll
    for (int i = 0; i < 16; ++i) vw[i] = *(const unsigned*)(P + (size_t)(row0 + seg * 16 + i) * PLD + 3072 + h * 128 + 2 * cp);
    u32x4 a, b, c, d;
    a.x = (vw[0] & 0xffffu) | (vw[1] << 16); a.y = (vw[2] & 0xffffu) | (vw[3] << 16); a.z = (vw[4] & 0xffffu) | (vw[5] << 16); a.w = (vw[6] & 0xffffu) | (vw[7] << 16);
    b.x = (vw[8] & 0xffffu) | (vw[9] << 16); b.y = (vw[10] & 0xffffu) | (vw[11] << 16); b.z = (vw[12] & 0xffffu) | (vw[13] << 16); b.w = (vw[14] & 0xffffu) | (vw[15] << 16);
    c.x = (vw[0] >> 16) | (vw[1] & 0xffff0000u); c.y = (vw[2] >> 16) | (vw[3] & 0xffff0000u); c.z = (vw[4] >> 16) | (vw[5] & 0xffff0000u); c.w = (vw[6] >> 16) | (vw[7] & 0xffff0000u);
    d.x = (vw[8] >> 16) | (vw[9] & 0xffff0000u); d.y = (vw[10] >> 16) | (vw[11] & 0xffff0000u); d.z = (vw[12] >> 16) | (vw[13] & 0xffff0000u); d.w = (vw[14] >> 16) | (vw[15] & 0xffff0000u);
    LAS unsigned char* r0 = F.lds + HG_VT + (2 * cp) * HG_VPITCH + seg * 32;
    *(LAS u32x4*)r0 = a; *(LAS u32x4*)(r0 + 16) = b; *(LAS u32x4*)(r0 + HG_VPITCH) = c; *(LAS u32x4*)(r0 + HG_VPITCH + 16) = d;
}
__device__ __forceinline__ void phase_hg_a(Frame& F) {
    const bf16_t* P = WSB(WS_P);
    const int dir = F.wave >> 2, seg = F.wave & 3, cp = F.lane, r = F.lane & 31, hf = F.lane >> 5;
    constexpr int HG_KD = HG_QR;
    for (int u = F.bid; u < 260 * 8; u += F.G) {
        const int tc = u >> 3, h = u & 7, row0 = tc_row0(tc), p = dir ? tc_pb(tc) : tc_pf(tc);
        __syncthreads();
        HgPrep R; hg_prep(F, P, row0, h, dir, seg, cp, R);
        if (dir == 0) hg_stage_vt(F, P, row0, h, seg, cp);
        {
            float e0[16], e1[16];
#pragma unroll
            for (int i = 0; i < 16; ++i) { e0[i] = R.k0[i] * __expf(R.tot0 - R.off0 - R.c0[i]); e1[i] = R.k1[i] * __expf(R.tot1 - R.off1 - R.c1[i]); }
            u32x4 a, b, c, d;
            if (dir == 0) {
                a.x = pk2(e0[0], e0[1]); a.y = pk2(e0[2], e0[3]); a.z = pk2(e0[4], e0[5]); a.w = pk2(e0[6], e0[7]); b.x = pk2(e0[8], e0[9]); b.y = pk2(e0[10], e0[11]); b.z = pk2(e0[12], e0[13]); b.w = pk2(e0[14], e0[15]);
                c.x = pk2(e1[0], e1[1]); c.y = pk2(e1[2], e1[3]); c.z = pk2(e1[4], e1[5]); c.w = pk2(e1[6], e1[7]); d.x = pk2(e1[8], e1[9]); d.y = pk2(e1[10], e1[11]); d.z = pk2(e1[12], e1[13]); d.w = pk2(e1[14], e1[15]);
            } else {
                a.x = pk2(e0[15], e0[14]); a.y = pk2(e0[13], e0[12]); a.z = pk2(e0[11], e0[10]); a.w = pk2(e0[9], e0[8]); b.x = pk2(e0[7], e0[6]); b.y = pk2(e0[5], e0[4]); b.z = pk2(e0[3], e0[2]); b.w = pk2(e0[1], e0[0]);
                c.x = pk2(e1[15], e1[14]); c.y = pk2(e1[13], e1[12]); c.z = pk2(e1[11], e1[10]); c.w = pk2(e1[9], e1[8]); d.x = pk2(e1[7], e1[6]); d.y = pk2(e1[5], e1[4]); d.z = pk2(e1[3], e1[2]); d.w = pk2(e1[1], e1[0]);
            }
            const int tok_lo = dir ? 48 - 16 * seg : 16 * seg;
            LAS unsigned char* r0 = F.lds + HG_KD + (dir * 128 + 2 * cp) * HG_VPITCH + tok_lo * 2;
            *(LAS u32x4*)r0 = a; *(LAS u32x4*)(r0 + 16) = b; *(LAS u32x4*)(r0 + HG_VPITCH) = c; *(LAS u32x4*)(r0 + HG_VPITCH + 16) = d;
            if (seg == 0) { float* dp = WSF(WS_DT) + ((size_t)(dir * 8 + h) * 260 + p) * 128 + 2 * cp; dp[0] = __expf(R.tot0); dp[1] = __expf(R.tot1); }
        }
        __syncthreads();
        f32x16 acc[4];
#pragma unroll
        for (int j = 0; j < 4; ++j)
#pragma unroll
            for (int i = 0; i < 16; ++i) acc[j][i] = 0.f;
#pragma unroll
        for (int ks = 0; ks < 4; ++ks) {
            const bf16x8 a = *(const LAS bf16x8*)(F.lds + HG_KD + (dir * 128 + seg * 32 + r) * HG_VPITCH + (ks * 16 + hf * 8) * 2);
#pragma unroll
            for (int j = 0; j < 4; ++j) { const bf16x8 b = *(const LAS bf16x8*)(F.lds + HG_VT + (j * 32 + r) * HG_VPITCH + (ks * 16 + hf * 8) * 2); acc[j] = MFMA32(a, b, acc[j]); }
        }
        bf16_t* st = hg_state(F, dir, h, p);
#pragma unroll
        for (int j = 0; j < 4; ++j)
#pragma unroll
            for (int g = 0; g < 4; ++g) { u32x2 w; w.x = cvt_pk_bf16(acc[j][4 * g], acc[j][4 * g + 1]); w.y = cvt_pk_bf16(acc[j][4 * g + 2], acc[j][4 * g + 3]);
                *(u32x2*)(st + ((size_t)((j * 8 + seg * 2 + (g >> 1)) * 64 + (g & 1) * 32 + r)) * 8 + 4 * hf) = w; }
    }
}
__device__ __forceinline__ void phase_hg_b(Frame& F) {
    for (int idx = F.bid * NTHR + F.tid; idx < 2 * 8 * 8192; idx += F.G * NTHR) {
        const int e2 = idx & 8191, h = (idx >> 13) & 7, dir = idx >> 16;
        const int eo = e2 * 2, dk = ((eo >> 9) & 7) * 16 + ((eo >> 8) & 1) * 8 + (eo & 7);
        unsigned* sp = (unsigned*)(hg_state(F, dir, h, 0) + eo);
        const f32x2* dp = (const f32x2*)(WSF(WS_DT) + ((size_t)(dir * 8 + h) * 260) * 128 + dk);
        float s0 = 0.f, s1 = 0.f;
        for (int p = 0; p < 260; p += 20) {
            unsigned x[20]; f32x2 d[20];
#pragma unroll
            for (int j = 0; j < 20; ++j) { x[j] = sp[(size_t)(p + j) * 8192]; d[j] = dp[(size_t)(p + j) * 64]; }
#pragma unroll
            for (int j = 0; j < 20; ++j) { sp[(size_t)(p + j) * 8192] = cvt_pk_bf16(s0, s1); s0 = d[j].x * s0 + lo_bf(x[j]); s1 = d[j].y * s1 + hi_bf(x[j]); }
        }
    }
}
__device__ __forceinline__ void phase_hg_c(Frame& F) {
    const bf16_t* P = WSB(WS_P); bf16_t* O = WSB(WS_XSA);
    const int dir = F.wave >> 2, seg = F.wave & 3, cp = F.lane, r = F.lane & 31, hf = F.lane >> 5;
    unsigned zw[16], qw_[16], vw[16];
#define HGC_LOAD(uu) do { const int tc_ = (uu) >> 3, h_ = (uu) & 7, row0_ = tc_row0(tc_); \
        _Pragma("unroll") for (int i = 0; i < 16; ++i) { const int si = seg * 16 + i, tok = dir ? 63 - si : si; const bf16_t* pr_ = P + (size_t)(row0_ + tok) * PLD + h_ * 128 + 2 * cp; \
            zw[i] = *(const unsigned*)(pr_ + 1024 + dir * 1024); qw_[i] = *(const unsigned*)pr_; } \
        if (dir == 0) { _Pragma("unroll") for (int i = 0; i < 16; ++i) vw[i] = *(const unsigned*)(P + (size_t)(row0_ + seg * 16 + i) * PLD + 3072 + h_ * 128 + 2 * cp); } } while (0)
    if (F.bid < 260 * 8) HGC_LOAD(F.bid);
    for (int u = F.bid; u < 260 * 8; u += F.G) {
        const int tc = u >> 3, h = u & 7, row0 = tc_row0(tc);
        const int tb2 = F.wave >> 2, jb = F.wave & 3;
        bf16x8 sf[16];
        {
            const bf16_t* s0p = hg_state(F, 0, h, tc_pf(tc)) + (size_t)(jb * 8 * 64 + F.lane) * 8;
            const bf16_t* s1p = hg_state(F, 1, h, tc_pb(tc)) + (size_t)(jb * 8 * 64 + F.lane) * 8;
#pragma unroll
            for (int ks = 0; ks < 8; ++ks) { sf[ks] = *(const bf16x8*)(s0p + ks * 512); sf[8 + ks] = *(const bf16x8*)(s1p + ks * 512); }
        }
        __syncthreads();
        HgPrep R; hg_prep_z(F, zw, h, dir, seg, cp, R);
        if (dir == 0) hg_stage_vt_v(F, vw, seg, cp);
        {
            const float eref0 = __expf(R.ref0), eref1 = __expf(R.ref1), eoff0 = __expf(R.off0 - R.ref0), eoff1 = __expf(R.off1 - R.ref1);
#pragma unroll
            for (int i = 0; i < 16; ++i) {
                const int si = seg * 16 + i, tok = dir ? 63 - si : si;
                const unsigned qw = qw_[i];
                const float q0 = lo_bf(qw), q1 = hi_bf(qw);
                const float ea0 = eoff0 * R.c0[i], ea1 = eoff1 * R.c1[i];
                const int lo = (dir * 64 + tok) * HG_PITCH + 4 * cp;
                const float qr0 = q0 * ea0, qr1 = q1 * ea1;
                *(LAS unsigned*)(F.lds + HG_QR + lo) = cvt_pk_bf16(qr0, qr1);
                *(LAS unsigned*)(F.lds + HG_KR + lo) = cvt_pk_bf16(R.k0[i] * __builtin_amdgcn_rcpf(ea0), R.k1[i] * __builtin_amdgcn_rcpf(ea1));
                *(LAS unsigned*)(F.lds + HG_QI + lo) = cvt_pk_bf16(qr0 * eref0, qr1 * eref1);
            }
        }
        __syncthreads();
        { const int un = u + F.G; if (un < 260 * 8) HGC_LOAD(un); }
        u32x2 gwp[4];
#pragma unroll
        for (int g = 0; g < 4; ++g) gwp[g] = *(const u32x2*)(P + (size_t)(row0 + tb2 * 32 + r) * PLD + 4096 + h * 128 + jb * 32 + 8 * g + 4 * hf);
        {
            const int tb = (F.wave >> 1) & 1, sb = F.wave & 1;
            f32x16 acc;
#pragma unroll
            for (int i = 0; i < 16; ++i) acc[i] = 0.f;
#pragma unroll
            for (int ks = 0; ks < 8; ++ks) {
                const bf16x8 a = *(const LAS bf16x8*)(F.lds + HG_KR + (dir * 64 + sb * 32 + r) * HG_PITCH + (ks * 16 + hf * 8) * 2);
                const bf16x8 b = *(const LAS bf16x8*)(F.lds + HG_QR + (dir * 64 + tb * 32 + r) * HG_PITCH + (ks * 16 + hf * 8) * 2);
                acc = MFMA32(a, b, acc);
            }
            const int t = tb * 32 + r;
#pragma unroll
            for (int g = 0; g < 4; ++g) {
                const int s0 = sb * 32 + 8 * g + 4 * hf; float v[4];
#pragma unroll
                for (int j = 0; j < 4; ++j) { const int s_ = s0 + j; const bool keep = dir ? (s_ >= t) : (s_ <= t); v[j] = keep ? acc[4 * g + j] : 0.f; }
                u32x2 w; w.x = pk2(v[0], v[1]); w.y = pk2(v[2], v[3]);
                *(LAS u32x2*)(F.lds + HG_ATT + t * HG_PITCH + (dir * 64 + s0) * 2) = w;
            }
        }
        __syncthreads();
        f32x16 o;
#pragma unroll
        for (int i = 0; i < 16; ++i) o[i] = 0.f;
#pragma unroll
        for (int ks = 0; ks < 8; ++ks) {
            const bf16x8 a = *(const LAS bf16x8*)(F.lds + HG_VT + (jb * 32 + r) * HG_VPITCH + ((ks & 3) * 16 + hf * 8) * 2);
            const bf16x8 b = *(const LAS bf16x8*)(F.lds + HG_ATT + (tb2 * 32 + r) * HG_PITCH + (ks * 16 + hf * 8) * 2);
            o = MFMA32(a, b, o);
        }
#pragma unroll
        for (int ks = 0; ks < 16; ++ks) {
            const bf16x8 b = *(const LAS bf16x8*)(F.lds + HG_QI + ((ks >> 3) * 64 + tb2 * 32 + r) * HG_PITCH + ((ks & 7) * 16 + hf * 8) * 2);
            o = MFMA32(sf[ks], b, o);
        }
        float ss = 0.f;
#pragma unroll
        for (int i = 0; i < 16; ++i) ss += o[i] * o[i];
        ss += __shfl_xor(ss, 32);
        LAS float* red = (LAS float*)(F.lds + HG_RED);
        if (hf == 0) red[(tb2 * 4 + jb) * 32 + r] = ss;
        __syncthreads();
        const float tot = red[(tb2 * 4 + 0) * 32 + r] + red[(tb2 * 4 + 1) * 32 + r] + red[(tb2 * 4 + 2) * 32 + r] + red[(tb2 * 4 + 3) * 32 + r];
        const float rn = rsqrtf(tot * (1.0f / 128.0f) + EPS);
        const int row = row0 + tb2 * 32 + r;
#pragma unroll
        for (int g = 0; g < 4; ++g) {
            const int dv = jb * 32 + 8 * g + 4 * hf;
            const u32x2 gw = gwp[g];
            const f32x4 nw = *(const f32x4*)(F.in[12] + dv);
            u32x2 w; w.x = pk2(o[4 * g] * rn * nw[0] * lo_bf(gw.x), o[4 * g + 1] * rn * nw[1] * hi_bf(gw.x));
            w.y = pk2(o[4 * g + 2] * rn * nw[2] * lo_bf(gw.y), o[4 * g + 3] * rn * nw[3] * hi_bf(gw.y));
            *(u32x2*)(O + (size_t)row * D + h * 128 + dv) = w;
        }
    }
}


constexpr int AT_K = 0, AT_V = 2 * 9216, AT_PITCH = 144;
__device__ __forceinline__ void phase_att(Frame& F) {
    const bf16_t* QKV = WSB(WS_P); bf16_t* O = WSB(WS_XSA);
    const int r = F.lane & 31, hf = F.lane >> 5, g = F.wave >> 1, th = F.wave & 1;
    const int kkey = F.tid >> 3, kc = F.tid & 7, vkey = F.tid & 63, vdg = F.tid >> 6;
    for (int u = F.vcu; u < 1024; u += F.G) {
        const int kvh = u & 3, t0 = (u >> 2) * 64, qh = kvh * 4 + g, t = t0 + 32 * th + r;
        bf16x8 qf[4];
#pragma unroll
        for (int ks = 0; ks < 4; ++ks) qf[ks] = *(const bf16x8*)(QKV + (size_t)t * QK_LD + qh * 64 + ks * 16 + hf * 8);
        int jfirst = 0, jlast = 4;
        if (t0 - 128 < 0) jfirst = (128 - t0) >> 6;
        if (t0 + 191 >= NLAT) jlast = 4 - ((t0 + 192 - NLAT) >> 6);
        const int ntl = jlast - jfirst + 1, nt = ntl + 4;
        const bf16_t* kbase = QKV + 1024 + kvh * 64;
        u32x4 kreg, vreg;
#define AT_LOAD(it) do { const int s0_ = ((it) < ntl) ? (t0 - 128 + 64 * (jfirst + (it))) : (NLAT + 64 * ((it) - ntl)); \
            kreg = *(const u32x4*)(kbase + (size_t)(s0_ + kkey) * QK_LD + 8 * kc); vreg = *(const u32x4*)(kbase + (size_t)(s0_ + vkey) * QK_LD + 256 + 8 * vdg); } while (0)
#define AT_WRITE(b) do { *(LAS u32x4*)(F.lds + AT_K + (b) * 9216 + kkey * AT_PITCH + 16 * kc) = kreg; \
            LAS unsigned short* vp_ = (LAS unsigned short*)(F.lds + AT_V + (b) * 9216 + (8 * vdg) * AT_PITCH + vkey * 2); \
            vp_[0] = (unsigned short)(vreg.x & 0xffffu); vp_[AT_PITCH / 2] = (unsigned short)(vreg.x >> 16); vp_[2 * (AT_PITCH / 2)] = (unsigned short)(vreg.y & 0xffffu); vp_[3 * (AT_PITCH / 2)] = (unsigned short)(vreg.y >> 16); \
            vp_[4 * (AT_PITCH / 2)] = (unsigned short)(vreg.z & 0xffffu); vp_[5 * (AT_PITCH / 2)] = (unsigned short)(vreg.z >> 16); vp_[6 * (AT_PITCH / 2)] = (unsigned short)(vreg.w & 0xffffu); vp_[7 * (AT_PITCH / 2)] = (unsigned short)(vreg.w >> 16); } while (0)
        AT_LOAD(0); AT_WRITE(0);
        __syncthreads();
        float m = F.in[25][qh] * 1.4426950408889634f, l = 1.0f;
        f32x16 o0, o1;
#pragma unroll
        for (int i = 0; i < 16; ++i) { o0[i] = 0.f; o1[i] = 0.f; }
        for (int it = 0; it < nt; ++it) {
            const int b = it & 1;
            if (it + 1 < nt) AT_LOAD(it + 1);
            f32x16 x0, x1;
#pragma unroll
            for (int i = 0; i < 16; ++i) { x0[i] = 0.f; x1[i] = 0.f; }
#pragma unroll
            for (int ks = 0; ks < 4; ++ks) {
                const bf16x8 a0 = *(const LAS bf16x8*)(F.lds + AT_K + b * 9216 + r * AT_PITCH + (ks * 16 + hf * 8) * 2);
                const bf16x8 a1 = *(const LAS bf16x8*)(F.lds + AT_K + b * 9216 + (32 + r) * AT_PITCH + (ks * 16 + hf * 8) * 2);
                x0 = MFMA32(a0, qf[ks], x0); x1 = MFMA32(a1, qf[ks], x1);
            }
            if (it < ntl) { const int j = jfirst + it;
                if (j == 0 || j == 4) { const int s0 = t0 - 128 + 64 * j;
#pragma unroll
                    for (int i = 0; i < 16; ++i) { const int sk = s0 + (i & 3) + 8 * (i >> 2) + 4 * hf; const int d0 = sk - t, d1 = sk + 32 - t;
                        if (d0 < -128 || d0 > 128) x0[i] = -1e30f; if (d1 < -128 || d1 > 128) x1[i] = -1e30f; } } }
            float mx = x0[0];
#pragma unroll
            for (int i = 0; i < 16; ++i) { mx = fmaxf(mx, x0[i]); mx = fmaxf(mx, x1[i]); }
            mx = fmaxf(mx, __shfl_xor(mx, 32));
            if (__any(mx > m + 8.0f)) {
                const float mn = fmaxf(m, mx), al = __builtin_amdgcn_exp2f(m - mn); m = mn; l *= al;
#pragma unroll
                for (int i = 0; i < 16; ++i) { o0[i] *= al; o1[i] *= al; }
            }
            float ls = 0.f;
#pragma unroll
            for (int i = 0; i < 16; ++i) { x0[i] = __builtin_amdgcn_exp2f(x0[i] - m); x1[i] = __builtin_amdgcn_exp2f(x1[i] - m); ls += x0[i] + x1[i]; }
            ls += __shfl_xor(ls, 32);
            l += ls;
#pragma unroll
            for (int kt = 0; kt < 2; ++kt)
#pragma unroll
                for (int s_ = 0; s_ < 2; ++s_) {
                    u32x4 pw;
                    if (kt == 0) { pw.x = cvt_pk_bf16(x0[8 * s_], x0[8 * s_ + 1]); pw.y = cvt_pk_bf16(x0[8 * s_ + 2], x0[8 * s_ + 3]); pw.z = cvt_pk_bf16(x0[8 * s_ + 4], x0[8 * s_ + 5]); pw.w = cvt_pk_bf16(x0[8 * s_ + 6], x0[8 * s_ + 7]); }
                    else { pw.x = cvt_pk_bf16(x1[8 * s_], x1[8 * s_ + 1]); pw.y = cvt_pk_bf16(x1[8 * s_ + 2], x1[8 * s_ + 3]); pw.z = cvt_pk_bf16(x1[8 * s_ + 4], x1[8 * s_ + 5]); pw.w = cvt_pk_bf16(x1[8 * s_ + 6], x1[8 * s_ + 7]); }
                    const bf16x8 pb = __builtin_bit_cast(bf16x8, pw);
                    const int koff = (kt * 32 + 16 * s_ + 4 * hf) * 2;
                    const LAS unsigned char* v0p = F.lds + AT_V + b * 9216 + r * AT_PITCH + koff; const LAS unsigned char* v1p = v0p + 32 * AT_PITCH;
                    u32x4 a0w, a1w; const u32x2 a00 = *(const LAS u32x2*)v0p, a01 = *(const LAS u32x2*)(v0p + 16), a10 = *(const LAS u32x2*)v1p, a11 = *(const LAS u32x2*)(v1p + 16);
                    a0w.x = a00.x; a0w.y = a00.y; a0w.z = a01.x; a0w.w = a01.y; a1w.x = a10.x; a1w.y = a10.y; a1w.z = a11.x; a1w.w = a11.y;
                    o0 = MFMA32(__builtin_bit_cast(bf16x8, a0w), pb, o0); o1 = MFMA32(__builtin_bit_cast(bf16x8, a1w), pb, o1);
                }
            if (it + 1 < nt) AT_WRITE(b ^ 1);
            __syncthreads();
        }
        const float il = 1.0f / l;
#pragma unroll
        for (int g4 = 0; g4 < 4; ++g4) {
            const int d = 8 * g4 + 4 * hf;
            u32x2 w0, w1; w0.x = cvt_pk_bf16(o0[4 * g4] * il, o0[4 * g4 + 1] * il); w0.y = cvt_pk_bf16(o0[4 * g4 + 2] * il, o0[4 * g4 + 3] * il);
            w1.x = cvt_pk_bf16(o1[4 * g4] * il, o1[4 * g4 + 1] * il); w1.y = cvt_pk_bf16(o1[4 * g4 + 2] * il, o1[4 * g4 + 3] * il);
            *(u32x2*)(O + (size_t)t * D + qh * 64 + d) = w0; *(u32x2*)(O + (size_t)t * D + qh * 64 + 32 + d) = w1;
        }
#undef AT_LOAD
#undef AT_WRITE
    }
#undef HGC_LOAD
}


constexpr size_t WS_SDEC = WS_CTL + 32768;
constexpr size_t WS_TS = WS_CTL + 24576;
__device__ __forceinline__ bf16_t* ssm_state(const Frame& F, int dir, int h, int p) { return (bf16_t*)(F.ws + WS_ST) + ((size_t)(dir * 32 + h) * 65 + p) * 8192; }
constexpr int SS_PT = 528;
constexpr int SA_BT = 0, SA_XW = 128 * SS_PT, SA_SC = SA_XW + 2 * 64 * SS_PT;
constexpr int SC_BM = 0, SC_XT = 256 * 272, SC_SC = SC_XT + 64 * SS_PT, SC_ST = SC_SC + 6144;
static_assert(SA_SC + 4096 <= MISC_OFF && SC_ST + 128 * 272 <= MISC_OFF, "Mamba LDS map");
__device__ __forceinline__ float wave_incl_scan(float v, int lane) {
#pragma unroll
    for (int o = 1; o < 64; o <<= 1) { const float t = __shfl_up(v, o); if (lane >= o) v += t; }
    return v;
}
struct SsmDt { float x[4]; };
__device__ __forceinline__ void ssm_scalars_load(const Frame& F, int r0, int h, SsmDt& R) {
    if (F.wave < 2) { const int dir = F.wave;
#pragma unroll
        for (int j = 0; j < 4; ++j) { const int i = dir ? 255 - (4 * F.lane + j) : 4 * F.lane + j; R.x[j] = WSF(WS_DT)[(size_t)(r0 + i) * 64 + dir * 32 + h]; } }
}
__device__ __forceinline__ void ssm_scalars(const Frame& F, LAS float* SC, int h, const SsmDt& R) {
    if (F.wave < 2) {
        const int dir = F.wave; const float A = -__expf(F.in[18][dir * 32 + h]), dtb = F.in[17][dir * 32 + h];
        float dt[4], c[4], run = 0.f;
#pragma unroll
        for (int j = 0; j < 4; ++j) { const float x = R.x[j] + dtb; dt[j] = (x > 20.f) ? x : log1pf(__expf(x)); run += dt[j] * A; c[j] = run; }
        const float off = wave_incl_scan(run, F.lane) - run;
#pragma unroll
        for (int j = 0; j < 4; ++j) { const int i = dir ? 255 - (4 * F.lane + j) : 4 * F.lane + j; SC[dir * 256 + i] = dt[j]; SC[512 + dir * 256 + i] = off + c[j]; }
    }
    __syncthreads();
}
__device__ __forceinline__ u32x4 pack8(const float (&v)[8]) { u32x4 w; w.x = cvt_pk_bf16(v[0], v[1]); w.y = cvt_pk_bf16(v[2], v[3]); w.z = cvt_pk_bf16(v[4], v[5]); w.w = cvt_pk_bf16(v[6], v[7]); return w; }
__device__ __forceinline__ void run_geom(int ru, int& r0, int& pf, int& pb) {
    if (ru < 64) { r0 = ru * 256; pf = 1 + ru; pb = 1 + (63 - ru); } else { r0 = NLAT; pf = 0; pb = 0; }
}
__device__ __forceinline__ void phase_ssm_conv(Frame& F) {
    bf16_t* P = WSB(WS_P); const bf16_t* HALO = WSB(WS_HALO);
    for (int u = F.bid; u < 260 * 3; u += F.G) {
        const int tk = u / 3, ch = (u % 3) * 1024 + F.tid * 2;
        const bool first = (tk == 0 || tk == 256), last = (tk == 255 || tk == 259);
        unsigned raw[68];
        raw[0] = first ? 0u : *(const unsigned*)(HALO + ((size_t)tk * 4 + 0) * SSM_CD + ch); raw[1] = first ? 0u : *(const unsigned*)(HALO + ((size_t)tk * 4 + 1) * SSM_CD + ch);
        raw[66] = last ? 0u : *(const unsigned*)(HALO + ((size_t)tk * 4 + 2) * SSM_CD + ch); raw[67] = last ? 0u : *(const unsigned*)(HALO + ((size_t)tk * 4 + 3) * SSM_CD + ch);
        bf16_t* colp = P + (size_t)tk * 64 * PLD + 2048 + ch;
#pragma unroll
        for (int i = 0; i < 64; ++i) raw[2 + i] = *(const unsigned*)(colp + (size_t)i * PLD);
        float cw0[5], cw1[5];
#pragma unroll
        for (int j = 0; j < 5; ++j) { const f32x2 w = *(const f32x2*)(F.in[15] + j * SSM_CD + ch); cw0[j] = w.x; cw1[j] = w.y; }
        const f32x2 cb = *(const f32x2*)(F.in[16] + ch);
#pragma unroll
        for (int i = 0; i < 64; ++i) {
            const float a0 = cb.x + cw0[0] * lo_bf(raw[i]) + cw0[1] * lo_bf(raw[i + 1]) + cw0[2] * lo_bf(raw[i + 2]) + cw0[3] * lo_bf(raw[i + 3]) + cw0[4] * lo_bf(raw[i + 4]);
            const float a1 = cb.y + cw1[0] * hi_bf(raw[i]) + cw1[1] * hi_bf(raw[i + 1]) + cw1[2] * hi_bf(raw[i + 2]) + cw1[3] * hi_bf(raw[i + 3]) + cw1[4] * hi_bf(raw[i + 4]);
            *(unsigned*)(colp + (size_t)i * PLD) = cvt_pk_bf16(siluf_(a0), siluf_(a1));
        }
    }
}
constexpr int SCT_N = 2048;
__device__ __forceinline__ void ssm_tables(Frame& F) {
    float* T = (float*)(F.ws + WS_XSA);
    const int gw = F.vcu * NWAVES + F.wave, NGW = F.G * NWAVES;
    for (int task = gw; task < 65 * 32 * 2; task += NGW) {
        const int u = task >> 1, dir = task & 1, ru = u >> 5, h = u & 31; int r0, pf, pb; run_geom(ru, r0, pf, pb);
        const float A = -__expf(F.in[18][dir * 32 + h]), dtb = F.in[17][dir * 32 + h];
        float xr_[4];
#pragma unroll
        for (int j = 0; j < 4; ++j) { const int i = dir ? 255 - (4 * F.lane + j) : 4 * F.lane + j; xr_[j] = WSF(WS_DT)[(size_t)(r0 + i) * 64 + dir * 32 + h]; }
        float dt[4], c[4], run = 0.f;
#pragma unroll
        for (int j = 0; j < 4; ++j) { const float x = xr_[j] + dtb; dt[j] = (x > 20.f) ? x : log1pf(__expf(x)); run += dt[j] * A; c[j] = run; }
        const float off = wave_incl_scan(run, F.lane) - run;
#pragma unroll
        for (int j = 0; j < 4; ++j) c[j] += off;
        const float cref = __shfl(c[3], (F.lane & ~7) | 7);
        const float last = __shfl(c[3], 63);
        float e[4], wgt[4];
#pragma unroll
        for (int j = 0; j < 4; ++j) { e[j] = dt[j] * __expf(cref - c[j]); wgt[j] = dt[j] * __expf(last - c[j]); }
        float* tb = T + (size_t)u * SCT_N;
        if (dir == 0) { const int i0 = 4 * F.lane;
            *(f32x4*)(tb + i0) = (f32x4){dt[0], dt[1], dt[2], dt[3]}; *(f32x4*)(tb + 512 + i0) = (f32x4){c[0], c[1], c[2], c[3]};
            *(f32x4*)(tb + 1024 + i0) = (f32x4){e[0], e[1], e[2], e[3]}; *(f32x4*)(tb + 1536 + i0) = (f32x4){wgt[0], wgt[1], wgt[2], wgt[3]};
        } else { const int i0 = 252 - 4 * F.lane;
            *(f32x4*)(tb + 256 + i0) = (f32x4){dt[3], dt[2], dt[1], dt[0]}; *(f32x4*)(tb + 768 + i0) = (f32x4){c[3], c[2], c[1], c[0]};
            *(f32x4*)(tb + 1280 + i0) = (f32x4){e[3], e[2], e[1], e[0]}; *(f32x4*)(tb + 1792 + i0) = (f32x4){wgt[3], wgt[2], wgt[1], wgt[0]};
        }
        if (F.lane == 63) WSF(WS_SDEC)[(dir * 32 + h) * 65 + (dir ? pb : pf)] = __expf(last);
    }
}
__device__ __forceinline__ void phase_ssm_a(Frame& F) {
    const bf16_t* P = WSB(WS_P); const float* T = (const float*)(F.ws + WS_XSA);
    const int r = F.lane & 31, hf = F.lane >> 5;
    for (int u = F.vcu; u < 65 * 32; u += F.G) {
        const int ru = u >> 5, h = u & 31, g = h >> 3; int r0, pf, pb; run_geom(ru, r0, pf, pb);
        const int xcp = F.tid & 31, xsg = F.tid >> 5, bcp = F.tid & 63, bsg = F.tid >> 6;
        unsigned xr[16], br[32];
        { const bf16_t* xp = P + (size_t)(r0 + xsg * 16) * PLD + 2048 + h * 64 + 2 * xcp;
#pragma unroll
          for (int i = 0; i < 16; ++i) xr[i] = *(const unsigned*)(xp + (size_t)i * PLD);
          const bf16_t* bp = P + (size_t)(r0 + bsg * 32) * PLD + 4096 + g * 128 + 2 * bcp;
#pragma unroll
          for (int i = 0; i < 32; ++i) br[i] = *(const unsigned*)(bp + (size_t)i * PLD); }
        f32x4 wfv[4], wbv[4];
        { const float* tw = T + (size_t)u * SCT_N + 1536 + xsg * 16;
#pragma unroll
          for (int q = 0; q < 4; ++q) { wfv[q] = *(const f32x4*)(tw + 4 * q); wbv[q] = *(const f32x4*)(tw + 256 + 4 * q); } }
        __syncthreads();
#pragma unroll
        for (int k8 = 0; k8 < 4; ++k8) {
            u32x4 lo, hi;
            lo.x = (br[8 * k8] & 0xffffu) | (br[8 * k8 + 1] << 16); lo.y = (br[8 * k8 + 2] & 0xffffu) | (br[8 * k8 + 3] << 16); lo.z = (br[8 * k8 + 4] & 0xffffu) | (br[8 * k8 + 5] << 16); lo.w = (br[8 * k8 + 6] & 0xffffu) | (br[8 * k8 + 7] << 16);
            hi.x = (br[8 * k8] >> 16) | (br[8 * k8 + 1] & 0xffff0000u); hi.y = (br[8 * k8 + 2] >> 16) | (br[8 * k8 + 3] & 0xffff0000u); hi.z = (br[8 * k8 + 4] >> 16) | (br[8 * k8 + 5] & 0xffff0000u); hi.w = (br[8 * k8 + 6] >> 16) | (br[8 * k8 + 7] & 0xffff0000u);
            LAS unsigned char* bp = F.lds + SA_BT + (2 * bcp) * SS_PT + (bsg * 32 + k8 * 8) * 2; *(LAS u32x4*)bp = lo; *(LAS u32x4*)(bp + SS_PT) = hi;
        }
#pragma unroll
        for (int k8 = 0; k8 < 2; ++k8) {
            float f0[8], f1[8], b0[8], b1[8];
#pragma unroll
            for (int j = 0; j < 8; ++j) { const float x0 = lo_bf(xr[k8 * 8 + j]), x1 = hi_bf(xr[k8 * 8 + j]);
                const float wf = wfv[k8 * 2 + (j >> 2)][j & 3], wb = wbv[k8 * 2 + (j >> 2)][j & 3]; f0[j] = x0 * wf; f1[j] = x1 * wf; b0[j] = x0 * wb; b1[j] = x1 * wb; }
            LAS unsigned char* xp = F.lds + SA_XW + (2 * xcp) * SS_PT + (xsg * 16 + k8 * 8) * 2;
            *(LAS u32x4*)xp = pack8(f0); *(LAS u32x4*)(xp + SS_PT) = pack8(f1); *(LAS u32x4*)(xp + 64 * SS_PT) = pack8(b0); *(LAS u32x4*)(xp + 65 * SS_PT) = pack8(b1);
        }
        __syncthreads();
        const int dir = F.wave >> 2, pt = (F.wave >> 1) & 1, nt0 = 2 * (F.wave & 1);
        f32x16 acc0, acc1;
#pragma unroll
        for (int i = 0; i < 16; ++i) { acc0[i] = 0.f; acc1[i] = 0.f; }
#pragma unroll 4
        for (int ks = 0; ks < 16; ++ks) {
            const bf16x8 b = *(const LAS bf16x8*)(F.lds + SA_XW + (dir * 64 + pt * 32 + r) * SS_PT + (ks * 16 + hf * 8) * 2);
            const bf16x8 a0 = *(const LAS bf16x8*)(F.lds + SA_BT + (nt0 * 32 + r) * SS_PT + (ks * 16 + hf * 8) * 2);
            const bf16x8 a1 = *(const LAS bf16x8*)(F.lds + SA_BT + ((nt0 + 1) * 32 + r) * SS_PT + (ks * 16 + hf * 8) * 2);
            acc0 = MFMA32(a0, b, acc0); acc1 = MFMA32(a1, b, acc1);
        }
        bf16_t* st = ssm_state(F, dir, h, dir ? pb : pf) + (size_t)(pt * 32 + r) * 128;
#pragma unroll
        for (int g4 = 0; g4 < 4; ++g4) { u32x2 w0, w1; w0.x = cvt_pk_bf16(acc0[4 * g4], acc0[4 * g4 + 1]); w0.y = cvt_pk_bf16(acc0[4 * g4 + 2], acc0[4 * g4 + 3]);
            w1.x = cvt_pk_bf16(acc1[4 * g4], acc1[4 * g4 + 1]); w1.y = cvt_pk_bf16(acc1[4 * g4 + 2], acc1[4 * g4 + 3]);
            *(u32x2*)(st + nt0 * 32 + 8 * g4 + 4 * hf) = w0; *(u32x2*)(st + (nt0 + 1) * 32 + 8 * g4 + 4 * hf) = w1; }
    }
}
__device__ __forceinline__ void phase_ssm_b(Frame& F) {
    for (int idx = F.bid * NTHR + F.tid; idx < 2 * 32 * 4096; idx += F.G * NTHR) {
        const int e2 = idx & 4095, hh = idx >> 12;
        unsigned* sp = (unsigned*)((bf16_t*)(F.ws + WS_ST) + (size_t)hh * 65 * 8192) + e2;
        const float* dp = WSF(WS_SDEC) + hh * 65;
        float s0 = 0.f, s1 = 0.f;
        for (int p = 0; p < 65; p += 13) {
            unsigned x[13]; float d[13];
#pragma unroll
            for (int j = 0; j < 13; ++j) { x[j] = sp[(size_t)(p + j) * 4096]; d[j] = dp[p + j]; }
#pragma unroll
            for (int j = 0; j < 13; ++j) { sp[(size_t)(p + j) * 4096] = cvt_pk_bf16(s0, s1); s0 = d[j] * s0 + lo_bf(x[j]); s1 = d[j] * s1 + hi_bf(x[j]); }
        }
    }
}
__device__ __forceinline__ void phase_ssm_c(Frame& F, bool dry = false) {
    bf16_t* P = WSB(WS_P); LAS float* SC = (LAS float*)(F.lds + SC_SC); const float* T = (const float*)(F.ws + WS_XSA);
    const int r = F.lane & 31, hf = F.lane >> 5, w = F.wave;
    for (int u = F.vcu; u < 65 * 32; u += F.G) {
        const int ru = u >> 5, h = u & 31, g = h >> 3; int r0, pf, pb; run_geom(ru, r0, pf, pb);
        const int ti = 32 * w + r, trow = r0 + ti;
        f32x4 scv = {0.f, 0.f, 0.f, 0.f}; if (F.tid < 384) scv = *(const f32x4*)(T + (size_t)u * SCT_N + 4 * F.tid);
        bf16x8 cf[8];
#pragma unroll
        for (int ks = 0; ks < 8; ++ks) cf[ks] = *(const bf16x8*)(P + (size_t)trow * PLD + 4608 + g * 128 + ks * 16 + hf * 8);
        const int xcp = F.tid & 31, xsg = F.tid >> 5;
        unsigned xr[16];
        { const bf16_t* xp = P + (size_t)(r0 + xsg * 16) * PLD + 2048 + h * 64 + 2 * xcp;
#pragma unroll
          for (int i = 0; i < 16; ++i) xr[i] = *(const unsigned*)(xp + (size_t)i * PLD); }
        u32x4 bm[8];
#pragma unroll
        for (int k = 0; k < 8; ++k) { const int idx = F.tid + 512 * k, row = idx >> 4, c16 = idx & 15; bm[k] = *(const u32x4*)(P + (size_t)(r0 + row) * PLD + 4096 + g * 128 + c16 * 8); }
        u32x4 sv[4];
#pragma unroll
        for (int k = 0; k < 4; ++k) { const int idx = F.tid + 512 * k, dir = idx >> 10, e = idx & 1023; sv[k] = *(const u32x4*)(ssm_state(F, dir, h, dir ? pb : pf) + e * 8); }
        bf16_t* zp = P + (size_t)trow * PLD + h * 64;
        u32x2 zv[8];
#pragma unroll
        for (int g4 = 0; g4 < 4; ++g4) { zv[2 * g4] = *(const u32x2*)(zp + 8 * g4 + 4 * hf); zv[2 * g4 + 1] = *(const u32x2*)(zp + 32 + 8 * g4 + 4 * hf); }
        __syncthreads();
        if (F.tid < 384) *(LAS f32x4*)(SC + 4 * F.tid) = scv;
#pragma unroll
        for (int k = 0; k < 8; ++k) { const int idx = F.tid + 512 * k, row = idx >> 4, c16 = idx & 15; *(LAS u32x4*)(F.lds + SC_BM + row * 272 + c16 * 16) = bm[k]; }
#pragma unroll
        for (int k = 0; k < 4; ++k) { const int idx = F.tid + 512 * k, dir = idx >> 10, e = idx & 1023; *(LAS u32x4*)(F.lds + SC_ST + (dir * 64 + (e >> 4)) * 272 + (e & 15) * 16) = sv[k]; }
#pragma unroll
        for (int k8 = 0; k8 < 2; ++k8) {
            u32x4 lo, hi;
            lo.x = (xr[8 * k8] & 0xffffu) | (xr[8 * k8 + 1] << 16); lo.y = (xr[8 * k8 + 2] & 0xffffu) | (xr[8 * k8 + 3] << 16); lo.z = (xr[8 * k8 + 4] & 0xffffu) | (xr[8 * k8 + 5] << 16); lo.w = (xr[8 * k8 + 6] & 0xffffu) | (xr[8 * k8 + 7] << 16);
            hi.x = (xr[8 * k8] >> 16) | (xr[8 * k8 + 1] & 0xffff0000u); hi.y = (xr[8 * k8 + 2] >> 16) | (xr[8 * k8 + 3] & 0xffff0000u); hi.z = (xr[8 * k8 + 4] >> 16) | (xr[8 * k8 + 5] & 0xffff0000u); hi.w = (xr[8 * k8 + 6] >> 16) | (xr[8 * k8 + 7] & 0xffff0000u);
            LAS unsigned char* xp = F.lds + SC_XT + (2 * xcp) * SS_PT + (xsg * 16 + k8 * 8) * 2; *(LAS u32x4*)xp = lo; *(LAS u32x4*)(xp + SS_PT) = hi;
        }
        __syncthreads();
        const float cft = SC[512 + ti], cbt = SC[768 + ti];
        f32x16 y0, y1;
#pragma unroll
        for (int i = 0; i < 16; ++i) { y0[i] = 0.f; y1[i] = 0.f; }
#pragma unroll 1
        for (int sb = 0; sb < 8; ++sb) {
            f32x16 x;
#pragma unroll
            for (int i = 0; i < 16; ++i) x[i] = 0.f;
#pragma unroll
            for (int ks = 0; ks < 8; ++ks) { const bf16x8 a = *(const LAS bf16x8*)(F.lds + SC_BM + (sb * 32 + r) * 272 + (ks * 16 + hf * 8) * 2); x = MFMA32(a, cf[ks], x); }
            if (sb == w) {
#pragma unroll
                for (int g4 = 0; g4 < 4; ++g4) {
                    const int sl = sb * 32 + 8 * g4 + 4 * hf;
                    const f32x4 dtf = *(const LAS f32x4*)(SC + sl), dtb = *(const LAS f32x4*)(SC + 256 + sl), cfs = *(const LAS f32x4*)(SC + 512 + sl), cbs = *(const LAS f32x4*)(SC + 768 + sl);
#pragma unroll
                    for (int j = 0; j < 4; ++j) { const int s_ = sl + j; float m = 0.f;
                        if (s_ <= ti) m += __expf(cft - cfs[j]) * dtf[j];
                        if (s_ >= ti) m += __expf(cbt - cbs[j]) * dtb[j];
                        x[4 * g4 + j] *= m; }
                }
            } else {
                const bool fwd = sb < w;
                const float fac = fwd ? __expf(cft - SC[512 + sb * 32 + 31]) : __expf(cbt - SC[768 + sb * 32]);
                const LAS float* E = SC + (fwd ? 1024 : 1280) + sb * 32 + 4 * hf;
#pragma unroll
                for (int g4 = 0; g4 < 4; ++g4) { const f32x4 e4 = *(const LAS f32x4*)(E + 8 * g4);
#pragma unroll
                    for (int j = 0; j < 4; ++j) x[4 * g4 + j] *= fac * e4[j]; }
            }
#pragma unroll
            for (int s2 = 0; s2 < 2; ++s2) {
                u32x4 pw; pw.x = cvt_pk_bf16(x[8 * s2], x[8 * s2 + 1]); pw.y = cvt_pk_bf16(x[8 * s2 + 2], x[8 * s2 + 3]); pw.z = cvt_pk_bf16(x[8 * s2 + 4], x[8 * s2 + 5]); pw.w = cvt_pk_bf16(x[8 * s2 + 6], x[8 * s2 + 7]);
                const bf16x8 pb_ = __builtin_bit_cast(bf16x8, pw);
                const LAS unsigned char* a0p = F.lds + SC_XT + r * SS_PT + (sb * 32 + 16 * s2 + 4 * hf) * 2; const LAS unsigned char* a1p = a0p + 32 * SS_PT;
                const u32x2 a00 = *(const LAS u32x2*)a0p, a01 = *(const LAS u32x2*)(a0p + 16), a10 = *(const LAS u32x2*)a1p, a11 = *(const LAS u32x2*)(a1p + 16);
                u32x4 a0w, a1w; a0w.x = a00.x; a0w.y = a00.y; a0w.z = a01.x; a0w.w = a01.y; a1w.x = a10.x; a1w.y = a10.y; a1w.z = a11.x; a1w.w = a11.y;
                y0 = MFMA32(__builtin_bit_cast(bf16x8, a0w), pb_, y0); y1 = MFMA32(__builtin_bit_cast(bf16x8, a1w), pb_, y1);
            }
        }
#pragma unroll
        for (int dir = 0; dir < 2; ++dir) {
            const float e = __expf(dir ? cbt : cft);
#pragma unroll
            for (int pt = 0; pt < 2; ++pt) {
                f32x16 yd;
#pragma unroll
                for (int i = 0; i < 16; ++i) yd[i] = 0.f;
#pragma unroll
                for (int ks = 0; ks < 8; ++ks) { const bf16x8 sa = *(const LAS bf16x8*)(F.lds + SC_ST + (dir * 64 + pt * 32 + r) * 272 + (ks * 16 + hf * 8) * 2); yd = MFMA32(sa, cf[ks], yd); }
                if (pt == 0) {
#pragma unroll
                    for (int i = 0; i < 16; ++i) y0[i] += e * yd[i];
                } else {
#pragma unroll
                    for (int i = 0; i < 16; ++i) y1[i] += e * yd[i];
                }
            }
        }
        const float Dk = F.in[19][h];
        bf16_t* zo = dry ? WSB(WS_HALO) + ((size_t)(u & 255) * 256 + ti) * 64 : zp; float ssq_ = 0.f;
#pragma unroll
        for (int g4 = 0; g4 < 4; ++g4) {
            const int p0 = 8 * g4 + 4 * hf;
            const u32x2 z0 = zv[2 * g4], z1 = zv[2 * g4 + 1];
            float xa[4], xb[4];
#pragma unroll
            for (int j = 0; j < 4; ++j) { xa[j] = bf2f(*(const LAS unsigned short*)(F.lds + SC_XT + (p0 + j) * SS_PT + ti * 2)); xb[j] = bf2f(*(const LAS unsigned short*)(F.lds + SC_XT + (32 + p0 + j) * SS_PT + ti * 2)); }
            float va[4], vb[4];
            va[0] = (y0[4 * g4] + Dk * xa[0]) * siluf_(lo_bf(z0.x)); va[1] = (y0[4 * g4 + 1] + Dk * xa[1]) * siluf_(hi_bf(z0.x));
            va[2] = (y0[4 * g4 + 2] + Dk * xa[2]) * siluf_(lo_bf(z0.y)); va[3] = (y0[4 * g4 + 3] + Dk * xa[3]) * siluf_(hi_bf(z0.y));
            vb[0] = (y1[4 * g4] + Dk * xb[0]) * siluf_(lo_bf(z1.x)); vb[1] = (y1[4 * g4 + 1] + Dk * xb[1]) * siluf_(hi_bf(z1.x));
            vb[2] = (y1[4 * g4 + 2] + Dk * xb[2]) * siluf_(lo_bf(z1.y)); vb[3] = (y1[4 * g4 + 3] + Dk * xb[3]) * siluf_(hi_bf(z1.y));
            ssq_ += (va[0] * va[0] + va[1] * va[1]) + (va[2] * va[2] + va[3] * va[3]) + (vb[0] * vb[0] + vb[1] * vb[1]) + (vb[2] * vb[2] + vb[3] * vb[3]);
            u32x2 o0, o1; o0.x = cvt_pk_bf16(va[0], va[1]); o0.y = cvt_pk_bf16(va[2], va[3]); o1.x = cvt_pk_bf16(vb[0], vb[1]); o1.y = cvt_pk_bf16(vb[2], vb[3]);
            *(u32x2*)(zo + p0) = o0; *(u32x2*)(zo + 32 + p0) = o1;
        }
        ssq_ += __shfl_xor(ssq_, 32);
        if (!dry && hf == 0) WSF(WS_SSQ)[(size_t)trow * 32 + h] = ssq_;
    }
}
__device__ __forceinline__ void phase_ssm_d(Frame& F) {
    bf16_t* P = WSB(WS_P);
    const int gw = F.bid * NWAVES + F.wave, NGW = F.G * NWAVES;
    for (int it = gw; it < MALL * 4; it += NGW) {
        const int row = it >> 2, g = it & 3; const int c = g * 512 + F.lane * 8;
        const u32x4 yv = *(const u32x4*)(P + (size_t)row * PLD + c);
        float y[8] = {lo_bf(yv.x), hi_bf(yv.x), lo_bf(yv.y), hi_bf(yv.y), lo_bf(yv.z), hi_bf(yv.z), lo_bf(yv.w), hi_bf(yv.w)}; float ss = 0.f;
#pragma unroll
        for (int j = 0; j < 8; ++j) ss += y[j] * y[j];
        ss = wave_sum(ss); const float rn = rsqrtf(ss * (1.0f / 512.0f) + EPS);
        u32x4 o; o.x = cvt_pk_bf16(y[0] * rn, y[1] * rn); o.y = cvt_pk_bf16(y[2] * rn, y[3] * rn); o.z = cvt_pk_bf16(y[4] * rn, y[5] * rn); o.w = cvt_pk_bf16(y[6] * rn, y[7] * rn);
        *(u32x4*)(P + (size_t)row * PLD + c) = o;
    }
}

template <int WIN> __device__ __forceinline__ void pool_unit(const bf16_t* XS, bf16_t* DL, const LAS float* rsd, int t0, int s0, int s1, int c) {
    constexpr int HB = WIN / 2, KLO = 8 - HB, KHI = 8 + 16 + HB - 1;
    unsigned raw[32];
#pragma unroll
    for (int k = KLO; k < KHI; ++k) { const int rr = t0 - 8 + k; const int rc = rr < s0 ? s0 : (rr >= s1 ? s1 - 1 : rr); raw[k] = *(const unsigned*)(XS + (size_t)rc * D + c); }
    float p0[33], p1[33], h0[32], h1[32];
    p0[KLO] = 0.f; p1[KLO] = 0.f;
#pragma unroll
    for (int k = KLO; k < KHI; ++k) { const float rr = rsd[k]; h0[k] = rr * lo_bf(raw[k]); h1[k] = rr * hi_bf(raw[k]); p0[k + 1] = p0[k] + h0[k]; p1[k + 1] = p1[k] + h1[k]; }
#pragma unroll
    for (int j = 0; j < 16; ++j) {
        const int t = t0 + j; int lo = t - HB, hi = t + WIN - HB; lo = lo < s0 ? s0 : lo; hi = hi > s1 ? s1 : hi;
        const float inv = 1.0f / (float)(hi - lo);
        const float a0 = (p0[8 + j + WIN - HB] - p0[8 + j - HB]) * inv - h0[8 + j], a1 = (p1[8 + j + WIN - HB] - p1[8 + j - HB]) * inv - h1[8 + j];
        *(unsigned*)(DL + (size_t)t * D + c) = cvt_pk_bf16(a0, a1);
    }
}
__device__ __forceinline__ void phase_pool_delta(Frame& F) {
    LAS float* rsd = (LAS float*)F.lds;
    const bf16_t* XS = WSB(WS_XSA); bf16_t* DL = WSB(WS_P);
    const int c = F.tid * 2, gi = F.tid >> 7;
    for (int u = F.bid; u < MALL / 16; u += F.G) {
        const int t0 = u * 16, s0 = (t0 >= NLAT) ? NLAT : 0, s1 = (t0 >= NLAT) ? MALL : NLAT;
        __syncthreads();
        if (F.tid < 32) { const int rr = t0 - 8 + F.tid; float v = 0.f;
            if (rr >= s0 && rr < s1 && rr >= NLAT) v = ctx_rstd(F, rr - NLAT);
            else if (rr >= s0 && rr < s1) { const float* sp = WSF(WS_SLOTS) + (size_t)rr * 16; const f32x4 a = *(const f32x4*)sp, b_ = *(const f32x4*)(sp + 4), c_ = *(const f32x4*)(sp + 8), d = *(const f32x4*)(sp + 12);
                const float t = ((a[0] + a[1]) + (a[2] + a[3])) + ((b_[0] + b_[1]) + (b_[2] + b_[3])) + ((c_[0] + c_[1]) + (c_[2] + c_[3])) + ((d[0] + d[1]) + (d[2] + d[3]));
                v = rsqrtf(t * (1.0f / 1024.0f) + EPS); }
            rsd[F.tid] = v; }
        __syncthreads();
        if (gi == 0) pool_unit<2>(XS, DL, rsd, t0, s0, s1, c); else if (gi == 1) pool_unit<4>(XS, DL, rsd, t0, s0, s1, c);
        else if (gi == 2) pool_unit<8>(XS, DL, rsd, t0, s0, s1, c); else pool_unit<16>(XS, DL, rsd, t0, s0, s1, c);
    }
}
__device__ __forceinline__ void phase_final(Frame& F) {
    const int gw = F.bid * NWAVES + F.wave, NGW = F.G * NWAVES;
    for (int row = gw; row < NLAT; row += NGW) {
        float t = (F.lane < 16) ? WSF(WS_SLOTS)[(size_t)row * 16 + F.lane] : 0.f; t = wave_sum(t);
        const float r = rsqrtf(t * (1.0f / 1024.0f) + EPS);
        float* xr = F.out + (size_t)row * D; const _Float16* xi = (const _Float16*)(F.ws + WS_XSB) + (size_t)row * D;
#pragma unroll
        for (int j = 0; j < 2; ++j) { const int k = j * 512 + F.lane * 8; const f32x8 x = __builtin_convertvector(*(const h16x8*)(xi + k), f32x8);
            const f32x4 w0 = *(const f32x4*)(F.in[9] + k), w1 = *(const f32x4*)(F.in[9] + k + 4);
            *(f32x4*)(xr + k) = (f32x4){x[0], x[1], x[2], x[3]} * r * w0; *(f32x4*)(xr + k + 4) = (f32x4){x[4], x[5], x[6], x[7]} * r * w1; }
    }
}

enum { PH_P0A = 0, PH_P0B, PH_L0_G1, PH_L0_MA, PH_L0_MB, PH_L0_MC, PH_L0_G2, PH_L0_G3, PH_L0_G4,
       PH_L1_G1, PH_L1_CV, PH_L1_MA, PH_L1_MB, PH_L1_MC, PH_L1_MD, PH_L1_G2, PH_L1_G3, PH_L1_G4,
       PH_L2_DELTA, PH_L2_G2, PH_L2_G3, PH_L2_G4,
       PH_L3_G1, PH_L3_ATT, PH_L3_G2, PH_L3_G3, PH_L3_G4, PH_FINAL, NPHASE };
__global__ void __launch_bounds__(NTHR, 2) fwd_kernel(Args args) {
    extern __shared__ __attribute__((aligned(16))) unsigned char lds_raw[];
    Frame F; F.lds = (LAS unsigned char*)lds_raw; F.tid = threadIdx.x; F.lane = F.tid & 63; F.wave = __builtin_amdgcn_readfirstlane(F.tid >> 6);
    F.G = gridDim.x; F.bid = blockIdx.x; F.vcu = (F.G % 8 == 0) ? (F.bid % 8) * (F.G / 8) + F.bid / 8 : F.bid; F.in = args.in; F.out = args.out; F.ws = args.ws;
    volatile LAS unsigned* MISC = (volatile LAS unsigned*)(F.lds + MISC_OFF);
    for (int u = F.tid; u < 128; u += NTHR) ((LAS unsigned*)(F.lds + MISC_OFF))[u] = 0u;
    __syncthreads();
    const int lo = args.ph_lo, hi = args.ph_hi;
#if MK_ONE_LAUNCH
    XcdBarrier bar = xcd_barrier_post((unsigned*)(F.ws + WS_CTL), MISC + 8);
    if (lo < 0) cg::this_grid().sync();
    int n_ts = 0;
#define STAMP() do { STAMPX(n_ts); ++n_ts; } while (0)
    STAMP();
#define SEAM() do { xcd_barrier(bar); STAMP(); } while (0)
#else
    (void)MISC;
#define SEAM() do { } while (0)
#endif
#define IN(k) (lo <= (k) && (k) < hi)
#ifndef PHASE_MASK
#define PHASE_MASK 0xFFFFFFFFull
#endif
#ifndef DUP_MASK
#define DUP_MASK 0ull
#endif
#define PH(k, ...) do { if constexpr (((PHASE_MASK) >> (k)) & 1ull) { if (IN(k)) { __VA_ARGS__; if constexpr (((DUP_MASK) >> (k)) & 1ull) { __syncthreads(); __VA_ARGS__; } if (IN((k) + 1)) SEAM(); } } } while (0)
#define PH_EMPTY(k) do { } while (0)
    LAS unsigned char* ring = F.lds;
    const int c_ = F.bid;
#define RUN_G1(k, epi, Wt, nN, CMODE, cpar) PH(k, { Gemm g{WSB(WS_XSA), Wt, D, D, D, 0}; StaticOrder S; S.init(64, nN, F.G, c_); const int heavy_ = (64 * (nN)) % F.G; if (heavy_ == 0) ctx_gemm<CMODE, 8>(F, cpar, 0); pg8::gemm_phase(ring, g, S, epi); if (heavy_ != 0) ctx_gemm<CMODE, 8>(F, cpar, heavy_); })
    const float* XF = (const float*)(F.ws + WS_XSB);
#define RUN_G2(k, layer, BH_, Aptr, lda_, K_, Wt_, apn_, ldb_, nMr_, blat_, bctx_, xsout_) PH(k, { \
        EpiResid<BH_, true> e{blat_, F.out, WSF(WS_GATE) + ((size_t)(layer) * 2 + 0) * 2 * 1024, WSF(WS_CS) + ((size_t)(layer) * 2 + 1) * 2 * 1024, xsout_, WSF(WS_SLOTS)}; \
        Gemm g{Aptr, Wt_, lda_, ldb_, K_, apn_, 1 + (layer)}; StaticOrder S; S.init(64, 4, F.G, c_); \
        if (F.G == 256) { EpiResidLds<BH_, true> el{e.base, e.out, e.gate, e.csn, e.xs, e.slots}; pg8::gemm_phase(ring, g, S, el); } else pg8::gemm_phase(ring, g, S, e); STAMPX(34 + 4 * (1 + (layer))); \
        if (nMr_ == 65) { CtxP cp{Aptr, lda_, apn_, Wt_, ldb_, K_, 32, nullptr, nullptr, 0, nullptr, nullptr, bctx_, WSF(WS_XCTX), WSF(WS_GATE) + ((size_t)(layer) * 2 + 0) * 2 * 1024, WSF(WS_CS) + ((size_t)(layer) * 2 + 1) * 2 * 1024, xsout_, (layer) == 0}; ctx_gemm<4, (K_) / 128>(F, cp, 0); } STAMPX(35 + 4 * (1 + (layer))); })
#define RUN_G3(k, layer, nMr_, xsin_) PH(k, { \
        EpiG1<3> e{WSF(WS_SLOTS), WSF(WS_BIAS3) + (size_t)(layer) * 2 * FH2, FH2, WSB(WS_P), nullptr, nullptr}; \
        Gemm g{xsin_, WSB(WS_W_FFNIN) + (size_t)(layer) * FH2 * D, D, D, D, 0}; StaticOrder S; S.init(64, FH2 / 256, F.G, c_); pg8::gemm_phase(ring, g, S, e); \
        if (nMr_ == 65) { CtxP cp{xsin_, D, 0, WSB(WS_W_FFNIN) + (size_t)(layer) * FH2 * D, D, D, FH / 32, WSF(WS_BIAS3) + (size_t)(layer) * 2 * FH2 + FH2, WSB(WS_P), FH, nullptr, nullptr, nullptr, nullptr, nullptr, nullptr, nullptr}; ctx_gemm<3, 8>(F, cp, (64 * (FH2 / 256)) % F.G); } })
#define RUN_G4(k, layer, OH_, outp_, nMr_) PH(k, { \
        EpiResid<true, OH_> e{F.out, outp_, WSF(WS_GATE) + ((size_t)(layer) * 2 + 1) * 2 * 1024, ((layer) < 3) ? WSF(WS_CS) + ((size_t)((layer) + 1) * 2 + 0) * 2 * 1024 : (const float*)nullptr, WSB(WS_XSA), WSF(WS_SLOTS)}; \
        Gemm g{WSB(WS_P), WSB(WS_W_FFNOUT) + (size_t)(layer) * D * FH, FH, FH, FH, 0, 5 + (layer)}; StaticOrder S; S.init(64, 4, F.G, c_); \
        if (F.G == 256) { EpiResidLds<true, OH_> el{e.base, e.out, e.gate, e.csn, e.xs, e.slots}; pg8::gemm_phase(ring, g, S, el); } else pg8::gemm_phase(ring, g, S, e); STAMPX(34 + 4 * (5 + (layer))); \
        if (nMr_ == 65) { CtxP cp{WSB(WS_P), FH, 0, WSB(WS_W_FFNOUT) + (size_t)(layer) * D * FH, FH, FH, 32, nullptr, nullptr, 0, nullptr, nullptr, WSF(WS_XCTX), WSF(WS_XCTX), WSF(WS_GATE) + ((size_t)(layer) * 2 + 1) * 2 * 1024, ((layer) < 3) ? WSF(WS_CS) + ((size_t)((layer) + 1) * 2 + 0) * 2 * 1024 : (const float*)nullptr, WSB(WS_XSA)}; ctx_gemm<4, FH / 128>(F, cp, 0); } STAMPX(35 + 4 * (5 + (layer))); })

    PH(PH_P0A, phase_p0a(F));
    PH(PH_P0B, phase_p0b(F));
    { EpiG1<0> e{WSF(WS_SLOTS), WSF(WS_BIAS1), FH2, WSB(WS_P), nullptr, nullptr}; CtxP cp{WSB(WS_XSA), D, 0, WSB(WS_W_HGIN), D, D, HG_N / 32, WSF(WS_BIAS1) + FH2, WSB(WS_P), PLD, nullptr, nullptr, nullptr, nullptr, nullptr, nullptr, nullptr}; RUN_G1(PH_L0_G1, e, WSB(WS_W_HGIN), HG_N / 256, 0, cp); }
    PH(PH_L0_MA, phase_hg_a(F));
    PH(PH_L0_MB, phase_hg_b(F));
    PH(PH_L0_MC, phase_hg_c(F));
    RUN_G2(PH_L0_G2, 0, false, WSB(WS_XSA), D, D, WSB(WS_W_HGOUT), 0, D, 65, F.in[0], F.in[2], WSB(WS_XSB));
    RUN_G3(PH_L0_G3, 0, 65, WSB(WS_XSB));
    RUN_G4(PH_L0_G4, 0, true, (void*)F.out, 65);
    { EpiG1<1> e{WSF(WS_SLOTS), WSF(WS_BIAS1) + (size_t)1 * 2 * FH2, FH2, WSB(WS_P), WSF(WS_DT), WSB(WS_HALO)}; CtxP cp{WSB(WS_XSA), D, 0, WSB(WS_W_SSMIN), D, D, SSM_NP / 32, WSF(WS_BIAS1) + (size_t)1 * 2 * FH2 + FH2, WSB(WS_P), PLD, WSF(WS_DT), WSB(WS_HALO), nullptr, nullptr, nullptr, nullptr, nullptr}; RUN_G1(PH_L1_G1, e, WSB(WS_W_SSMIN), SSM_NP / 256, 1, cp); }
    PH(PH_L1_CV, phase_ssm_conv(F); ssm_tables(F));
    PH(PH_L1_MA, phase_ssm_a(F));
    PH(PH_L1_MB, phase_ssm_b(F));
    PH(PH_L1_MC, phase_ssm_c(F));
    if (F.G != 256) PH(PH_L1_MD, phase_ssm_d(F));
    PH(PH_L1_G2, {
        const float* gate_ = WSF(WS_GATE) + ((size_t)1 * 2 + 0) * 2 * 1024; const float* cs_ = WSF(WS_CS) + ((size_t)1 * 2 + 1) * 2 * 1024;
        const bool fuse_ = (F.G == 256);
        Gemm g{WSB(WS_P), WSB(WS_W_SSMOUT), PLD, SSM_DI, SSM_DI, 0, 2}; StaticOrder S; S.init(64, 4, F.G, c_);
        if (fuse_) {
            pg8::Unit u0; S.next(0, u0);
            if (F.tid < 256) {
                const float* sp = WSF(WS_SSQ) + (size_t)(u0.pm * BM + F.tid) * 32; float rg[4];
                _Pragma("unroll") for (int gq = 0; gq < 4; ++gq) { const f32x4 a = *(const f32x4*)(sp + 8 * gq), b_ = *(const f32x4*)(sp + 8 * gq + 4);
                    rg[gq] = rsqrtf((((a[0] + a[1]) + (a[2] + a[3])) + ((b_[0] + b_[1]) + (b_[2] + b_[3]))) * (1.0f / 512.0f) + EPS); }
                *(LAS f32x4*)(F.lds + RQ_OFF + F.tid * 16) = (f32x4){rg[0] / rg[1], rg[1] / rg[2], rg[2] / rg[3], rg[3]};
            }
            __syncthreads();
            EpiResidLds<true, true, true> el{(const void*)F.out, (void*)F.out, gate_, cs_, WSB(WS_XSA), WSF(WS_SLOTS)}; pg8::gemm_phase(ring, g, S, el);
        } else { EpiResid<true, true> e{(const void*)F.out, (void*)F.out, gate_, cs_, WSB(WS_XSA), WSF(WS_SLOTS)}; pg8::gemm_phase(ring, g, S, e); }
        { CtxP cp{WSB(WS_P), PLD, 0, WSB(WS_W_SSMOUT), SSM_DI, SSM_DI, 32, nullptr, nullptr, 0, nullptr, nullptr, WSF(WS_XCTX), WSF(WS_XCTX), gate_, cs_, WSB(WS_XSA), 0, fuse_ ? WSF(WS_SSQ) : (const float*)nullptr}; ctx_gemm<4, SSM_DI / 128>(F, cp, 0); }
    });
    RUN_G3(PH_L1_G3, 1, 65, WSB(WS_XSA));
    RUN_G4(PH_L1_G4, 1, true, (void*)F.out, 65);
    PH(PH_L2_DELTA, phase_pool_delta(F));
    RUN_G2(PH_L2_G2, 2, true, WSB(WS_P), D, 256, WSB(WS_W_POOL), 256, 256, 65, F.out, WSF(WS_XCTX), WSB(WS_XSB));
    RUN_G3(PH_L2_G3, 2, 65, WSB(WS_XSB));
    RUN_G4(PH_L2_G4, 2, true, (void*)F.out, 65);
    { EpiQKV e{WSF(WS_SLOTS), WSF(WS_BIAS1) + (size_t)3 * 2 * FH2, FH2, WSB(WS_P), WSF(WS_ROPE)}; CtxP cp{WSB(WS_XSA), D, 0, WSB(WS_W_QKV), D, D, ATT_N / 32, WSF(WS_BIAS1) + (size_t)3 * 2 * FH2 + FH2, WSB(WS_P), QK_LD, nullptr, nullptr, nullptr, nullptr, nullptr, nullptr, nullptr}; RUN_G1(PH_L3_G1, e, WSB(WS_W_QKV), ATT_N / 256, 2, cp); }
    PH(PH_L3_ATT, phase_att(F));
    RUN_G2(PH_L3_G2, 3, true, WSB(WS_XSA), D, D, WSB(WS_W_ATTOUT), 0, D, 64, F.out, WSF(WS_XCTX), WSB(WS_XSB));
    RUN_G3(PH_L3_G3, 3, 64, WSB(WS_XSB));
    RUN_G4(PH_L3_G4, 3, true, (void*)(F.ws + WS_XSB), 64);
    PH(PH_FINAL, phase_final(F));
    if (PA_I >= 0 || PB_I >= 0) {
        __syncthreads();
        if (PB_I >= 0) { const float eb = (float)(g_ts[PB_J < 0 ? 0 : PB_J] - g_ts[PB_I < 0 ? 0 : PB_I]) * 1e-5f;
            if (F.bid == 0) for (int row = 1 + F.wave; row <= 1024; row += 8) { float* xr = F.out + (size_t)row * D;
                for (int j = 0; j < 16; ++j) xr[j * 64 + F.lane] += eb; } }
        if (PA_I >= 0 && F.bid == 0 && F.tid == 0) { __builtin_amdgcn_s_waitcnt(0); F.out[0] += (float)(g_ts[PA_J < 0 ? 0 : PA_J] - g_ts[PA_I < 0 ? 0 : PA_I]) * 2e-5f * PA_FINE; }
    }
#undef IN
#undef PH
#undef SEAM
}

extern "C" void kernel_launch(void* const* d_in, const int* in_sizes, int n_in, void* d_out, int out_size, void* d_ws, size_t ws_size, hipStream_t stream) {
    static int grid = 0;
    if (grid == 0) {
        if (n_in != 27 || out_size != NLAT * D || ws_size < WS_END) { fprintf(stderr, "kernel_launch: unexpected shapes (n_in %d out %d ws %zu need %zu)\n", n_in, out_size, ws_size, (size_t)WS_END); grid = -1; return; }
        int dev = 0, cus = 0, per_cu = 0;
        hipGetDevice(&dev); hipDeviceGetAttribute(&cus, hipDeviceAttributeMultiprocessorCount, dev);
        if (hipFuncSetAttribute((const void*)fwd_kernel, hipFuncAttributeMaxDynamicSharedMemorySize, LDS_BYTES) != hipSuccess) { fprintf(stderr, "hipFuncSetAttribute failed\n"); grid = -1; return; }
        hipOccupancyMaxActiveBlocksPerMultiprocessor(&per_cu, (const void*)fwd_kernel, NTHR, LDS_BYTES);
        (void)hipGetLastError();
        if (per_cu < 1) { fprintf(stderr, "occupancy query says %d\n", per_cu); grid = -1; return; }
        grid = cus;
    }
    if (grid < 0) return;
    hipMemsetAsync((char*)d_ws + WS_CTL, 0, CTL_BYTES, stream);
    Args a{};
    for (int i = 0; i < 27; ++i) a.in[i] = (const float*)d_in[i];
    a.out = (float*)d_out; a.ws = (unsigned char*)d_ws;
    a.ph_lo = 0; a.ph_hi = NPHASE;
    void* kargs[] = {&a};
    hipError_t e = hipLaunchCooperativeKernel((const void*)fwd_kernel, dim3(grid), dim3(NTHR), kargs, LDS_BYTES, stream);
    if (e != hipSuccess) fprintf(stderr, "cooperative launch failed: %s\n", hipGetErrorString(e));
}
```

```cpp
#include <hip/hip_runtime.h>
#include <hip/hip_cooperative_groups.h>
#include <cstdio>
#include <cstdint>
namespace cg = cooperative_groups;

#ifndef MK_ONE_LAUNCH
#define MK_ONE_LAUNCH 1
#endif

#define LAS __attribute__((address_space(3)))
typedef unsigned short bf16_t;
typedef short bf16x8 __attribute__((ext_vector_type(8)));
typedef float f32x4 __attribute__((ext_vector_type(4)));
typedef float f32x2 __attribute__((ext_vector_type(2)));
typedef unsigned u32x4 __attribute__((ext_vector_type(4)));
typedef unsigned u32x2 __attribute__((ext_vector_type(2)));
typedef float f32x16 __attribute__((ext_vector_type(16)));
#define MFMA32(a, b, c) __builtin_amdgcn_mfma_f32_32x32x16_bf16((a), (b), (c), 0, 0, 0)

constexpr int D = 1024, NLAT = 16384, NCTX = 256, MALL = NLAT + NCTX, DEPTH = 4;
constexpr int FH = 2816, FH2 = 5632;
constexpr int HG_N = 5120;
constexpr int SSM_N = 5184, SSM_NP = 5376;
constexpr int SSM_DI = 2048, SSM_CD = 3072;
constexpr int ATT_N = 1536, QK_LD = 1536;
constexpr int PLD = 5120;
constexpr float EPS = 1e-6f;
constexpr int NWAVES = 8, NTHR = 512;
constexpr int LDS_BYTES = 147456, MISC_OFF = LDS_BYTES - 512;

constexpr size_t al256(size_t x) { return (x + 255) & ~(size_t)255; }
constexpr size_t WS_CTL = 0, CTL_BYTES = 131072;
constexpr size_t WS_MODS = WS_CTL + CTL_BYTES;
constexpr size_t WS_CS = WS_MODS + (size_t)4 * 2 * 6144 * 4;
constexpr size_t WS_GATE = WS_CS + (size_t)4 * 2 * 2 * 1024 * 4;
constexpr size_t WS_BIAS1 = WS_GATE + (size_t)4 * 2 * 2 * 1024 * 4;
constexpr size_t WS_BIAS3 = WS_BIAS1 + (size_t)4 * 2 * FH2 * 4;
constexpr size_t WS_LB = WS_BIAS3 + (size_t)4 * 2 * FH2 * 4;
constexpr size_t WS_ROPE = WS_LB + 2 * 1024 * 4;
constexpr size_t WS_SLOTS = WS_ROPE + 2 * 256 * 16 * 4;
constexpr size_t WS_XCTX = WS_SLOTS + (size_t)MALL * 16 * 4;
constexpr size_t WS_DT = WS_XCTX + (size_t)NCTX * D * 4;
constexpr size_t WS_W_HGIN = al256(WS_DT + (size_t)MALL * 64 * 4);
constexpr size_t WS_W_HGOUT = WS_W_HGIN + (size_t)HG_N * D * 2;
constexpr size_t WS_W_SSMIN = WS_W_HGOUT + (size_t)D * D * 2;
constexpr size_t WS_W_SSMOUT = WS_W_SSMIN + (size_t)SSM_NP * D * 2;
constexpr size_t WS_W_POOL = WS_W_SSMOUT + (size_t)D * SSM_DI * 2;
constexpr size_t WS_W_QKV = WS_W_POOL + (size_t)4 * 256 * 256 * 2;
constexpr size_t WS_W_ATTOUT = WS_W_QKV + (size_t)ATT_N * D * 2;
constexpr size_t WS_W_FFNIN = WS_W_ATTOUT + (size_t)D * D * 2;
constexpr size_t WS_W_FFNOUT = WS_W_FFNIN + (size_t)4 * FH2 * D * 2;
constexpr size_t WS_XSA = WS_W_FFNOUT + (size_t)4 * D * FH * 2;
constexpr size_t WS_P = WS_XSA + (size_t)MALL * D * 2;
constexpr size_t P_BYTES = (size_t)MALL * PLD * 2;
constexpr size_t WS_XSB = WS_P + (size_t)96 * 1024 * 1024;
constexpr size_t WS_ST = WS_P + P_BYTES;
constexpr size_t ST_BYTES = (size_t)2 * 5 * 260 * 128 * 128 * 2;
constexpr size_t WS_HALO = WS_ST + (size_t)72 * 1024 * 1024;
constexpr size_t WS_SSQ = WS_ST + (size_t)79 * 1024 * 1024;
constexpr size_t WS_END = WS_ST + ST_BYTES;
static_assert(WS_HALO + (size_t)260 * 4 * 3072 * 2 <= WS_SSQ && WS_SSQ + (size_t)MALL * 32 * 4 <= WS_END && (size_t)2 * 32 * 65 * 8192 * 2 <= (size_t)72 * 1024 * 1024, "halo buffer");
static_assert(WS_END <= (size_t)402653184, "workspace map exceeds 4 x largest input");
static_assert((size_t)MALL * FH * 2 <= (size_t)96 * 1024 * 1024 && WS_XSB + (size_t)NLAT * D * 4 <= WS_ST, "H / XS_B / final f32 X overlay inside P");

__device__ __forceinline__ float bf2f(bf16_t b) { return __uint_as_float(((unsigned)b) << 16); }
__device__ __forceinline__ unsigned f2bf(float f) { unsigned u = __float_as_uint(f); return (u + 0x7fffu + ((u >> 16) & 1u)) >> 16; }
__device__ __forceinline__ unsigned pk2(float lo, float hi) { return f2bf(lo) | (f2bf(hi) << 16); }
typedef __bf16 bf16v2_t __attribute__((ext_vector_type(2)));
__device__ __forceinline__ unsigned cvt_pk_bf16(float lo, float hi) { const f32x2 f = {lo, hi}; return __builtin_bit_cast(unsigned, __builtin_convertvector(f, bf16v2_t)); }
__device__ __forceinline__ float sigmoidf_(float x) { return __builtin_amdgcn_rcpf(1.0f + __expf(-x)); }
__device__ __forceinline__ float siluf_(float x) { return x * sigmoidf_(x); }
__device__ __forceinline__ float lo_bf(unsigned w) { return __uint_as_float(w << 16); }
__device__ __forceinline__ float hi_bf(unsigned w) { return __uint_as_float(w & 0xffff0000u); }
__device__ __forceinline__ float wave_sum(float v) {
#pragma unroll
    for (int o = 1; o < 64; o <<= 1) v += __shfl_xor(v, o);
    return v;
}

#define XB_TMO      128
#define XB_XCNT(j)  (256  + 64 * (j))
#define XB_XSUB(j)  (1280 + 64 * (j))
#define XB_XGEN(j)  (2304 + 64 * (j))
#define XB_TOP      3328
#define XB_TOPGEN   3392
#define XCD_BAR_WORDS 3456
#define XB_SPIN_CAP (1u << 22)
__device__ __forceinline__ unsigned xb_ld(unsigned* p)              { return __hip_atomic_load(p, __ATOMIC_RELAXED, __HIP_MEMORY_SCOPE_AGENT); }
__device__ __forceinline__ unsigned xb_add(unsigned* p, unsigned v) { return __hip_atomic_fetch_add(p, v, __ATOMIC_RELAXED, __HIP_MEMORY_SCOPE_AGENT); }
__device__ __forceinline__ unsigned xb_xcc_id() { return (unsigned)__builtin_amdgcn_s_getreg((3 << 11) | 20) & 0xFu; }
#define XB_SPIN(cond, bar) do { unsigned _sp = 0; while (cond) { __builtin_amdgcn_s_sleep(1); \
    if ((++_sp & 255u) == 0u) { if (xb_ld(&(bar)[XB_TMO])) break; if (_sp > XB_SPIN_CAP) { atomicAdd(&(bar)[XB_TMO], 1u); break; } } } } while (0)
struct XcdBarrier { unsigned* bar; unsigned x; volatile LAS unsigned* st; };
__device__ __forceinline__ XcdBarrier xcd_barrier_post(unsigned* bar, volatile LAS unsigned* st) {
    XcdBarrier b; b.bar = bar; b.x = xb_xcc_id(); b.st = st;
    if (threadIdx.x == 0) (void)xb_add(&bar[XB_XCNT(b.x)], 1u);
    return b;
}
__device__ __forceinline__ void xcd_barrier_complete(unsigned* bar, unsigned x, unsigned& nloc, unsigned& nx) {
    const unsigned G = gridDim.x * gridDim.y * gridDim.z;
    unsigned sum, cnt, mine, sp = 0u;
    for (;;) {
        sum = 0u; cnt = 0u; mine = 0u;
#pragma unroll
        for (unsigned j = 0; j < 16; ++j) { const unsigned c = xb_ld(&bar[XB_XCNT(j)]); sum += c; cnt += (c > 0u) ? 1u : 0u; mine = (j == x) ? c : mine; }
        if (sum == G) break;
        __builtin_amdgcn_s_sleep(1);
        if ((++sp & 255u) == 0u) { if (xb_ld(&bar[XB_TMO])) break; if (sp > XB_SPIN_CAP) { atomicAdd(&bar[XB_TMO], 1u); break; } }
    }
    nloc = mine > 0u ? mine : 1u; nx = cnt > 0u ? cnt : 1u;
}
__device__ __forceinline__ void xcd_barrier(const XcdBarrier& b) {
    asm volatile("s_waitcnt vmcnt(0)" ::: "memory");
    __syncthreads();
    if (threadIdx.x == 0) {
        unsigned* bar = b.bar;
        __builtin_amdgcn_s_waitcnt(0);
        unsigned nloc = b.st[0], nx = b.st[1];
        if (nloc == 0u) { xcd_barrier_complete(bar, b.x, nloc, nx); b.st[0] = nloc; b.st[1] = nx; }
        const unsigned old = xb_add(&bar[XB_XSUB(b.x)], 1u);
        const unsigned gen = old / nloc;
        if (old + 1u == (gen + 1u) * nloc) {
            __builtin_amdgcn_fence(__ATOMIC_RELEASE, "agent");
            asm volatile("s_waitcnt vmcnt(0)" ::: "memory");
            const unsigned og = xb_add(&bar[XB_TOP], 1u);
            const unsigned tg = og / nx;
            if (og + 1u == (tg + 1u) * nx) xb_add(&bar[XB_TOPGEN], 1u);
            else XB_SPIN(xb_ld(&bar[XB_TOPGEN]) == tg, bar);
            __builtin_amdgcn_fence(__ATOMIC_ACQUIRE, "agent");
            xb_add(&bar[XB_XGEN(b.x)], 1u);
            asm volatile("s_waitcnt vmcnt(0)" ::: "memory");
        } else {
            XB_SPIN(xb_ld(&bar[XB_XGEN(b.x)]) == gen, bar);
            __builtin_amdgcn_fence(__ATOMIC_ACQUIRE, "agent");
            asm volatile("s_waitcnt vmcnt(0)" ::: "memory");
        }
    }
    __syncthreads();
}

#ifndef PA_I
#define PA_I -1
#define PA_J -1
#endif
#ifndef PA_FINE
#define PA_FINE 1.0f
#endif
#ifndef PB_I
#define PB_I -1
#define PB_J -1
#endif
__device__ unsigned long long g_ts[96];
#define STAMPX(i) do { if ((PA_I >= 0 || PB_I >= 0) && blockIdx.x == 0 && threadIdx.x == 0) g_ts[(i)] = __builtin_amdgcn_s_memrealtime(); } while (0)
namespace pg8 {
constexpr int BM = 256, BK = 64, HALF = 128, HTB = HALF * BK * 2, STAGE_BYTES = 8 * HTB, NXCD = 8, WGM = 8;
__host__ __device__ __forceinline__ int lds_byte(int r, int c) { const int st = (r >> 4) * 2 + (c >> 5), rr = r & 15, cc = c & 31, ob = rr * 64 + cc * 2; return st * 1024 + (ob ^ (((ob >> 9) & 1) << 5)); }
__host__ __device__ __forceinline__ void stage_rc(int b, int& R, int& C) { const int st = b / 1024, sb = b % 1024, swz = sb ^ (((sb >> 9) & 1) << 5); R = (st >> 1) * 16 + swz / 64; C = (st & 1) * 32 + (swz % 64) / 2; }
__host__ __device__ __forceinline__ int perm32(int rho) { const int n = rho >> 4, i = rho & 15; return 8 * (i >> 2) + 4 * n + (i & 3); }
struct Unit { int pm, pn; };
struct Gemm { const bf16_t* A; const bf16_t* Bt; int lda, ldb, K, a_pn_step; int stamp = 0; };
struct StaticOrder {
    int nM, nN, nwg, G, c;
    __device__ __forceinline__ void init(int nM_, int nN_, int G_, int c_) { nM = nM_; nN = nN_; nwg = nM * nN; G = G_; c = c_; }
    __device__ __forceinline__ bool next(int i, Unit& u) const {
        const long L = (long)i * G + c; if (L >= nwg) return false;
        int wgid = (int)L; { const int q = nwg / NXCD, r = nwg % NXCD, xcd = wgid % NXCD, off = wgid / NXCD; wgid = (xcd < r ? xcd * (q + 1) : r * (q + 1) + (xcd - r) * q) + off; }
        const int nig = WGM * nN, gid = wgid / nig, fm = gid * WGM, gsz = (nM - fm) < WGM ? (nM - fm) : WGM;
        u.pm = fm + ((wgid % nig) % gsz); u.pn = (wgid % nig) / gsz; return true;
    }
};

template <class Epi, bool ALIGN_EPI = true, bool SP2 = true>
__device__ __forceinline__ void gemm_phase(LAS unsigned char* lds, const Gemm g, const StaticOrder& S, const Epi& E) {
    const int tid = threadIdx.x, wid = __builtin_amdgcn_readfirstlane(tid >> 6), lane = tid & 63, wr = wid >> 2, wc = wid & 3, fr = lane & 15, fq = lane >> 4;
    const int nt = g.K / BK;
    unsigned voffA[2], voffB[2];
#pragma unroll
    for (int i = 0; i < 2; ++i) { int R, C; stage_rc(tid * 16 + i * 8192, R, C); const int Rb = Epi::PERM ? ((R & ~31) + perm32(R & 31)) : R;
        voffA[i] = (unsigned)(R * g.lda + C) * 2u; voffB[i] = (unsigned)(Rb * g.ldb + C) * 2u; }
    const size_t kstep = (size_t)(BK * 2);
    const size_t hstepA = (size_t)HALF * g.lda * 2, hstepB = (size_t)HALF * g.ldb * 2;
    const unsigned ldsw = (unsigned)wid * 1024u;
    const int aoff = lds_byte(wr * 64 + fr, fq * 8), boff = lds_byte(wc * 32 + fr, fq * 8);
#define PG8_SA(b, h) (((b) * 2 + (h)) * HTB)
#define PG8_SB(b, h) ((4 + (b) * 2 + (h)) * HTB)
#define PG8_STAGE(bufoff, gbase, voff) do { _Pragma("unroll") for (int _i = 0; _i < 2; ++_i) \
        __builtin_amdgcn_global_load_lds((const unsigned*)((const char*)(gbase) + (voff)[_i]), (LAS unsigned*)(lds + (bufoff) + ldsw + _i * 8192), 16, 0, 0); } while (0)
#define PG8_LDA(dst, b, h) do { _Pragma("unroll") for (int m = 0; m < 4; ++m) _Pragma("unroll") for (int k = 0; k < 2; ++k) dst[m][k] = *(const LAS bf16x8*)(lds + PG8_SA(b, h) + aoff + m * 2048 + k * 1024); } while (0)
#define PG8_LDB(dst, b, h) do { _Pragma("unroll") for (int n = 0; n < 2; ++n) _Pragma("unroll") for (int k = 0; k < 2; ++k) dst[n][k] = *(const LAS bf16x8*)(lds + PG8_SB(b, h) + boff + n * 2048 + k * 1024); } while (0)
#define PG8_MMA(ai, bj, At, Bt) do { __builtin_amdgcn_s_setprio(1); _Pragma("unroll") for (int m = 0; m < 4; ++m) _Pragma("unroll") for (int n = 0; n < 2; ++n) _Pragma("unroll") for (int k = 0; k < 2; ++k) \
        acc[ai][bj][m][n] = __builtin_amdgcn_mfma_f32_16x16x32_bf16(Bt[n][k], At[m][k], acc[ai][bj][m][n], 0, 0, 0); __builtin_amdgcn_s_setprio(0); } while (0)
#define PG8_WAIT_V(n) asm volatile("s_waitcnt vmcnt(" #n ")" ::: "memory")
#define PG8_WAIT_L(n) asm volatile("s_waitcnt lgkmcnt(" #n ")" ::: "memory")
#define PG8_BAR __builtin_amdgcn_s_barrier()
#define PG8_SCHED __builtin_amdgcn_sched_barrier(0)
    Unit cur, nxt; int ui = 0;
    if (!S.next(0, cur)) return;
    f32x4 acc[2][2][4][2];
#pragma unroll
    for (int a = 0; a < 2; ++a)
#pragma unroll
        for (int b = 0; b < 2; ++b)
#pragma unroll
            for (int m = 0; m < 4; ++m)
#pragma unroll
                for (int n = 0; n < 2; ++n) acc[a][b][m][n] = (f32x4){0.f, 0.f, 0.f, 0.f};
    bf16x8 At[4][2], B0[2][2], B1[2][2];
    const char* cA = (const char*)g.A + ((size_t)cur.pm * BM * g.lda + (size_t)cur.pn * g.a_pn_step) * 2; const char* cB = (const char*)g.Bt + (size_t)cur.pn * BM * g.ldb * 2;
    if constexpr (SP2) {
        PG8_STAGE(PG8_SB(0, 0), cB, voffB); PG8_STAGE(PG8_SB(0, 1), cB + hstepB, voffB); PG8_STAGE(PG8_SA(0, 0), cA, voffA); PG8_STAGE(PG8_SA(0, 1), cA + hstepA, voffA);
        if (wr == 1) PG8_BAR;
        PG8_WAIT_V(2); PG8_BAR;
        PG8_STAGE(PG8_SB(1, 0), cB + kstep, voffB); PG8_STAGE(PG8_SA(1, 0), cA + kstep, voffA); PG8_STAGE(PG8_SB(1, 1), cB + hstepB + kstep, voffB);
        PG8_WAIT_V(6); PG8_BAR;
    } else {
        PG8_STAGE(PG8_SB(0, 0), cB, voffB); PG8_STAGE(PG8_SA(0, 0), cA, voffA); PG8_STAGE(PG8_SB(0, 1), cB + hstepB, voffB); PG8_STAGE(PG8_SA(0, 1), cA + hstepA, voffA);
        if (wr == 1) PG8_BAR;
        PG8_WAIT_V(4); PG8_BAR;
        PG8_STAGE(PG8_SB(1, 0), cB + kstep, voffB); PG8_STAGE(PG8_SA(1, 0), cA + kstep, voffA); PG8_STAGE(PG8_SB(1, 1), cB + hstepB + kstep, voffB);
        PG8_WAIT_V(6); PG8_BAR;
    }
    for (;;) {
        const bool has_next = S.next(ui + 1, nxt);
        const char* nA = has_next ? (const char*)g.A + ((size_t)nxt.pm * BM * g.lda + (size_t)nxt.pn * g.a_pn_step) * 2 : cA; const char* nB = has_next ? (const char*)g.Bt + (size_t)nxt.pn * BM * g.ldb * 2 : cB;
        for (int t = 0; t < nt; t += 2) {
            if constexpr (Epi::KSCALE) { if (t != 0 && (t & 7) == 0) E.kscale(acc, t >> 3, wr, fr, lds); }
            const bool last = (t == nt - 2);
            const char* a1 = cA + (size_t)(t + 1) * kstep;
            const char* a2 = last ? nA : cA + (size_t)(t + 2) * kstep; const char* b2 = last ? nB : cB + (size_t)(t + 2) * kstep;
            const char* a3 = a2 + kstep; const char* b3 = b2 + kstep;
            if constexpr (SP2) {
            PG8_LDB(B0, 0, 0); PG8_LDB(B1, 0, 1); PG8_SCHED; PG8_LDA(At, 0, 0); PG8_STAGE(PG8_SA(1, 1), a1 + hstepA, voffA);
            PG8_WAIT_V(8); PG8_WAIT_L(0); PG8_BAR; PG8_MMA(0, 0, At, B0); PG8_MMA(0, 1, At, B1); PG8_BAR; PG8_SCHED;
            PG8_LDA(At, 0, 1); PG8_STAGE(PG8_SB(0, 0), b2, voffB); PG8_STAGE(PG8_SB(0, 1), b2 + hstepB, voffB); PG8_STAGE(PG8_SA(0, 0), a2, voffA);
            PG8_WAIT_V(8); PG8_WAIT_L(0); PG8_BAR; PG8_MMA(1, 0, At, B0); PG8_MMA(1, 1, At, B1); PG8_BAR; PG8_SCHED;
            PG8_LDB(B0, 1, 0); PG8_LDB(B1, 1, 1); PG8_SCHED; PG8_LDA(At, 1, 0); PG8_STAGE(PG8_SA(0, 1), a2 + hstepA, voffA);
            PG8_WAIT_V(8); PG8_WAIT_L(0); PG8_BAR; PG8_MMA(0, 0, At, B0); PG8_MMA(0, 1, At, B1); PG8_BAR; PG8_SCHED;
            PG8_LDA(At, 1, 1); PG8_STAGE(PG8_SB(1, 0), b3, voffB); PG8_STAGE(PG8_SB(1, 1), b3 + hstepB, voffB); PG8_STAGE(PG8_SA(1, 0), a3, voffA);
            PG8_WAIT_V(8); PG8_WAIT_L(0); PG8_BAR; PG8_MMA(1, 0, At, B0); PG8_MMA(1, 1, At, B1); PG8_BAR; PG8_SCHED;
            } else {
            PG8_LDB(B0, 0, 0); PG8_SCHED; PG8_LDA(At, 0, 0); PG8_STAGE(PG8_SA(1, 1), a1 + hstepA, voffA);
            PG8_WAIT_L(8); PG8_BAR; PG8_WAIT_L(0); PG8_MMA(0, 0, At, B0); PG8_BAR; PG8_SCHED;
            PG8_LDB(B1, 0, 1); PG8_STAGE(PG8_SB(0, 0), b2, voffB);
            PG8_BAR; PG8_WAIT_L(0); PG8_MMA(0, 1, At, B1); PG8_BAR;
            PG8_LDA(At, 0, 1); PG8_STAGE(PG8_SA(0, 0), a2, voffA);
            PG8_BAR; PG8_WAIT_L(0); PG8_MMA(1, 0, At, B0); PG8_BAR; PG8_SCHED;
            PG8_STAGE(PG8_SB(0, 1), b2 + hstepB, voffB);
            PG8_WAIT_V(6); PG8_BAR; PG8_MMA(1, 1, At, B1); PG8_BAR;
            PG8_LDB(B0, 1, 0); PG8_SCHED; PG8_LDA(At, 1, 0); PG8_STAGE(PG8_SA(0, 1), a2 + hstepA, voffA);
            PG8_WAIT_L(8); PG8_BAR; PG8_WAIT_L(0); PG8_MMA(0, 0, At, B0); PG8_BAR; PG8_SCHED;
            PG8_LDB(B1, 1, 1); PG8_STAGE(PG8_SB(1, 0), b3, voffB);
            PG8_BAR; PG8_WAIT_L(0); PG8_MMA(0, 1, At, B1); PG8_BAR;
            PG8_LDA(At, 1, 1); PG8_STAGE(PG8_SA(1, 0), a3, voffA);
            PG8_BAR; PG8_WAIT_L(0); PG8_MMA(1, 0, At, B0); PG8_BAR; PG8_SCHED;
            PG8_STAGE(PG8_SB(1, 1), b3 + hstepB, voffB);
            PG8_WAIT_V(6); PG8_BAR; PG8_MMA(1, 1, At, B1); PG8_BAR;
            }
        }
        if (ui == 0) STAMPX(32 + 4 * g.stamp);
        if constexpr (ALIGN_EPI) { if (wr == 0) PG8_BAR; }
        if constexpr (!Epi::AFTER_DRAIN) { E(acc, cur, wr, wc, fr, fq); if (ui == 0) STAMPX(33 + 4 * g.stamp); }
        if (!has_next) break;
#pragma unroll
        for (int a = 0; a < 2; ++a)
#pragma unroll
            for (int b = 0; b < 2; ++b)
#pragma unroll
                for (int m = 0; m < 4; ++m)
#pragma unroll
                    for (int n = 0; n < 2; ++n) acc[a][b][m][n] = (f32x4){0.f, 0.f, 0.f, 0.f};
        cur = nxt; cA = nA; cB = nB; ++ui;
        if constexpr (ALIGN_EPI) { if (wr == 1) PG8_BAR; }
    }
    PG8_WAIT_V(0);
    if constexpr (!ALIGN_EPI) { if (wr == 0) PG8_BAR; }
    PG8_BAR;
    if constexpr (Epi::AFTER_DRAIN) { E.fused(acc, cur, wr, wc, fr, fq, lds, wid, lane); STAMPX(33 + 4 * g.stamp); }
#undef PG8_SA
#undef PG8_SB
#undef PG8_STAGE
#undef PG8_LDA
#undef PG8_LDB
#undef PG8_MMA
#undef PG8_WAIT_V
#undef PG8_WAIT_L
#undef PG8_BAR
#undef PG8_SCHED
}
}
using pg8::Unit; using pg8::Gemm; using pg8::StaticOrder; using pg8::HALF; using pg8::BM;

__device__ __forceinline__ void load_rstd(const float* slots, int row0, int fq, float (&rs)[2][4]) {
#pragma unroll
    for (int ai = 0; ai < 2; ++ai)
#pragma unroll
        for (int m = 0; m < 4; ++m) {
            const f32x4 s = *(const f32x4*)(slots + (size_t)(row0 + ai * HALF + m * 16) * 16 + 4 * fq);
            float t = (s.x + s.y) + (s.z + s.w); t += __shfl_xor(t, 16); t += __shfl_xor(t, 32);
            rs[ai][m] = rsqrtf(t * (1.0f / 1024.0f) + EPS);
        }
}
template <int MODE> struct EpiG1 {
    static constexpr bool PERM = true, AFTER_DRAIN = false, KSCALE = false;
    const float* slots; const float* bias; int bias_ld;
    bf16_t* O; float* DT; bf16_t* HALO;
    __device__ __forceinline__ void operator()(const f32x4 (&acc)[2][2][4][2], const Unit& u, int wr, int wc, int fr, int fq) const {
        const int row0 = u.pm * BM + wr * 64 + fr; const int var = (u.pm >= 64) ? 1 : 0;
        float rs[2][4]; load_rstd(slots, row0, fq, rs);
        const int cl = wc * 32 + 8 * fq;
        const float* bp = bias + (size_t)var * bias_ld + u.pn * BM + cl;
        f32x4 bv[2][2];
#pragma unroll
        for (int bj = 0; bj < 2; ++bj)
#pragma unroll
            for (int n = 0; n < 2; ++n) bv[bj][n] = *(const f32x4*)(bp + bj * HALF + 4 * n);
#pragma unroll
        for (int ai = 0; ai < 2; ++ai)
#pragma unroll
            for (int m = 0; m < 4; ++m) {
                const int row = row0 + ai * HALF + m * 16; const float r = rs[ai][m];
                if constexpr (MODE == 3) {
                    f32x4 g0 = acc[ai][0][m][0] * r + bv[0][0], g1 = acc[ai][0][m][1] * r + bv[0][1];
                    f32x4 u0 = acc[ai][1][m][0] * r + bv[1][0], u1 = acc[ai][1][m][1] * r + bv[1][1];
                    u32x4 w;
                    w.x = cvt_pk_bf16(siluf_(g0[0]) * u0[0], siluf_(g0[1]) * u0[1]); w.y = cvt_pk_bf16(siluf_(g0[2]) * u0[2], siluf_(g0[3]) * u0[3]);
                    w.z = cvt_pk_bf16(siluf_(g1[0]) * u1[0], siluf_(g1[1]) * u1[1]); w.w = cvt_pk_bf16(siluf_(g1[2]) * u1[2], siluf_(g1[3]) * u1[3]);
                    *(u32x4*)(O + (size_t)row * FH + u.pn * HALF + cl) = w;
                } else {
#pragma unroll
                    for (int bj = 0; bj < 2; ++bj) {
                        f32x4 v0 = acc[ai][bj][m][0] * r + bv[bj][0], v1 = acc[ai][bj][m][1] * r + bv[bj][1];
                        const int col = u.pn * BM + bj * HALF + cl;
                        if constexpr (MODE == 0) {
                            if (u.pn < 4 || u.pn >= 16) {
#pragma unroll
                                for (int j = 0; j < 4; ++j) { v0[j] = siluf_(v0[j]); v1[j] = siluf_(v1[j]); } }
                            u32x4 w; w.x = cvt_pk_bf16(v0[0], v0[1]); w.y = cvt_pk_bf16(v0[2], v0[3]); w.z = cvt_pk_bf16(v1[0], v1[1]); w.w = cvt_pk_bf16(v1[2], v1[3]);
                            *(u32x4*)(O + (size_t)row * PLD + col) = w;
                        } else if constexpr (MODE == 1) {
                            if (u.pn < 20) {
                                u32x4 w; w.x = cvt_pk_bf16(v0[0], v0[1]); w.y = cvt_pk_bf16(v0[2], v0[3]); w.z = cvt_pk_bf16(v1[0], v1[1]); w.w = cvt_pk_bf16(v1[2], v1[3]);
                                *(u32x4*)(O + (size_t)row * PLD + col) = w;
                                if (u.pn >= 8) {
                                    const int rm = row & 63, tk = row >> 6;
                                    if (rm >= 62 && tk + 1 < 260) *(u32x4*)(HALO + ((size_t)(tk + 1) * 4 + (rm - 62)) * SSM_CD + (col - 2048)) = w;
                                    if (rm < 2 && tk >= 1) *(u32x4*)(HALO + ((size_t)(tk - 1) * 4 + 2 + rm) * SSM_CD + (col - 2048)) = w;
                                }
                            } else if (bj == 0 && wc < 2) {
                                float* dp = DT + (size_t)row * 64 + cl; *(f32x4*)dp = v0; *(f32x4*)(dp + 4) = v1;
                            }
                        }
                    }
                }
            }
    }
};
struct EpiQKV {
    static constexpr bool PERM = true, AFTER_DRAIN = false, KSCALE = false;
    const float* slots; const float* bias; int bias_ld; bf16_t* O; const float* rope;
    __device__ __forceinline__ void operator()(const f32x4 (&acc)[2][2][4][2], const Unit& u, int wr, int wc, int fr, int fq) const {
        const int row0 = u.pm * BM + wr * 64 + fr; const int var = (u.pm >= 64) ? 1 : 0;
        float rs[2][4]; load_rstd(slots, row0, fq, rs);
        const int cl = wc * 32 + 8 * fq;
        const float* bp = bias + (size_t)var * bias_ld + u.pn * BM + cl;
        f32x4 bv[2][2];
#pragma unroll
        for (int bj = 0; bj < 2; ++bj)
#pragma unroll
            for (int n = 0; n < 2; ++n) bv[bj][n] = *(const f32x4*)(bp + bj * HALF + 4 * n);
        const float qs = (u.pn < 4) ? 0.125f * 1.4426950408889634f : 1.0f;     const float sg = (fq < 2) ? -1.f : 1.f; const bool do_rope = (var == 0) && (u.pn < 5);
        bf16_t* op = O + (size_t)row0 * QK_LD + u.pn * BM + cl;
#pragma unroll
        for (int ai = 0; ai < 2; ++ai)
#pragma unroll
            for (int m = 0; m < 4; ++m) { const int row = row0 + ai * HALF + m * 16; const float r = rs[ai][m];
                f32x4 c0 = {1.f, 1.f, 1.f, 1.f}, c1 = c0, s0 = {0.f, 0.f, 0.f, 0.f}, s1 = s0;
                if (do_rope) { const int pos = (wc & 1) ? (row & 63) : (row >> 6); const float* cp = rope + pos * 16 + 8 * (fq & 1);
                    c0 = *(const f32x4*)cp; c1 = *(const f32x4*)(cp + 4); s0 = *(const f32x4*)(cp + 4096) * sg; s1 = *(const f32x4*)(cp + 4100) * sg; }
#pragma unroll
                for (int bj = 0; bj < 2; ++bj) { f32x4 v0 = acc[ai][bj][m][0] * r + bv[bj][0], v1 = acc[ai][bj][m][1] * r + bv[bj][1];
                    f32x4 p0, p1;
#pragma unroll
                    for (int j = 0; j < 4; ++j) { p0[j] = __shfl_xor(v0[j], 32); p1[j] = __shfl_xor(v1[j], 32); }
                    v0 = (v0 * c0 + p0 * s0) * qs; v1 = (v1 * c1 + p1 * s1) * qs;
                    u32x4 w; w.x = cvt_pk_bf16(v0[0], v0[1]); w.y = cvt_pk_bf16(v0[2], v0[3]); w.z = cvt_pk_bf16(v1[0], v1[1]); w.w = cvt_pk_bf16(v1[2], v1[3]);
                    *(u32x4*)(op + (size_t)(ai * HALF + m * 16) * QK_LD + bj * HALF) = w; }
                asm volatile("" ::: "memory"); }
    }
};
typedef _Float16 h16x4 __attribute__((ext_vector_type(4)));
typedef _Float16 h16x8 __attribute__((ext_vector_type(8)));
typedef float f32x8 __attribute__((ext_vector_type(8)));
template <bool BH, bool OH> struct EpiResid {
    static constexpr bool PERM = false, AFTER_DRAIN = false, KSCALE = false;
    const void* base; void* out;
    const float* gate; const float* csn; bf16_t* xs; float* slots;
    __device__ __forceinline__ void operator()(const f32x4 (&acc)[2][2][4][2], const Unit& u, int wr, int wc, int fr, int fq) const {
        const int row0 = u.pm * BM + wr * 64 + fr, col0 = u.pn * BM + wc * 32 + 4 * fq;
        f32x4 gv[2][2], cv[2][2];
#pragma unroll
        for (int bj = 0; bj < 2; ++bj)
#pragma unroll
            for (int n = 0; n < 2; ++n) { gv[bj][n] = *(const f32x4*)(gate + col0 + bj * HALF + n * 16);
                cv[bj][n] = csn ? *(const f32x4*)(csn + col0 + bj * HALF + n * 16) : (f32x4){0.f, 0.f, 0.f, 0.f}; }
#pragma unroll
        for (int ai = 0; ai < 2; ++ai)
#pragma unroll
            for (int m = 0; m < 4; ++m) {
                const int row = row0 + ai * HALF + m * 16; const size_t off = (size_t)row * D + col0; float ss = 0.f;
#pragma unroll
                for (int bj = 0; bj < 2; ++bj)
#pragma unroll
                    for (int n = 0; n < 2; ++n) {
                        f32x4 b;
                        if constexpr (BH) b = __builtin_convertvector(*(const h16x4*)((const _Float16*)base + off + bj * HALF + n * 16), f32x4);
                        else b = *(const f32x4*)((const float*)base + off + bj * HALF + n * 16);
                        const f32x4 x = b + gv[bj][n] * acc[ai][bj][m][n];
                        if constexpr (OH) *(h16x4*)((_Float16*)out + off + bj * HALF + n * 16) = __builtin_convertvector(x, h16x4);
                        else *(f32x4*)((float*)out + off + bj * HALF + n * 16) = x;
                        ss += (x[0] * x[0] + x[1] * x[1]) + (x[2] * x[2] + x[3] * x[3]);
                        if (csn) { const f32x4 y = x * cv[bj][n]; u32x2 w; w.x = cvt_pk_bf16(y[0], y[1]); w.y = cvt_pk_bf16(y[2], y[3]); *(u32x2*)(xs + off + bj * HALF + n * 16) = w; }
                    }
                ss += __shfl_xor(ss, 16); ss += __shfl_xor(ss, 32);
                if (fq == 0) slots[(size_t)row * 16 + u.pn * 4 + wc] = ss;
            }
    }
};

constexpr int RQ_OFF = 133120;
template <bool BH, bool OH, bool KS = false> struct EpiResidLds {
    static constexpr bool PERM = false, AFTER_DRAIN = true, KSCALE = KS;
    __device__ __forceinline__ void kscale(f32x4 (&acc)[2][2][4][2], int g, int wr, int fr, LAS unsigned char* lds) const {
        const LAS float* RQ = (const LAS float*)(lds + RQ_OFF);
#pragma unroll
        for (int ai = 0; ai < 2; ++ai)
#pragma unroll
            for (int m = 0; m < 4; ++m) { const float q = RQ[(ai * HALF + wr * 64 + m * 16 + fr) * 4 + (g - 1)];
#pragma unroll
                for (int bj = 0; bj < 2; ++bj)
#pragma unroll
                    for (int n = 0; n < 2; ++n) acc[ai][bj][m][n] = acc[ai][bj][m][n] * q; }
    }
    const void* base; void* out;
    const float* gate; const float* csn; bf16_t* xs; float* slots;
    __device__ __forceinline__ void fused(const f32x4 (&acc)[2][2][4][2], const Unit& u, int wr, int wc, int fr, int fq, LAS unsigned char* lds, int wid, int lane) const {
        constexpr int PITCH = 1040;
        const int hl = lane & 31, hw = lane >> 5;
        const int colg = u.pn * BM + 8 * hl;
        const f32x4 gv0 = *(const f32x4*)(gate + colg), gv1 = *(const f32x4*)(gate + colg + 4);
        const f32x4 cv0 = csn ? *(const f32x4*)(csn + colg) : (f32x4){0.f, 0.f, 0.f, 0.f}, cv1 = csn ? *(const f32x4*)(csn + colg + 4) : (f32x4){0.f, 0.f, 0.f, 0.f};
        h16x8 bh[BH ? 16 : 1]; f32x4 bf[BH ? 1 : 16];
        if constexpr (BH) {
#pragma unroll
            for (int q = 0; q < 16; ++q) bh[q] = *(const h16x8*)((const _Float16*)base + (size_t)(u.pm * BM + (q >> 3) * HALF + wid * 16 + 2 * (q & 7) + hw) * D + colg);
        }
#pragma unroll
        for (int ai = 0; ai < 2; ++ai) {
            if constexpr (!BH) {
#pragma unroll
                for (int q = 0; q < 8; ++q) { const float* bp_ = (const float*)base + (size_t)(u.pm * BM + ai * HALF + wid * 16 + 2 * q + hw) * D + colg; bf[2 * q] = *(const f32x4*)bp_; bf[2 * q + 1] = *(const f32x4*)(bp_ + 4); }
            }
#pragma unroll
            for (int m = 0; m < 4; ++m)
#pragma unroll
                for (int bj = 0; bj < 2; ++bj)
#pragma unroll
                    for (int n = 0; n < 2; ++n) *(LAS f32x4*)(lds + (wr * 64 + m * 16 + fr) * PITCH + (bj * HALF + wc * 32 + n * 16 + fq * 4) * 4) = acc[ai][bj][m][n];
            __syncthreads();
#pragma unroll
            for (int st = 0; st < 8; ++st) {
                const int lr = wid * 16 + 2 * st + hw, row = u.pm * BM + ai * HALF + lr; const size_t off = (size_t)row * D + colg;
                f32x4 a0 = *(const LAS f32x4*)(lds + lr * PITCH + hl * 32), a1 = *(const LAS f32x4*)(lds + lr * PITCH + hl * 32 + 16);
                if constexpr (KS) { const float q_ = ((const LAS float*)(lds + RQ_OFF))[(ai * HALF + lr) * 4 + 3]; a0 = a0 * q_; a1 = a1 * q_; }
                f32x4 b0, b1;
                if constexpr (BH) { const f32x8 bb = __builtin_convertvector(bh[ai * 8 + st], f32x8); b0 = (f32x4){bb[0], bb[1], bb[2], bb[3]}; b1 = (f32x4){bb[4], bb[5], bb[6], bb[7]}; }
                else { b0 = bf[2 * st]; b1 = bf[2 * st + 1]; }
                const f32x4 x0 = b0 + gv0 * a0, x1 = b1 + gv1 * a1;
                if constexpr (OH) { const h16x4 l_ = __builtin_convertvector(x0, h16x4), h_ = __builtin_convertvector(x1, h16x4);
                    *(h16x8*)((_Float16*)out + off) = (h16x8){l_[0], l_[1], l_[2], l_[3], h_[0], h_[1], h_[2], h_[3]}; }
                else { *(f32x4*)((float*)out + off) = x0; *(f32x4*)((float*)out + off + 4) = x1; }
                if (csn) { const f32x4 y0 = x0 * cv0, y1 = x1 * cv1; u32x4 w; w.x = cvt_pk_bf16(y0[0], y0[1]); w.y = cvt_pk_bf16(y0[2], y0[3]); w.z = cvt_pk_bf16(y1[0], y1[1]); w.w = cvt_pk_bf16(y1[2], y1[3]); *(u32x4*)(xs + off) = w; }
                float ss = ((x0[0] * x0[0] + x0[1] * x0[1]) + (x0[2] * x0[2] + x0[3] * x0[3])) + ((x1[0] * x1[0] + x1[1] * x1[1]) + (x1[2] * x1[2] + x1[3] * x1[3]));
#pragma unroll
                for (int o = 1; o < 32; o <<= 1) ss += __shfl_xor(ss, o);
                if (hl < 4) slots[(size_t)row * 16 + u.pn * 4 + hl] = (hl == 0) ? ss : 0.f;
            }
            __syncthreads();
        }
    }
};

struct Args { const float* in[27]; float* out; unsigned char* ws; int ph_lo, ph_hi; };
struct Frame {
    LAS unsigned char* lds; int tid, lane, wave, G, bid, vcu;
    const float* const* in; float* out; unsigned char* ws;
};
#define WSF(off) ((float*)(F.ws + (off)))
#define WSB(off) ((bf16_t*)(F.ws + (off)))


constexpr size_t WS_CSS = WS_CTL + 65536;
__device__ __forceinline__ float ctx_rstd(const Frame& F, int crow_) {
    const float* p = WSF(WS_CSS) + crow_ * 32; float t = 0.f;
#pragma unroll
    for (int j = 0; j < 8; ++j) { const f32x4 v = *(const f32x4*)(p + 4 * j); t += (v[0] + v[1]) + (v[2] + v[3]); }
    return rsqrtf(t * (1.0f / 1024.0f) + EPS);
}
struct CtxP { const bf16_t* A; int lda, a_grp_step; const bf16_t* Wt; int ldb, K, ncb; const float* bias; bf16_t* O; int ldo; float* DT; bf16_t* HALO;
              const float* base; float* xout; const float* gate; const float* csn; bf16_t* xs; int dbg = 0; const float* ssq = nullptr; };
template <int MODE, int NKS> __device__ __forceinline__ void ctx_gemm(Frame& F, const CtxP p, int heavy) {
    const int r = F.lane & 31, hf = F.lane >> 5, w = F.wave;
    if (F.bid < heavy) return;
    const int t0_ = F.bid - heavy, tstep_ = F.G - heavy;
    constexpr int nks = NKS; const int kslice = NKS * 16;
    LAS float* red = (LAS float*)F.lds;
    LAS float* ssq = (LAS float*)(F.lds + 65536);
    if (p.dbg) STAMPX(80);
    for (int t = t0_; t < p.ncb * 8; t += tstep_) {
        const int cb = t >> 3, rb = t & 7;
        const bf16_t* ap = p.A + (size_t)(NLAT + rb * 32 + r) * p.lda + (cb >> 3) * p.a_grp_step + w * kslice + hf * 8;
        int wrow = cb * 32 + r; if (MODE == 3) wrow = 256 * (cb >> 2) + 32 * (cb & 3) + r;
        const bf16_t* bp = p.Wt + (size_t)wrow * p.ldb + w * kslice + hf * 8;
        f32x16 acc, acc2;
#pragma unroll
        for (int i = 0; i < 16; ++i) { acc[i] = 0.f; acc2[i] = 0.f; }
        const int e_ln = F.tid & 63, e_g4 = (F.tid >> 6) & 3, e_rr = e_ln & 31, e_hh = e_ln >> 5;
        const int e_crow = rb * 32 + e_rr, e_col = cb * 32 + 8 * e_g4 + 4 * e_hh;
        f32x4 pe0 = {0.f, 0.f, 0.f, 0.f}, pe1 = pe0, pe2 = pe0; float pe_rs = 0.f;
        if (F.tid < 256) {
            if (MODE == 4) { pe0 = *(const f32x4*)(p.base + (size_t)e_crow * D + e_col); pe1 = *(const f32x4*)(p.gate + D + e_col); if (p.csn) pe2 = *(const f32x4*)(p.csn + D + e_col); }
            else { pe_rs = ctx_rstd(F, e_crow);
                if (MODE == 3) { const int brow = 256 * (cb >> 2) + 32 * (cb & 3) + 8 * e_g4 + 4 * e_hh; pe0 = *(const f32x4*)(p.bias + brow); pe1 = *(const f32x4*)(p.bias + brow + 128); }
                else pe0 = *(const f32x4*)(p.bias + e_col); }
        }
        constexpr int KB = (NKS > 16) ? (NKS + 1) / 2 : 8;
#pragma unroll
        for (int k0 = 0; k0 < nks; k0 += KB) {
            bf16x8 a[KB], b[KB], b2[KB];
#pragma unroll
            for (int j = 0; j < KB; ++j) if (k0 + j < nks) { a[j] = *(const bf16x8*)(ap + (k0 + j) * 16); b[j] = *(const bf16x8*)(bp + (k0 + j) * 16); if (MODE == 3) b2[j] = *(const bf16x8*)(bp + (size_t)128 * p.ldb + (k0 + j) * 16); }
#pragma unroll
            for (int j = 0; j < KB; ++j) if (k0 + j < nks) { acc = MFMA32(b[j], a[j], acc); if (MODE == 3) acc2 = MFMA32(b2[j], a[j], acc2); }
            if (nks > KB) asm volatile("" ::: "memory");
        }
        if (p.dbg) STAMPX(81);
        if (MODE == 4 && p.ssq) { const float* sp_ = p.ssq + (size_t)(NLAT + rb * 32 + r) * 32 + (w >> 1) * 8; const f32x4 s0_ = *(const f32x4*)sp_, s1_ = *(const f32x4*)(sp_ + 4);
            const float rg = rsqrtf((((s0_[0] + s0_[1]) + (s0_[2] + s0_[3])) + ((s1_[0] + s1_[1]) + (s1_[2] + s1_[3]))) * (1.0f / 512.0f) + EPS);
#pragma unroll
            for (int i = 0; i < 16; ++i) acc[i] *= rg; }
        __syncthreads();
#pragma unroll
        for (int i = 0; i < 16; ++i) { red[(w * 16 + i) * 64 + F.lane] = acc[i]; if (MODE == 3) red[8192 + (w * 16 + i) * 64 + F.lane] = acc2[i]; }
        __syncthreads();
        if (p.dbg) STAMPX(82);
        float ss = 0.f;
        if (F.tid < 256) {
            const int ln = F.tid & 63, g4 = F.tid >> 6, rr = ln & 31, hh = ln >> 5;
            float v[4], v2[4];
#pragma unroll
            for (int j = 0; j < 4; ++j) { float sa = 0.f, sb = 0.f;
#pragma unroll
                for (int ww = 0; ww < 8; ++ww) { sa += red[(ww * 16 + 4 * g4 + j) * 64 + ln]; if (MODE == 3) sb += red[8192 + (ww * 16 + 4 * g4 + j) * 64 + ln]; }
                v[j] = sa; v2[j] = sb; }
            const int crow_ = rb * 32 + rr, row = NLAT + crow_, col = cb * 32 + 8 * g4 + 4 * hh;
            if (MODE == 4) {
                const f32x4 b_ = pe0, gt = pe1;
                f32x4 x; x[0] = b_[0] + gt[0] * v[0]; x[1] = b_[1] + gt[1] * v[1]; x[2] = b_[2] + gt[2] * v[2]; x[3] = b_[3] + gt[3] * v[3];
                *(f32x4*)(p.xout + (size_t)crow_ * D + col) = x;
                ss = (x[0] * x[0] + x[1] * x[1]) + (x[2] * x[2] + x[3] * x[3]);
                if (p.csn) { const f32x4 c_ = pe2; u32x2 o; o.x = cvt_pk_bf16(x[0] * c_[0], x[1] * c_[1]); o.y = cvt_pk_bf16(x[2] * c_[2], x[3] * c_[3]); *(u32x2*)(p.xs + (size_t)row * D + col) = o; }
            } else {
                const float rs = pe_rs;
                if (MODE == 3) {
                    const f32x4 bg = pe0, bu = pe1;
                    u32x2 o; o.x = cvt_pk_bf16(siluf_(v[0] * rs + bg[0]) * (v2[0] * rs + bu[0]), siluf_(v[1] * rs + bg[1]) * (v2[1] * rs + bu[1]));
                    o.y = cvt_pk_bf16(siluf_(v[2] * rs + bg[2]) * (v2[2] * rs + bu[2]), siluf_(v[3] * rs + bg[3]) * (v2[3] * rs + bu[3]));
                    *(u32x2*)(p.O + (size_t)row * p.ldo + col) = o;
                } else {
                    const f32x4 bv = pe0;
                    float y[4];
#pragma unroll
                    for (int j = 0; j < 4; ++j) y[j] = v[j] * rs + bv[j];
                    if (MODE == 0 && (col < 1024 || col >= 4096)) {
#pragma unroll
                        for (int j = 0; j < 4; ++j) y[j] = siluf_(y[j]); }
                    if (MODE == 1 && col >= 5120) { if (col < 5184) *(f32x4*)(p.DT + (size_t)row * 64 + (col - 5120)) = (f32x4){y[0], y[1], y[2], y[3]}; }
                    else {
                        u32x2 o; o.x = cvt_pk_bf16(y[0], y[1]); o.y = cvt_pk_bf16(y[2], y[3]);
                        *(u32x2*)(p.O + (size_t)row * p.ldo + col) = o;
                        if (MODE == 1 && col >= 2048) { const int rm = row & 63, tk = row >> 6;
                            if (rm >= 62 && tk + 1 < 260) *(u32x2*)(p.HALO + ((size_t)(tk + 1) * 4 + (rm - 62)) * SSM_CD + (col - 2048)) = o;
                            if (rm < 2 && tk >= 1) *(u32x2*)(p.HALO + ((size_t)(tk - 1) * 4 + 2 + rm) * SSM_CD + (col - 2048)) = o; }
                    }
                }
            }
        }
        if (p.dbg) STAMPX(83);
        if (MODE == 4) {
            ss += __shfl_xor(ss, 32);
            if (F.tid < 256 && (F.tid & 63) < 32) ssq[(F.tid >> 6) * 32 + (F.tid & 31)] = ss;
            __syncthreads();
            if (F.tid < 32) WSF(WS_CSS)[(rb * 32 + F.tid) * 32 + cb] = (ssq[F.tid] + ssq[32 + F.tid]) + (ssq[64 + F.tid] + ssq[96 + F.tid]);
        }
    }
    if (p.dbg) STAMPX(84);
    __syncthreads();
    if (p.dbg) STAMPX(85);
}

__device__ __forceinline__ void transpose_item(const float* W, int K, int Nsrc, bf16_t* WT, int dst_row0, int src_col0, int kb, LAS float* scr, int lane, const float* ksc) {
    const int k0 = 64 * kb;
    f32x4 v[8];
    if (src_col0 >= 0) {
        const float* wp = W + (size_t)(k0 + (lane >> 3)) * Nsrc + src_col0 + 4 * (lane & 7);
#pragma unroll
        for (int i = 0; i < 8; ++i) v[i] = *(const f32x4*)(wp + (size_t)(8 * i) * Nsrc);
        if (ksc) {
#pragma unroll
            for (int i = 0; i < 8; ++i) v[i] = v[i] * ksc[k0 + (lane >> 3) + 8 * i]; }
    } else {
#pragma unroll
        for (int i = 0; i < 8; ++i) v[i] = (f32x4){0.f, 0.f, 0.f, 0.f};
    }
#pragma unroll
    for (int i = 0; i < 8; ++i) { LAS float* d = scr + ((lane >> 3) + 8 * i) * 33 + 4 * (lane & 7); d[0] = v[i][0]; d[1] = v[i][1]; d[2] = v[i][2]; d[3] = v[i][3]; }
    asm volatile("s_waitcnt lgkmcnt(0)" ::: "memory");
    const int c = lane & 7;
#pragma unroll
    for (int j = 0; j < 4; ++j) { const int n = (lane >> 3) + 8 * j; const LAS float* s = scr + (8 * c) * 33 + n;
        u32x4 o; o.x = pk2(s[0 * 33], s[1 * 33]); o.y = pk2(s[2 * 33], s[3 * 33]); o.z = pk2(s[4 * 33], s[5 * 33]); o.w = pk2(s[6 * 33], s[7 * 33]);
        *(u32x4*)(WT + (size_t)(dst_row0 + n) * K + k0 + 8 * c) = o; }
    asm volatile("s_waitcnt lgkmcnt(0)" ::: "memory");
}
struct ConvJob { int in_idx; size_t src_off; int K, Nsrc, Ndst, mode; size_t dst; };
__device__ __forceinline__ void phase_p0a(Frame& F) {
    {
        LAS float* sv = (LAS float*)F.lds;
        LAS float* red = sv + 2048;
        for (int i = F.tid; i < 2048; i += NTHR) { const float x = (i < 1024) ? F.in[1][i] : F.in[3][i - 1024]; sv[i] = siluf_(x); }
        __syncthreads();
        for (int task = F.bid; task < 256; task += F.G) {
            const int layer = task >> 6, cg_ = task & 63, krow = F.tid >> 5, c4 = F.tid & 31;
            f32x4 aL = {0.f, 0.f, 0.f, 0.f}, aC = {0.f, 0.f, 0.f, 0.f};
            if (c4 < 24) {
                const float* wp = F.in[4] + (size_t)layer * 1024 * 6144 + cg_ * 96 + c4 * 4;
#pragma unroll 8
                for (int j = 0; j < 64; ++j) { const int k = krow + 16 * j; const f32x4 w = *(const f32x4*)(wp + (size_t)k * 6144); aL += w * sv[k]; aC += w * sv[1024 + k]; }
                LAS float* r = red + (krow * 24 + c4) * 8;
                r[0] = aL[0]; r[1] = aL[1]; r[2] = aL[2]; r[3] = aL[3]; r[4] = aC[0]; r[5] = aC[1]; r[6] = aC[2]; r[7] = aC[3];
            }
            __syncthreads();
            if (F.tid < 192) { const int var = F.tid / 96, cc = F.tid % 96; float s = 0.f;
#pragma unroll
                for (int kr = 0; kr < 16; ++kr) s += red[(kr * 24 + (cc >> 2)) * 8 + var * 4 + (cc & 3)];
                const int n = cg_ * 96 + cc; WSF(WS_MODS)[((size_t)layer * 2 + var) * 6144 + n] = s + F.in[5][layer * 6144 + n]; }
            __syncthreads();
        }
    }
    {
        const int gt = F.bid * NTHR + F.tid, GT = F.G * NTHR;
        for (int i = gt; i < 2048; i += GT) {
            const int dir = i >> 10, d = i & 1023; float v[5], mx = -1e30f;
#pragma unroll
            for (int j = 0; j < 5; ++j) { v[j] = F.in[11][(dir * 5 + j) * 1024 + d]; mx = fmaxf(mx, v[j]); }
            float s = 0.f;
#pragma unroll
            for (int j = 0; j < 5; ++j) { v[j] = __expf(v[j] - mx); s += v[j]; }
            WSF(WS_LB)[i] = v[0] / s;
        }
        for (int i = gt; i < 4096; i += GT) {
            const int pos = i >> 4, f = i & 15;
            const float inv = powf(10000.0f, -(float)(2 * f) / 32.0f); const float ang = (float)pos * inv;
            const double rev = (double)ang * 0.15915494309189533577; const float fr_ = (float)(rev - floor(rev));
            WSF(WS_ROPE)[i] = __builtin_amdgcn_cosf(fr_); WSF(WS_ROPE)[4096 + i] = __builtin_amdgcn_sinf(fr_);
        }
    }
    {
        LAS float* scr = (LAS float*)(F.lds + F.wave * 8704);
        const int gw = F.bid * NWAVES + F.wave, NGW = F.G * NWAVES;
        constexpr int NJ = 19;
        const ConvJob jobs[NJ] = {
            {10, 0, 1024, HG_N, HG_N, 0, WS_W_HGIN}, {13, 0, 1024, 1024, 1024, 0, WS_W_HGOUT},
            {14, 0, 1024, SSM_N, SSM_NP, 0, WS_W_SSMIN}, {21, 0, 2048, 1024, 1024, 0, WS_W_SSMOUT},
            {22, 0, 256, 256, 256, 0, WS_W_POOL}, {22, 65536, 256, 256, 256, 0, WS_W_POOL + 131072}, {22, 131072, 256, 256, 256, 0, WS_W_POOL + 262144}, {22, 196608, 256, 256, 256, 0, WS_W_POOL + 393216},
            {24, 0, 1024, ATT_N, ATT_N, 0, WS_W_QKV}, {26, 0, 1024, 1024, 1024, 0, WS_W_ATTOUT},
            {7, 0, 1024, FH2, FH2, 1, WS_W_FFNIN}, {7, (size_t)1024 * FH2, 1024, FH2, FH2, 1, WS_W_FFNIN + (size_t)FH2 * 1024 * 2},
            {7, (size_t)2 * 1024 * FH2, 1024, FH2, FH2, 1, WS_W_FFNIN + (size_t)2 * FH2 * 1024 * 2}, {7, (size_t)3 * 1024 * FH2, 1024, FH2, FH2, 1, WS_W_FFNIN + (size_t)3 * FH2 * 1024 * 2},
            {8, 0, FH, 1024, 1024, 0, WS_W_FFNOUT}, {8, (size_t)FH * 1024, FH, 1024, 1024, 0, WS_W_FFNOUT + (size_t)1024 * FH * 2},
            {8, (size_t)2 * FH * 1024, FH, 1024, 1024, 0, WS_W_FFNOUT + (size_t)2 * 1024 * FH * 2}, {8, (size_t)3 * FH * 1024, FH, 1024, 1024, 0, WS_W_FFNOUT + (size_t)3 * 1024 * FH * 2},
            {0, 0, 0, 0, 0, 0, 0}};
        int total = 0;
#pragma unroll
        for (int j = 0; j < NJ - 1; ++j) total += (jobs[j].Ndst / 32) * (jobs[j].K / 64);
        for (int it = gw; it < total; it += NGW) {
            int r = it, j = 0;
#pragma unroll
            for (int jj = 0; jj < NJ - 1; ++jj) { const int n = (jobs[jj].Ndst / 32) * (jobs[jj].K / 64); if (j == jj && r >= n) { r -= n; j = jj + 1; } }
            int in_idx = 0, K = 0, Nsrc = 0, Ndst = 0, mode = 0; size_t so = 0, dst = 0;
#pragma unroll
            for (int jj = 0; jj < NJ - 1; ++jj) if (j == jj) { in_idx = jobs[jj].in_idx; so = jobs[jj].src_off; K = jobs[jj].K; Nsrc = jobs[jj].Nsrc; Ndst = jobs[jj].Ndst; mode = jobs[jj].mode; dst = jobs[jj].dst; }
            const int nblk = Ndst / 32, kb = r / nblk, nb = r % nblk; const int drow = nb * 32;
            int scol;
            if (mode == 1) { const int pn = drow >> 8, w = drow & 255; scol = (w < 128) ? (pn * 128 + w) : (FH + pn * 128 + (w - 128)); }
            else scol = (drow < Nsrc) ? drow : -1;
            transpose_item(F.in[in_idx] + so, K, Nsrc, WSB(dst), drow, scol, kb, scr, F.lane, (in_idx == 21) ? F.in[20] : (const float*)nullptr);
        }
    }
}

__device__ __forceinline__ void phase_p0b(Frame& F) {
    const int gt = F.bid * NTHR + F.tid, GT = F.G * NTHR;
    const float* mods = WSF(WS_MODS);
    for (int i = gt; i < 4 * 2 * 2 * 1024; i += GT) {
        const int k = i & 1023, var = (i >> 10) & 1, nrm = (i >> 11) & 1, layer = i >> 12;
        const float sc = mods[((size_t)layer * 2 + var) * 6144 + (nrm ? 4 : 1) * 1024 + k];
        WSF(WS_CS)[i] = F.in[6][(layer * 2 + nrm) * 1024 + k] * (1.0f + sc);
        float g = mods[((size_t)layer * 2 + var) * 6144 + (nrm ? 5 : 2) * 1024 + k];
        if (layer == 2 && nrm == 0) g *= F.in[23][k];
        WSF(WS_GATE)[i] = g;
    }
    const int gw = F.bid * NWAVES + F.wave, NGW = F.G * NWAVES;
    {
        constexpr int R0 = HG_N, R1 = SSM_NP, R3 = ATT_N, RF = 4 * FH2, RT = R0 + R1 + R3 + RF;
        for (int it = gw * 4; it < RT; it += NGW * 4) {
            int r = it, layer, which, n; const bf16_t* wt;
            if (r < R0) { layer = 0; which = 0; n = r; wt = WSB(WS_W_HGIN) + (size_t)n * D; }
            else if ((r -= R0) < R1) { layer = 1; which = 0; n = r; wt = WSB(WS_W_SSMIN) + (size_t)n * D; }
            else if ((r -= R1) < R3) { layer = 3; which = 0; n = r; wt = WSB(WS_W_QKV) + (size_t)n * D; }
            else { r -= R3; layer = r / FH2; which = 1; n = r % FH2; wt = WSB(WS_W_FFNIN) + ((size_t)layer * FH2 + n) * D; }
            u32x4 w[4][2];
#pragma unroll
            for (int q = 0; q < 4; ++q)
#pragma unroll
                for (int h = 0; h < 2; ++h) w[q][h] = *(const u32x4*)(wt + (size_t)q * D + h * 512 + F.lane * 8);
            float aL[4] = {0.f, 0.f, 0.f, 0.f}, aC[4] = {0.f, 0.f, 0.f, 0.f};
#pragma unroll
            for (int h = 0; h < 2; ++h) {
                const int k0 = h * 512 + F.lane * 8;
                const float* sL = mods + ((size_t)layer * 2 + 0) * 6144 + (which ? 3 : 0) * 1024 + k0; const float* sC = sL + 6144;
                const f32x4 l0 = *(const f32x4*)sL, l1 = *(const f32x4*)(sL + 4), c0 = *(const f32x4*)sC, c1 = *(const f32x4*)(sC + 4);
#pragma unroll
                for (int q = 0; q < 4; ++q) { const u32x4 ww = w[q][h];
                    const float w0 = lo_bf(ww.x), w1 = hi_bf(ww.x), w2 = lo_bf(ww.y), w3 = hi_bf(ww.y), w4 = lo_bf(ww.z), w5 = hi_bf(ww.z), w6 = lo_bf(ww.w), w7 = hi_bf(ww.w);
                    aL[q] += w0 * l0[0] + w1 * l0[1] + w2 * l0[2] + w3 * l0[3] + w4 * l1[0] + w5 * l1[1] + w6 * l1[2] + w7 * l1[3];
                    aC[q] += w0 * c0[0] + w1 * c0[1] + w2 * c0[2] + w3 * c0[3] + w4 * c1[0] + w5 * c1[1] + w6 * c1[2] + w7 * c1[3]; }
            }
#pragma unroll
            for (int q = 0; q < 4; ++q) { aL[q] = wave_sum(aL[q]); aC[q] = wave_sum(aC[q]); }
            if (F.lane == 0) { float* bp = WSF(which ? WS_BIAS3 : WS_BIAS1) + (size_t)layer * 2 * FH2 + n;
#pragma unroll
                for (int q = 0; q < 4; ++q) { bp[q] = aL[q]; bp[FH2 + q] = aC[q]; } }
        }
    }
    for (int row2 = gw * 2; row2 < MALL; row2 += NGW * 2) {
        f32x4 x[2][4];
#pragma unroll
        for (int q = 0; q < 2; ++q) { const int row = row2 + q; const float* xr = (row >= NLAT) ? F.in[2] + (size_t)(row - NLAT) * D : F.in[0] + (size_t)row * D;
#pragma unroll
            for (int j = 0; j < 2; ++j) { x[q][2 * j] = *(const f32x4*)(xr + j * 512 + F.lane * 8); x[q][2 * j + 1] = *(const f32x4*)(xr + j * 512 + F.lane * 8 + 4); } }
#pragma unroll
        for (int q = 0; q < 2; ++q) {
            const int row = row2 + q, var = row >= NLAT; float ss = 0.f;
#pragma unroll
            for (int j = 0; j < 2; ++j) {
                const int k = j * 512 + F.lane * 8; u32x4 w;
#pragma unroll
                for (int e = 0; e < 2; ++e) { const f32x4 xv = x[q][2 * j + e];
                    const f32x4 nw = *(const f32x4*)(F.in[6] + k + 4 * e); const f32x4 sc = *(const f32x4*)(mods + (size_t)var * 6144 + 1024 + k + 4 * e);
                    ss += (xv[0] * xv[0] + xv[1] * xv[1]) + (xv[2] * xv[2] + xv[3] * xv[3]);
                    const f32x4 y = xv * (nw * (sc + 1.0f));
                    if (e == 0) { w.x = pk2(y[0], y[1]); w.y = pk2(y[2], y[3]); } else { w.z = pk2(y[0], y[1]); w.w = pk2(y[2], y[3]); } }
                *(u32x4*)(WSB(WS_XSA) + (size_t)row * D + k) = w;
            }
            ss = wave_sum(ss);
            if (var) { if (F.lane < 32) WSF(WS_CSS)[(row - NLAT) * 32 + F.lane] = (F.lane == 0) ? ss : 0.f; }
            else if (F.lane < 16) WSF(WS_SLOTS)[(size_t)row * 16 + F.lane] = (F.lane == 0) ? ss : 0.f;
        }
    }
}

__device__ __forceinline__ int tc_row0(int tc) { return tc < 256 ? tc * 64 : NLAT + (tc - 256) * 64; }
__device__ __forceinline__ int tc_pf(int tc) { return tc < 256 ? 4 + tc : tc - 256; }
__device__ __forceinline__ int tc_pb(int tc) { return tc < 256 ? 4 + 255 - tc : 3 - (tc - 256); }
__device__ __forceinline__ bf16_t* hg_state(const Frame& F, int dir, int h, int p) {
    return (h < 5) ? (bf16_t*)(F.ws + WS_ST) + ((size_t)(dir * 5 + h) * 260 + p) * 16384 : (bf16_t*)F.out + ((size_t)(dir * 3 + (h - 5)) * 260 + p) * 16384;
}
constexpr int HG_VT = 0, HG_QR = 18432, HG_KR = 53248, HG_QI = 88064, HG_ATT = 122880, HG_SEG = 140288, HG_RED = 144384;
constexpr int HG_PITCH = 272, HG_VPITCH = 144;
static_assert(HG_RED + 1024 <= MISC_OFF, "HGRN LDS map");
struct HgPrep { float k0[16], k1[16], c0[16], c1[16], off0, off1, tot0, tot1, ref0, ref1; };
__device__ __forceinline__ void hg_prep(const Frame& F, const bf16_t* P, int row0, int h, int dir, int seg, int cp, HgPrep& R) {
    const float lb0 = WSF(WS_LB)[dir * 1024 + h * 128 + 2 * cp], lb1 = WSF(WS_LB)[dir * 1024 + h * 128 + 2 * cp + 1];
    unsigned zw[16];
#pragma unroll
    for (int i = 0; i < 16; ++i) { const int si = seg * 16 + i, tok = dir ? 63 - si : si; zw[i] = *(const unsigned*)(P + (size_t)(row0 + tok) * PLD + 1024 + dir * 1024 + h * 128 + 2 * cp); }
    float a0 = 0.f, a1 = 0.f;
#pragma unroll
    for (int i = 0; i < 16; ++i) {
        const float s0 = sigmoidf_(lo_bf(zw[i])), s1 = sigmoidf_(hi_bf(zw[i]));
        a0 += __logf(lb0 + (1.f - lb0) * s0); a1 += __logf(lb1 + (1.f - lb1) * s1);
        R.c0[i] = a0; R.c1[i] = a1; R.k0[i] = (1.f - lb0) * (1.f - s0); R.k1[i] = (1.f - lb1) * (1.f - s1);
    }
    LAS float* sg = (LAS float*)(F.lds + HG_SEG) + (dir * 4) * 128 + 2 * cp;
    sg[seg * 128] = a0; sg[seg * 128 + 1] = a1;
    __syncthreads();
    float o0 = 0.f, o1 = 0.f, t0 = 0.f, t1 = 0.f;
#pragma unroll
    for (int s_ = 0; s_ < 4; ++s_) { const float x0 = sg[s_ * 128], x1 = sg[s_ * 128 + 1]; if (s_ < seg) { o0 += x0; o1 += x1; } t0 += x0; t1 += x1; }
    R.off0 = o0; R.off1 = o1; R.tot0 = t0; R.tot1 = t1; R.ref0 = sg[0] + sg[128]; R.ref1 = sg[1] + sg[129];
}
__device__ __forceinline__ void hg_prep_z(const Frame& F, const unsigned (&zw)[16], int h, int dir, int seg, int cp, HgPrep& R) {
    const float lb0 = WSF(WS_LB)[dir * 1024 + h * 128 + 2 * cp], lb1 = WSF(WS_LB)[dir * 1024 + h * 128 + 2 * cp + 1];
    float p0 = 1.f, p1 = 1.f;
#pragma unroll
    for (int i = 0; i < 16; ++i) {
        const float s0 = sigmoidf_(lo_bf(zw[i])), s1 = sigmoidf_(hi_bf(zw[i]));
        p0 *= lb0 + (1.f - lb0) * s0; p1 *= lb1 + (1.f - lb1) * s1;
        R.c0[i] = p0; R.c1[i] = p1; R.k0[i] = (1.f - lb0) * (1.f - s0); R.k1[i] = (1.f - lb1) * (1.f - s1);
    }
    const float a0 = __logf(p0), a1 = __logf(p1);
    LAS float* sg = (LAS float*)(F.lds + HG_SEG) + (dir * 4) * 128 + 2 * cp;
    sg[seg * 128] = a0; sg[seg * 128 + 1] = a1;
    __syncthreads();
    float o0 = 0.f, o1 = 0.f, t0 = 0.f, t1 = 0.f;
#pragma unroll
    for (int s_ = 0; s_ < 4; ++s_) { const float x0 = sg[s_ * 128], x1 = sg[s_ * 128 + 1]; if (s_ < seg) { o0 += x0; o1 += x1; } t0 += x0; t1 += x1; }
    R.off0 = o0; R.off1 = o1; R.tot0 = t0; R.tot1 = t1; R.ref0 = sg[0] + sg[128]; R.ref1 = sg[1] + sg[129];
}
__device__ __forceinline__ void hg_stage_vt_v(const Frame& F, const unsigned (&vw)[16], int seg, int cp) {
    u32x4 a, b, c, d;
    a.x = (vw[0] & 0xffffu) | (vw[1] << 16); a.y = (vw[2] & 0xffffu) | (vw[3] << 16); a.z = (vw[4] & 0xffffu) | (vw[5] << 16); a.w = (vw[6] & 0xffffu) | (vw[7] << 16);
    b.x = (vw[8] & 0xffffu) | (vw[9] << 16); b.y = (vw[10] & 0xffffu) | (vw[11] << 16); b.z = (vw[12] & 0xffffu) | (vw[13] << 16); b.w = (vw[14] & 0xffffu) | (vw[15] << 16);
    c.x = (vw[0] >> 16) | (vw[1] & 0xffff0000u); c.y = (vw[2] >> 16) | (vw[3] & 0xffff0000u); c.z = (vw[4] >> 16) | (vw[5] & 0xffff0000u); c.w = (vw[6] >> 16) | (vw[7] & 0xffff0000u);
    d.x = (vw[8] >> 16) | (vw[9] & 0xffff0000u); d.y = (vw[10] >> 16) | (vw[11] & 0xffff0000u); d.z = (vw[12] >> 16) | (vw[13] & 0xffff0000u); d.w = (vw[14] >> 16) | (vw[15] & 0xffff0000u);
    LAS unsigned char* r0 = F.lds + HG_VT + (2 * cp) * HG_VPITCH + seg * 32;
    *(LAS u32x4*)r0 = a; *(LAS u32x4*)(r0 + 16) = b; *(LAS u32x4*)(r0 + HG_VPITCH) = c; *(LAS u32x4*)(r0 + HG_VPITCH + 16) = d;
}
__device__ __forceinline__ void hg_stage_vt(const Frame& F, const bf16_t* P, int row0, int h, int seg, int cp) {
    unsigned vw[16];
#pragma unroll
    for (int i = 0; i < 16; ++i) vw[i] = *(const unsigned*)(P + (size_t)(row0 + seg * 16 + i) * PLD + 3072 + h * 128 + 2 * cp);
    u32x4 a, b, c, d;
    a.x = (vw[0] & 0xffffu) | (vw[1] << 16); a.y = (vw[2] & 0xffffu) | (vw[3] << 16); a.z = (vw[4] & 0xffffu) | (vw[5] << 16); a.w = (vw[6] & 0xffffu) | (vw[7] << 16);
    b.x = (vw[8] & 0xffffu) | (vw[9] << 16); b.y = (vw[10] & 0xffffu) | (vw[11] << 16); b.z = (vw[12] & 0xffffu) | (vw[13] << 16); b.w = (vw[14] & 0xffffu) | (vw[15] << 16);
    c.x = (vw[0] >> 16) | (vw[1] & 0xffff0000u); c.y = (vw[2] >> 16) | (vw[3] & 0xffff0000u); c.z = (vw[4] >> 16) | (vw[5] & 0xffff0000u); c.w = (vw[6] >> 16) | (vw[7] & 0xffff0000u);
    d.x = (vw[8] >> 16) | (vw[9] & 0xffff0000u); d.y = (vw[10] >> 16) | (vw[11] & 0xffff0000u); d.z = (vw[12] >> 16) | (vw[13] & 0xffff0000u); d.w = (vw[14] >> 16) | (vw[15] & 0xffff0000u);
    LAS unsigned char* r0 = F.lds + HG_VT + (2 * cp) * HG_VPITCH + seg * 32;
    *(LAS u32x4*)r0 = a; *(LAS u32x4*)(r0 + 16) = b; *(LAS u32x4*)(r0 + HG_VPITCH) = c; *(LAS u32x4*)(r0 + HG_VPITCH + 16) = d;
}
__device__ __forceinline__ void phase_hg_a(Frame& F) {
    const bf16_t* P = WSB(WS_P);
    const int dir = F.wave >> 2, seg = F.wave & 3, cp = F.lane, r = F.lane & 31, hf = F.lane >> 5;
    constexpr int HG_KD = HG_QR;
    unsigned zw[16], vw[16];
#define HGA_LOAD(uu) do { const int tc_ = (uu) >> 3, h_ = (uu) & 7, row0_ = tc_row0(tc_); \
        _Pragma("unroll") for (int i = 0; i < 16; ++i) { const int si = seg * 16 + i, tok = dir ? 63 - si : si; zw[i] = *(const unsigned*)(P + (size_t)(row0_ + tok) * PLD + 1024 + dir * 1024 + h_ * 128 + 2 * cp); } \
        if (dir == 0) { _Pragma("unroll") for (int i = 0; i < 16; ++i) vw[i] = *(const unsigned*)(P + (size_t)(row0_ + seg * 16 + i) * PLD + 3072 + h_ * 128 + 2 * cp); } } while (0)
    if (F.bid < 260 * 8) HGA_LOAD(F.bid);
    for (int u = F.bid; u < 260 * 8; u += F.G) {
        const int tc = u >> 3, h = u & 7, p = dir ? tc_pb(tc) : tc_pf(tc);
        __syncthreads();
        HgPrep R; hg_prep_z(F, zw, h, dir, seg, cp, R);
        if (dir == 0) hg_stage_vt_v(F, vw, seg, cp);
        {
            float e0[16], e1[16];
            const float et0 = __expf(R.tot0 - R.off0), et1 = __expf(R.tot1 - R.off1);
#pragma unroll
            for (int i = 0; i < 16; ++i) { e0[i] = R.k0[i] * et0 * __builtin_amdgcn_rcpf(R.c0[i]); e1[i] = R.k1[i] * et1 * __builtin_amdgcn_rcpf(R.c1[i]); }
            u32x4 a, b, c, d;
            if (dir == 0) {
                a.x = pk2(e0[0], e0[1]); a.y = pk2(e0[2], e0[3]); a.z = pk2(e0[4], e0[5]); a.w = pk2(e0[6], e0[7]); b.x = pk2(e0[8], e0[9]); b.y = pk2(e0[10], e0[11]); b.z = pk2(e0[12], e0[13]); b.w = pk2(e0[14], e0[15]);
                c.x = pk2(e1[0], e1[1]); c.y = pk2(e1[2], e1[3]); c.z = pk2(e1[4], e1[5]); c.w = pk2(e1[6], e1[7]); d.x = pk2(e1[8], e1[9]); d.y = pk2(e1[10], e1[11]); d.z = pk2(e1[12], e1[13]); d.w = pk2(e1[14], e1[15]);
            } else {
                a.x = pk2(e0[15], e0[14]); a.y = pk2(e0[13], e0[12]); a.z = pk2(e0[11], e0[10]); a.w = pk2(e0[9], e0[8]); b.x = pk2(e0[7], e0[6]); b.y = pk2(e0[5], e0[4]); b.z = pk2(e0[3], e0[2]); b.w = pk2(e0[1], e0[0]);
                c.x = pk2(e1[15], e1[14]); c.y = pk2(e1[13], e1[12]); c.z = pk2(e1[11], e1[10]); c.w = pk2(e1[9], e1[8]); d.x = pk2(e1[7], e1[6]); d.y = pk2(e1[5], e1[4]); d.z = pk2(e1[3], e1[2]); d.w = pk2(e1[1], e1[0]);
            }
            const int tok_lo = dir ? 48 - 16 * seg : 16 * seg;
            LAS unsigned char* r0 = F.lds + HG_KD + (dir * 128 + 2 * cp) * HG_VPITCH + tok_lo * 2;
            *(LAS u32x4*)r0 = a; *(LAS u32x4*)(r0 + 16) = b; *(LAS u32x4*)(r0 + HG_VPITCH) = c; *(LAS u32x4*)(r0 + HG_VPITCH + 16) = d;
            if (seg == 0) { float* dp = WSF(WS_DT) + ((size_t)(dir * 8 + h) * 260 + p) * 128 + 2 * cp; dp[0] = __expf(R.tot0); dp[1] = __expf(R.tot1); }
        }
        __syncthreads();
        { const int un = u + F.G; if (un < 260 * 8) HGA_LOAD(un); }
        f32x16 acc[4];
#pragma unroll
        for (int j = 0; j < 4; ++j)
#pragma unroll
            for (int i = 0; i < 16; ++i) acc[j][i] = 0.f;
#pragma unroll
        for (int ks = 0; ks < 4; ++ks) {
            const bf16x8 a = *(const LAS bf16x8*)(F.lds + HG_KD + (dir * 128 + seg * 32 + r) * HG_VPITCH + (ks * 16 + hf * 8) * 2);
#pragma unroll
            for (int j = 0; j < 4; ++j) { const bf16x8 b = *(const LAS bf16x8*)(F.lds + HG_VT + (j * 32 + r) * HG_VPITCH + (ks * 16 + hf * 8) * 2); acc[j] = MFMA32(a, b, acc[j]); }
        }
        bf16_t* st = hg_state(F, dir, h, p);
#pragma unroll
        for (int j = 0; j < 4; ++j)
#pragma unroll
            for (int g = 0; g < 4; ++g) { u32x2 w; w.x = cvt_pk_bf16(acc[j][4 * g], acc[j][4 * g + 1]); w.y = cvt_pk_bf16(acc[j][4 * g + 2], acc[j][4 * g + 3]);
                *(u32x2*)(st + ((size_t)((j * 8 + seg * 2 + (g >> 1)) * 64 + (g & 1) * 32 + r)) * 8 + 4 * hf) = w; }
    }
#undef HGA_LOAD
}
__device__ __forceinline__ void phase_hg_b(Frame& F) {
    for (int idx = F.bid * NTHR + F.tid; idx < 2 * 8 * 8192; idx += F.G * NTHR) {
        const int e2 = idx & 8191, h = (idx >> 13) & 7, dir = idx >> 16;
        const int eo = e2 * 2, dk = ((eo >> 9) & 7) * 16 + ((eo >> 8) & 1) * 8 + (eo & 7);
        unsigned* sp = (unsigned*)(hg_state(F, dir, h, 0) + eo);
        const f32x2* dp = (const f32x2*)(WSF(WS_DT) + ((size_t)(dir * 8 + h) * 260) * 128 + dk);
        float s0 = 0.f, s1 = 0.f;
        for (int p = 0; p < 260; p += 20) {
            unsigned x[20]; f32x2 d[20];
#pragma unroll
            for (int j = 0; j < 20; ++j) { x[j] = sp[(size_t)(p + j) * 8192]; d[j] = dp[(size_t)(p + j) * 64]; }
#pragma unroll
            for (int j = 0; j < 20; ++j) { sp[(size_t)(p + j) * 8192] = cvt_pk_bf16(s0, s1); s0 = d[j].x * s0 + lo_bf(x[j]); s1 = d[j].y * s1 + hi_bf(x[j]); }
        }
    }
}
__device__ __forceinline__ void phase_hg_c(Frame& F) {
    const bf16_t* P = WSB(WS_P); bf16_t* O = WSB(WS_XSA);
    const int dir = F.wave >> 2, seg = F.wave & 3, cp = F.lane, r = F.lane & 31, hf = F.lane >> 5;
    unsigned zw[16], qw_[16], vw[16];
#define HGC_LOAD(uu) do { const int tc_ = (uu) >> 3, h_ = (uu) & 7, row0_ = tc_row0(tc_); \
        _Pragma("unroll") for (int i = 0; i < 16; ++i) { const int si = seg * 16 + i, tok = dir ? 63 - si : si; const bf16_t* pr_ = P + (size_t)(row0_ + tok) * PLD + h_ * 128 + 2 * cp; \
            zw[i] = *(const unsigned*)(pr_ + 1024 + dir * 1024); qw_[i] = *(const unsigned*)pr_; } \
        if (dir == 0) { _Pragma("unroll") for (int i = 0; i < 16; ++i) vw[i] = *(const unsigned*)(P + (size_t)(row0_ + seg * 16 + i) * PLD + 3072 + h_ * 128 + 2 * cp); } } while (0)
    if (F.bid < 260 * 8) HGC_LOAD(F.bid);
    for (int u = F.bid; u < 260 * 8; u += F.G) {
        const int tc = u >> 3, h = u & 7, row0 = tc_row0(tc);
        const int tb2 = F.wave >> 2, jb = F.wave & 3;
        bf16x8 sf[16];
        {
            const bf16_t* s0p = hg_state(F, 0, h, tc_pf(tc)) + (size_t)(jb * 8 * 64 + F.lane) * 8;
            const bf16_t* s1p = hg_state(F, 1, h, tc_pb(tc)) + (size_t)(jb * 8 * 64 + F.lane) * 8;
#pragma unroll
            for (int ks = 0; ks < 8; ++ks) { sf[ks] = *(const bf16x8*)(s0p + ks * 512); sf[8 + ks] = *(const bf16x8*)(s1p + ks * 512); }
        }
        __syncthreads();
        HgPrep R; hg_prep_z(F, zw, h, dir, seg, cp, R);
        if (dir == 0) hg_stage_vt_v(F, vw, seg, cp);
        {
            const float eref0 = __expf(R.ref0), eref1 = __expf(R.ref1), eoff0 = __expf(R.off0 - R.ref0), eoff1 = __expf(R.off1 - R.ref1);
#pragma unroll
            for (int i = 0; i < 16; ++i) {
                const int si = seg * 16 + i, tok = dir ? 63 - si : si;
                const unsigned qw = qw_[i];
                const float q0 = lo_bf(qw), q1 = hi_bf(qw);
                const float ea0 = eoff0 * R.c0[i], ea1 = eoff1 * R.c1[i];
                const int lo = (dir * 64 + tok) * HG_PITCH + 4 * cp;
                const float qr0 = q0 * ea0, qr1 = q1 * ea1;
                *(LAS unsigned*)(F.lds + HG_QR + lo) = cvt_pk_bf16(qr0, qr1);
                *(LAS unsigned*)(F.lds + HG_KR + lo) = cvt_pk_bf16(R.k0[i] * __builtin_amdgcn_rcpf(ea0), R.k1[i] * __builtin_amdgcn_rcpf(ea1));
                *(LAS unsigned*)(F.lds + HG_QI + lo) = cvt_pk_bf16(qr0 * eref0, qr1 * eref1);
            }
        }
        __syncthreads();
        { const int un = u + F.G; if (un < 260 * 8) HGC_LOAD(un); }
        u32x2 gwp[4];
#pragma unroll
        for (int g = 0; g < 4; ++g) gwp[g] = *(const u32x2*)(P + (size_t)(row0 + tb2 * 32 + r) * PLD + 4096 + h * 128 + jb * 32 + 8 * g + 4 * hf);
        {
            const int tb = (F.wave >> 1) & 1, sb = F.wave & 1;
            f32x16 acc;
#pragma unroll
            for (int i = 0; i < 16; ++i) acc[i] = 0.f;
#pragma unroll
            for (int ks = 0; ks < 8; ++ks) {
                const bf16x8 a = *(const LAS bf16x8*)(F.lds + HG_KR + (dir * 64 + sb * 32 + r) * HG_PITCH + (ks * 16 + hf * 8) * 2);
                const bf16x8 b = *(const LAS bf16x8*)(F.lds + HG_QR + (dir * 64 + tb * 32 + r) * HG_PITCH + (ks * 16 + hf * 8) * 2);
                acc = MFMA32(a, b, acc);
            }
            const int t = tb * 32 + r;
#pragma unroll
            for (int g = 0; g < 4; ++g) {
                const int s0 = sb * 32 + 8 * g + 4 * hf; float v[4];
#pragma unroll
                for (int j = 0; j < 4; ++j) { const int s_ = s0 + j; const bool keep = dir ? (s_ >= t) : (s_ <= t); v[j] = keep ? acc[4 * g + j] : 0.f; }
                u32x2 w; w.x = pk2(v[0], v[1]); w.y = pk2(v[2], v[3]);
                *(LAS u32x2*)(F.lds + HG_ATT + t * HG_PITCH + (dir * 64 + s0) * 2) = w;
            }
        }
        __syncthreads();
        f32x16 o;
#pragma unroll
        for (int i = 0; i < 16; ++i) o[i] = 0.f;
#pragma unroll
        for (int ks = 0; ks < 8; ++ks) {
            const bf16x8 a = *(const LAS bf16x8*)(F.lds + HG_VT + (jb * 32 + r) * HG_VPITCH + ((ks & 3) * 16 + hf * 8) * 2);
            const bf16x8 b = *(const LAS bf16x8*)(F.lds + HG_ATT + (tb2 * 32 + r) * HG_PITCH + (ks * 16 + hf * 8) * 2);
            o = MFMA32(a, b, o);
        }
#pragma unroll
        for (int ks = 0; ks < 16; ++ks) {
            const bf16x8 b = *(const LAS bf16x8*)(F.lds + HG_QI + ((ks >> 3) * 64 + tb2 * 32 + r) * HG_PITCH + ((ks & 7) * 16 + hf * 8) * 2);
            o = MFMA32(sf[ks], b, o);
        }
        float ss = 0.f;
#pragma unroll
        for (int i = 0; i < 16; ++i) ss += o[i] * o[i];
        ss += __shfl_xor(ss, 32);
        LAS float* red = (LAS float*)(F.lds + HG_RED);
        if (hf == 0) red[(tb2 * 4 + jb) * 32 + r] = ss;
        __syncthreads();
        const float tot = red[(tb2 * 4 + 0) * 32 + r] + red[(tb2 * 4 + 1) * 32 + r] + red[(tb2 * 4 + 2) * 32 + r] + red[(tb2 * 4 + 3) * 32 + r];
        const float rn = rsqrtf(tot * (1.0f / 128.0f) + EPS);
        const int row = row0 + tb2 * 32 + r;
#pragma unroll
        for (int g = 0; g < 4; ++g) {
            const int dv = jb * 32 + 8 * g + 4 * hf;
            const u32x2 gw = gwp[g];
            const f32x4 nw = *(const f32x4*)(F.in[12] + dv);
            u32x2 w; w.x = pk2(o[4 * g] * rn * nw[0] * lo_bf(gw.x), o[4 * g + 1] * rn * nw[1] * hi_bf(gw.x));
            w.y = pk2(o[4 * g + 2] * rn * nw[2] * lo_bf(gw.y), o[4 * g + 3] * rn * nw[3] * hi_bf(gw.y));
            *(u32x2*)(O + (size_t)row * D + h * 128 + dv) = w;
        }
    }
}


constexpr int AT_K = 0, AT_V = 2 * 9216, AT_PITCH = 144;
__device__ __forceinline__ void phase_att(Frame& F) {
    const bf16_t* QKV = WSB(WS_P); bf16_t* O = WSB(WS_XSA);
    const int r = F.lane & 31, hf = F.lane >> 5, g = F.wave >> 1, th = F.wave & 1;
    const int kkey = F.tid >> 3, kc = F.tid & 7, vkey = F.tid & 63, vdg = F.tid >> 6;
    for (int u = F.vcu; u < 1024; u += F.G) {
        const int kvh = u & 3, t0 = (u >> 2) * 64, qh = kvh * 4 + g, t = t0 + 32 * th + r;
        bf16x8 qf[4];
#pragma unroll
        for (int ks = 0; ks < 4; ++ks) qf[ks] = *(const bf16x8*)(QKV + (size_t)t * QK_LD + qh * 64 + ks * 16 + hf * 8);
        int jfirst = 0, jlast = 4;
        if (t0 - 128 < 0) jfirst = (128 - t0) >> 6;
        if (t0 + 191 >= NLAT) jlast = 4 - ((t0 + 192 - NLAT) >> 6);
        const int ntl = jlast - jfirst + 1, nt = ntl + 4;
        const bf16_t* kbase = QKV + 1024 + kvh * 64;
        u32x4 kreg, vreg;
#define AT_LOAD(it) do { const int s0_ = ((it) < ntl) ? (t0 - 128 + 64 * (jfirst + (it))) : (NLAT + 64 * ((it) - ntl)); \
            kreg = *(const u32x4*)(kbase + (size_t)(s0_ + kkey) * QK_LD + 8 * kc); vreg = *(const u32x4*)(kbase + (size_t)(s0_ + vkey) * QK_LD + 256 + 8 * vdg); } while (0)
#define AT_WRITE(b) do { *(LAS u32x4*)(F.lds + AT_K + (b) * 9216 + kkey * AT_PITCH + 16 * kc) = kreg; \
            LAS unsigned short* vp_ = (LAS unsigned short*)(F.lds + AT_V + (b) * 9216 + (8 * vdg) * AT_PITCH + vkey * 2); \
            vp_[0] = (unsigned short)(vreg.x & 0xffffu); vp_[AT_PITCH / 2] = (unsigned short)(vreg.x >> 16); vp_[2 * (AT_PITCH / 2)] = (unsigned short)(vreg.y & 0xffffu); vp_[3 * (AT_PITCH / 2)] = (unsigned short)(vreg.y >> 16); \
            vp_[4 * (AT_PITCH / 2)] = (unsigned short)(vreg.z & 0xffffu); vp_[5 * (AT_PITCH / 2)] = (unsigned short)(vreg.z >> 16); vp_[6 * (AT_PITCH / 2)] = (unsigned short)(vreg.w & 0xffffu); vp_[7 * (AT_PITCH / 2)] = (unsigned short)(vreg.w >> 16); } while (0)
        AT_LOAD(0); AT_WRITE(0);
        __syncthreads();
        float m = F.in[25][qh] * 1.4426950408889634f, l = 1.0f;
        f32x16 o0, o1;
#pragma unroll
        for (int i = 0; i < 16; ++i) { o0[i] = 0.f; o1[i] = 0.f; }
        for (int it = 0; it < nt; ++it) {
            const int b = it & 1;
            if (it + 1 < nt) AT_LOAD(it + 1);
            f32x16 x0, x1;
#pragma unroll
            for (int i = 0; i < 16; ++i) { x0[i] = 0.f; x1[i] = 0.f; }
#pragma unroll
            for (int ks = 0; ks < 4; ++ks) {
                const bf16x8 a0 = *(const LAS bf16x8*)(F.lds + AT_K + b * 9216 + r * AT_PITCH + (ks * 16 + hf * 8) * 2);
                const bf16x8 a1 = *(const LAS bf16x8*)(F.lds + AT_K + b * 9216 + (32 + r) * AT_PITCH + (ks * 16 + hf * 8) * 2);
                x0 = MFMA32(a0, qf[ks], x0); x1 = MFMA32(a1, qf[ks], x1);
            }
            if (it < ntl) { const int j = jfirst + it;
                if (j == 0 || j == 4) { const int s0 = t0 - 128 + 64 * j;
#pragma unroll
                    for (int i = 0; i < 16; ++i) { const int sk = s0 + (i & 3) + 8 * (i >> 2) + 4 * hf; const int d0 = sk - t, d1 = sk + 32 - t;
                        if (d0 < -128 || d0 > 128) x0[i] = -1e30f; if (d1 < -128 || d1 > 128) x1[i] = -1e30f; } } }
            float mx = x0[0];
#pragma unroll
            for (int i = 0; i < 16; ++i) { mx = fmaxf(mx, x0[i]); mx = fmaxf(mx, x1[i]); }
            mx = fmaxf(mx, __shfl_xor(mx, 32));
            if (__any(mx > m + 8.0f)) {
                const float mn = fmaxf(m, mx), al = __builtin_amdgcn_exp2f(m - mn); m = mn; l *= al;
#pragma unroll
                for (int i = 0; i < 16; ++i) { o0[i] *= al; o1[i] *= al; }
            }
            float ls = 0.f;
#pragma unroll
            for (int i = 0; i < 16; ++i) { x0[i] = __builtin_amdgcn_exp2f(x0[i] - m); x1[i] = __builtin_amdgcn_exp2f(x1[i] - m); ls += x0[i] + x1[i]; }
            ls += __shfl_xor(ls, 32);
            l += ls;
#pragma unroll
            for (int kt = 0; kt < 2; ++kt)
#pragma unroll
                for (int s_ = 0; s_ < 2; ++s_) {
                    u32x4 pw;
                    if (kt == 0) { pw.x = cvt_pk_bf16(x0[8 * s_], x0[8 * s_ + 1]); pw.y = cvt_pk_bf16(x0[8 * s_ + 2], x0[8 * s_ + 3]); pw.z = cvt_pk_bf16(x0[8 * s_ + 4], x0[8 * s_ + 5]); pw.w = cvt_pk_bf16(x0[8 * s_ + 6], x0[8 * s_ + 7]); }
                    else { pw.x = cvt_pk_bf16(x1[8 * s_], x1[8 * s_ + 1]); pw.y = cvt_pk_bf16(x1[8 * s_ + 2], x1[8 * s_ + 3]); pw.z = cvt_pk_bf16(x1[8 * s_ + 4], x1[8 * s_ + 5]); pw.w = cvt_pk_bf16(x1[8 * s_ + 6], x1[8 * s_ + 7]); }
                    const bf16x8 pb = __builtin_bit_cast(bf16x8, pw);
                    const int koff = (kt * 32 + 16 * s_ + 4 * hf) * 2;
                    const LAS unsigned char* v0p = F.lds + AT_V + b * 9216 + r * AT_PITCH + koff; const LAS unsigned char* v1p = v0p + 32 * AT_PITCH;
                    u32x4 a0w, a1w; const u32x2 a00 = *(const LAS u32x2*)v0p, a01 = *(const LAS u32x2*)(v0p + 16), a10 = *(const LAS u32x2*)v1p, a11 = *(const LAS u32x2*)(v1p + 16);
                    a0w.x = a00.x; a0w.y = a00.y; a0w.z = a01.x; a0w.w = a01.y; a1w.x = a10.x; a1w.y = a10.y; a1w.z = a11.x; a1w.w = a11.y;
                    o0 = MFMA32(__builtin_bit_cast(bf16x8, a0w), pb, o0); o1 = MFMA32(__builtin_bit_cast(bf16x8, a1w), pb, o1);
                }
            if (it + 1 < nt) AT_WRITE(b ^ 1);
            __syncthreads();
        }
        const float il = 1.0f / l;
#pragma unroll
        for (int g4 = 0; g4 < 4; ++g4) {
            const int d = 8 * g4 + 4 * hf;
            u32x2 w0, w1; w0.x = cvt_pk_bf16(o0[4 * g4] * il, o0[4 * g4 + 1] * il); w0.y = cvt_pk_bf16(o0[4 * g4 + 2] * il, o0[4 * g4 + 3] * il);
            w1.x = cvt_pk_bf16(o1[4 * g4] * il, o1[4 * g4 + 1] * il); w1.y = cvt_pk_bf16(o1[4 * g4 + 2] * il, o1[4 * g4 + 3] * il);
            *(u32x2*)(O + (size_t)t * D + qh * 64 + d) = w0; *(u32x2*)(O + (size_t)t * D + qh * 64 + 32 + d) = w1;
        }
#undef AT_LOAD
#undef AT_WRITE
    }
#undef HGC_LOAD
}


constexpr size_t WS_SDEC = WS_CTL + 32768;
constexpr size_t WS_TS = WS_CTL + 24576;
__device__ __forceinline__ bf16_t* ssm_state(const Frame& F, int dir, int h, int p) { return (bf16_t*)(F.ws + WS_ST) + ((size_t)(dir * 32 + h) * 65 + p) * 8192; }
constexpr int SS_PT = 528;
constexpr int SA_BT = 0, SA_XW = 128 * SS_PT, SA_SC = SA_XW + 2 * 64 * SS_PT;
constexpr int SC_BM = 0, SC_XT = 256 * 272, SC_SC = SC_XT + 64 * SS_PT, SC_ST = SC_SC + 6144;
static_assert(SA_SC + 4096 <= MISC_OFF && SC_ST + 128 * 272 <= MISC_OFF, "Mamba LDS map");
__device__ __forceinline__ float wave_incl_scan(float v, int lane) {
#pragma unroll
    for (int o = 1; o < 64; o <<= 1) { const float t = __shfl_up(v, o); if (lane >= o) v += t; }
    return v;
}
struct SsmDt { float x[4]; };
__device__ __forceinline__ void ssm_scalars_load(const Frame& F, int r0, int h, SsmDt& R) {
    if (F.wave < 2) { const int dir = F.wave;
#pragma unroll
        for (int j = 0; j < 4; ++j) { const int i = dir ? 255 - (4 * F.lane + j) : 4 * F.lane + j; R.x[j] = WSF(WS_DT)[(size_t)(r0 + i) * 64 + dir * 32 + h]; } }
}
__device__ __forceinline__ void ssm_scalars(const Frame& F, LAS float* SC, int h, const SsmDt& R) {
    if (F.wave < 2) {
        const int dir = F.wave; const float A = -__expf(F.in[18][dir * 32 + h]), dtb = F.in[17][dir * 32 + h];
        float dt[4], c[4], run = 0.f;
#pragma unroll
        for (int j = 0; j < 4; ++j) { const float x = R.x[j] + dtb; dt[j] = (x > 20.f) ? x : log1pf(__expf(x)); run += dt[j] * A; c[j] = run; }
        const float off = wave_incl_scan(run, F.lane) - run;
#pragma unroll
        for (int j = 0; j < 4; ++j) { const int i = dir ? 255 - (4 * F.lane + j) : 4 * F.lane + j; SC[dir * 256 + i] = dt[j]; SC[512 + dir * 256 + i] = off + c[j]; }
    }
    __syncthreads();
}
__device__ __forceinline__ u32x4 pack8(const float (&v)[8]) { u32x4 w; w.x = cvt_pk_bf16(v[0], v[1]); w.y = cvt_pk_bf16(v[2], v[3]); w.z = cvt_pk_bf16(v[4], v[5]); w.w = cvt_pk_bf16(v[6], v[7]); return w; }
__device__ __forceinline__ void run_geom(int ru, int& r0, int& pf, int& pb) {
    if (ru < 64) { r0 = ru * 256; pf = 1 + ru; pb = 1 + (63 - ru); } else { r0 = NLAT; pf = 0; pb = 0; }
}
__device__ __forceinline__ void phase_ssm_conv(Frame& F) {
    bf16_t* P = WSB(WS_P); const bf16_t* HALO = WSB(WS_HALO);
    for (int u = F.bid; u < 260 * 3; u += F.G) {
        const int tk = u / 3, ch = (u % 3) * 1024 + F.tid * 2;
        const bool first = (tk == 0 || tk == 256), last = (tk == 255 || tk == 259);
        unsigned raw[68];
        raw[0] = first ? 0u : *(const unsigned*)(HALO + ((size_t)tk * 4 + 0) * SSM_CD + ch); raw[1] = first ? 0u : *(const unsigned*)(HALO + ((size_t)tk * 4 + 1) * SSM_CD + ch);
        raw[66] = last ? 0u : *(const unsigned*)(HALO + ((size_t)tk * 4 + 2) * SSM_CD + ch); raw[67] = last ? 0u : *(const unsigned*)(HALO + ((size_t)tk * 4 + 3) * SSM_CD + ch);
        bf16_t* colp = P + (size_t)tk * 64 * PLD + 2048 + ch;
#pragma unroll
        for (int i = 0; i < 64; ++i) raw[2 + i] = *(const unsigned*)(colp + (size_t)i * PLD);
        float cw0[5], cw1[5];
#pragma unroll
        for (int j = 0; j < 5; ++j) { const f32x2 w = *(const f32x2*)(F.in[15] + j * SSM_CD + ch); cw0[j] = w.x; cw1[j] = w.y; }
        const f32x2 cb = *(const f32x2*)(F.in[16] + ch);
#pragma unroll
        for (int i = 0; i < 64; ++i) {
            const float a0 = cb.x + cw0[0] * lo_bf(raw[i]) + cw0[1] * lo_bf(raw[i + 1]) + cw0[2] * lo_bf(raw[i + 2]) + cw0[3] * lo_bf(raw[i + 3]) + cw0[4] * lo_bf(raw[i + 4]);
            const float a1 = cb.y + cw1[0] * hi_bf(raw[i]) + cw1[1] * hi_bf(raw[i + 1]) + cw1[2] * hi_bf(raw[i + 2]) + cw1[3] * hi_bf(raw[i + 3]) + cw1[4] * hi_bf(raw[i + 4]);
            *(unsigned*)(colp + (size_t)i * PLD) = cvt_pk_bf16(siluf_(a0), siluf_(a1));
        }
    }
}
constexpr int SCT_N = 2048;
__device__ __forceinline__ void ssm_tables(Frame& F) {
    float* T = (float*)(F.ws + WS_XSA);
    const int gw = F.vcu * NWAVES + F.wave, NGW = F.G * NWAVES;
    for (int task = gw; task < 65 * 32 * 2; task += NGW) {
        const int u = task >> 1, dir = task & 1, ru = u >> 5, h = u & 31; int r0, pf, pb; run_geom(ru, r0, pf, pb);
        const float A = -__expf(F.in[18][dir * 32 + h]), dtb = F.in[17][dir * 32 + h];
        float xr_[4];
#pragma unroll
        for (int j = 0; j < 4; ++j) { const int i = dir ? 255 - (4 * F.lane + j) : 4 * F.lane + j; xr_[j] = WSF(WS_DT)[(size_t)(r0 + i) * 64 + dir * 32 + h]; }
        float dt[4], c[4], run = 0.f;
#pragma unroll
        for (int j = 0; j < 4; ++j) { const float x = xr_[j] + dtb; dt[j] = (x > 20.f) ? x : log1pf(__expf(x)); run += dt[j] * A; c[j] = run; }
        const float off = wave_incl_scan(run, F.lane) - run;
#pragma unroll
        for (int j = 0; j < 4; ++j) c[j] += off;
        const float cref = __shfl(c[3], (F.lane & ~7) | 7);
        const float last = __shfl(c[3], 63);
        float e[4], wgt[4];
#pragma unroll
        for (int j = 0; j < 4; ++j) { e[j] = dt[j] * __expf(cref - c[j]); wgt[j] = dt[j] * __expf(last - c[j]); }
        float* tb = T + (size_t)u * SCT_N;
        if (dir == 0) { const int i0 = 4 * F.lane;
            *(f32x4*)(tb + i0) = (f32x4){dt[0], dt[1], dt[2], dt[3]}; *(f32x4*)(tb + 512 + i0) = (f32x4){c[0], c[1], c[2], c[3]};
            *(f32x4*)(tb + 1024 + i0) = (f32x4){e[0], e[1], e[2], e[3]}; *(f32x4*)(tb + 1536 + i0) = (f32x4){wgt[0], wgt[1], wgt[2], wgt[3]};
        } else { const int i0 = 252 - 4 * F.lane;
            *(f32x4*)(tb + 256 + i0) = (f32x4){dt[3], dt[2], dt[1], dt[0]}; *(f32x4*)(tb + 768 + i0) = (f32x4){c[3], c[2], c[1], c[0]};
            *(f32x4*)(tb + 1280 + i0) = (f32x4){e[3], e[2], e[1], e[0]}; *(f32x4*)(tb + 1792 + i0) = (f32x4){wgt[3], wgt[2], wgt[1], wgt[0]};
        }
        if (F.lane == 63) WSF(WS_SDEC)[(dir * 32 + h) * 65 + (dir ? pb : pf)] = __expf(last);
    }
}
__device__ __forceinline__ void phase_ssm_a(Frame& F) {
    const bf16_t* P = WSB(WS_P); const float* T = (const float*)(F.ws + WS_XSA);
    const int r = F.lane & 31, hf = F.lane >> 5;
    for (int u = F.vcu; u < 65 * 32; u += F.G) {
        const int ru = u >> 5, h = u & 31, g = h >> 3; int r0, pf, pb; run_geom(ru, r0, pf, pb);
        const int xcp = F.tid & 31, xsg = F.tid >> 5, bcp = F.tid & 63, bsg = F.tid >> 6;
        unsigned xr[16], br[32];
        { const bf16_t* xp = P + (size_t)(r0 + xsg * 16) * PLD + 2048 + h * 64 + 2 * xcp;
#pragma unroll
          for (int i = 0; i < 16; ++i) xr[i] = *(const unsigned*)(xp + (size_t)i * PLD);
          const bf16_t* bp = P + (size_t)(r0 + bsg * 32) * PLD + 4096 + g * 128 + 2 * bcp;
#pragma unroll
          for (int i = 0; i < 32; ++i) br[i] = *(const unsigned*)(bp + (size_t)i * PLD); }
        f32x4 wfv[4], wbv[4];
        { const float* tw = T + (size_t)u * SCT_N + 1536 + xsg * 16;
#pragma unroll
          for (int q = 0; q < 4; ++q) { wfv[q] = *(const f32x4*)(tw + 4 * q); wbv[q] = *(const f32x4*)(tw + 256 + 4 * q); } }
        __syncthreads();
#pragma unroll
        for (int k8 = 0; k8 < 4; ++k8) {
            u32x4 lo, hi;
            lo.x = (br[8 * k8] & 0xffffu) | (br[8 * k8 + 1] << 16); lo.y = (br[8 * k8 + 2] & 0xffffu) | (br[8 * k8 + 3] << 16); lo.z = (br[8 * k8 + 4] & 0xffffu) | (br[8 * k8 + 5] << 16); lo.w = (br[8 * k8 + 6] & 0xffffu) | (br[8 * k8 + 7] << 16);
            hi.x = (br[8 * k8] >> 16) | (br[8 * k8 + 1] & 0xffff0000u); hi.y = (br[8 * k8 + 2] >> 16) | (br[8 * k8 + 3] & 0xffff0000u); hi.z = (br[8 * k8 + 4] >> 16) | (br[8 * k8 + 5] & 0xffff0000u); hi.w = (br[8 * k8 + 6] >> 16) | (br[8 * k8 + 7] & 0xffff0000u);
            LAS unsigned char* bp = F.lds + SA_BT + (2 * bcp) * SS_PT + (bsg * 32 + k8 * 8) * 2; *(LAS u32x4*)bp = lo; *(LAS u32x4*)(bp + SS_PT) = hi;
        }
#pragma unroll
        for (int k8 = 0; k8 < 2; ++k8) {
            float f0[8], f1[8], b0[8], b1[8];
#pragma unroll
            for (int j = 0; j < 8; ++j) { const float x0 = lo_bf(xr[k8 * 8 + j]), x1 = hi_bf(xr[k8 * 8 + j]);
                const float wf = wfv[k8 * 2 + (j >> 2)][j & 3], wb = wbv[k8 * 2 + (j >> 2)][j & 3]; f0[j] = x0 * wf; f1[j] = x1 * wf; b0[j] = x0 * wb; b1[j] = x1 * wb; }
            LAS unsigned char* xp = F.lds + SA_XW + (2 * xcp) * SS_PT + (xsg * 16 + k8 * 8) * 2;
            *(LAS u32x4*)xp = pack8(f0); *(LAS u32x4*)(xp + SS_PT) = pack8(f1); *(LAS u32x4*)(xp + 64 * SS_PT) = pack8(b0); *(LAS u32x4*)(xp + 65 * SS_PT) = pack8(b1);
        }
        __syncthreads();
        const int dir = F.wave >> 2, pt = (F.wave >> 1) & 1, nt0 = 2 * (F.wave & 1);
        f32x16 acc0, acc1;
#pragma unroll
        for (int i = 0; i < 16; ++i) { acc0[i] = 0.f; acc1[i] = 0.f; }
#pragma unroll 4
        for (int ks = 0; ks < 16; ++ks) {
            const bf16x8 b = *(const LAS bf16x8*)(F.lds + SA_XW + (dir * 64 + pt * 32 + r) * SS_PT + (ks * 16 + hf * 8) * 2);
            const bf16x8 a0 = *(const LAS bf16x8*)(F.lds + SA_BT + (nt0 * 32 + r) * SS_PT + (ks * 16 + hf * 8) * 2);
            const bf16x8 a1 = *(const LAS bf16x8*)(F.lds + SA_BT + ((nt0 + 1) * 32 + r) * SS_PT + (ks * 16 + hf * 8) * 2);
            acc0 = MFMA32(a0, b, acc0); acc1 = MFMA32(a1, b, acc1);
        }
        bf16_t* st = ssm_state(F, dir, h, dir ? pb : pf) + (size_t)(pt * 32 + r) * 128;
#pragma unroll
        for (int g4 = 0; g4 < 4; ++g4) { u32x2 w0, w1; w0.x = cvt_pk_bf16(acc0[4 * g4], acc0[4 * g4 + 1]); w0.y = cvt_pk_bf16(acc0[4 * g4 + 2], acc0[4 * g4 + 3]);
            w1.x = cvt_pk_bf16(acc1[4 * g4], acc1[4 * g4 + 1]); w1.y = cvt_pk_bf16(acc1[4 * g4 + 2], acc1[4 * g4 + 3]);
            *(u32x2*)(st + nt0 * 32 + 8 * g4 + 4 * hf) = w0; *(u32x2*)(st + (nt0 + 1) * 32 + 8 * g4 + 4 * hf) = w1; }
    }
}
__device__ __forceinline__ void phase_ssm_b(Frame& F) {
    for (int idx = F.bid * NTHR + F.tid; idx < 2 * 32 * 4096; idx += F.G * NTHR) {
        const int e2 = idx & 4095, hh = idx >> 12;
        unsigned* sp = (unsigned*)((bf16_t*)(F.ws + WS_ST) + (size_t)hh * 65 * 8192) + e2;
        const float* dp = WSF(WS_SDEC) + hh * 65;
        float s0 = 0.f, s1 = 0.f;
        for (int p = 0; p < 65; p += 13) {
            unsigned x[13]; float d[13];
#pragma unroll
            for (int j = 0; j < 13; ++j) { x[j] = sp[(size_t)(p + j) * 4096]; d[j] = dp[p + j]; }
#pragma unroll
            for (int j = 0; j < 13; ++j) { sp[(size_t)(p + j) * 4096] = cvt_pk_bf16(s0, s1); s0 = d[j] * s0 + lo_bf(x[j]); s1 = d[j] * s1 + hi_bf(x[j]); }
        }
    }
}
__device__ __forceinline__ void phase_ssm_c(Frame& F, bool dry = false) {
    bf16_t* P = WSB(WS_P); LAS float* SC = (LAS float*)(F.lds + SC_SC); const float* T = (const float*)(F.ws + WS_XSA);
    const int r = F.lane & 31, hf = F.lane >> 5, w = F.wave;
    for (int u = F.vcu; u < 65 * 32; u += F.G) {
        const int ru = u >> 5, h = u & 31, g = h >> 3; int r0, pf, pb; run_geom(ru, r0, pf, pb);
        const int ti = 32 * w + r, trow = r0 + ti;
        f32x4 scv = {0.f, 0.f, 0.f, 0.f}; if (F.tid < 384) scv = *(const f32x4*)(T + (size_t)u * SCT_N + 4 * F.tid);
        bf16x8 cf[8];
#pragma unroll
        for (int ks = 0; ks < 8; ++ks) cf[ks] = *(const bf16x8*)(P + (size_t)trow * PLD + 4608 + g * 128 + ks * 16 + hf * 8);
        const int xcp = F.tid & 31, xsg = F.tid >> 5;
        unsigned xr[16];
        { const bf16_t* xp = P + (size_t)(r0 + xsg * 16) * PLD + 2048 + h * 64 + 2 * xcp;
#pragma unroll
          for (int i = 0; i < 16; ++i) xr[i] = *(const unsigned*)(xp + (size_t)i * PLD); }
        u32x4 bm[8];
#pragma unroll
        for (int k = 0; k < 8; ++k) { const int idx = F.tid + 512 * k, row = idx >> 4, c16 = idx & 15; bm[k] = *(const u32x4*)(P + (size_t)(r0 + row) * PLD + 4096 + g * 128 + c16 * 8); }
        u32x4 sv[4];
#pragma unroll
        for (int k = 0; k < 4; ++k) { const int idx = F.tid + 512 * k, dir = idx >> 10, e = idx & 1023; sv[k] = *(const u32x4*)(ssm_state(F, dir, h, dir ? pb : pf) + e * 8); }
        bf16_t* zp = P + (size_t)trow * PLD + h * 64;
        u32x2 zv[8];
#pragma unroll
        for (int g4 = 0; g4 < 4; ++g4) { zv[2 * g4] = *(const u32x2*)(zp + 8 * g4 + 4 * hf); zv[2 * g4 + 1] = *(const u32x2*)(zp + 32 + 8 * g4 + 4 * hf); }
        __syncthreads();
        if (F.tid < 384) *(LAS f32x4*)(SC + 4 * F.tid) = scv;
#pragma unroll
        for (int k = 0; k < 8; ++k) { const int idx = F.tid + 512 * k, row = idx >> 4, c16 = idx & 15; *(LAS u32x4*)(F.lds + SC_BM + row * 272 + c16 * 16) = bm[k]; }
#pragma unroll
        for (int k = 0; k < 4; ++k) { const int idx = F.tid + 512 * k, dir = idx >> 10, e = idx & 1023; *(LAS u32x4*)(F.lds + SC_ST + (dir * 64 + (e >> 4)) * 272 + (e & 15) * 16) = sv[k]; }
#pragma unroll
        for (int k8 = 0; k8 < 2; ++k8) {
            u32x4 lo, hi;
            lo.x = (xr[8 * k8] & 0xffffu) | (xr[8 * k8 + 1] << 16); lo.y = (xr[8 * k8 + 2] & 0xffffu) | (xr[8 * k8 + 3] << 16); lo.z = (xr[8 * k8 + 4] & 0xffffu) | (xr[8 * k8 + 5] << 16); lo.w = (xr[8 * k8 + 6] & 0xffffu) | (xr[8 * k8 + 7] << 16);
            hi.x = (xr[8 * k8] >> 16) | (xr[8 * k8 + 1] & 0xffff0000u); hi.y = (xr[8 * k8 + 2] >> 16) | (xr[8 * k8 + 3] & 0xffff0000u); hi.z = (xr[8 * k8 + 4] >> 16) | (xr[8 * k8 + 5] & 0xffff0000u); hi.w = (xr[8 * k8 + 6] >> 16) | (xr[8 * k8 + 7] & 0xffff0000u);
            LAS unsigned char* xp = F.lds + SC_XT + (2 * xcp) * SS_PT + (xsg * 16 + k8 * 8) * 2; *(LAS u32x4*)xp = lo; *(LAS u32x4*)(xp + SS_PT) = hi;
        }
        __syncthreads();
        const float cft = SC[512 + ti], cbt = SC[768 + ti];
        f32x16 y0, y1;
#pragma unroll
        for (int i = 0; i < 16; ++i) { y0[i] = 0.f; y1[i] = 0.f; }
#pragma unroll 1
        for (int sb = 0; sb < 8; ++sb) {
            f32x16 x;
#pragma unroll
            for (int i = 0; i < 16; ++i) x[i] = 0.f;
#pragma unroll
            for (int ks = 0; ks < 8; ++ks) { const bf16x8 a = *(const LAS bf16x8*)(F.lds + SC_BM + (sb * 32 + r) * 272 + (ks * 16 + hf * 8) * 2); x = MFMA32(a, cf[ks], x); }
            if (sb == w) {
#pragma unroll
                for (int g4 = 0; g4 < 4; ++g4) {
                    const int sl = sb * 32 + 8 * g4 + 4 * hf;
                    const f32x4 dtf = *(const LAS f32x4*)(SC + sl), dtb = *(const LAS f32x4*)(SC + 256 + sl), cfs = *(const LAS f32x4*)(SC + 512 + sl), cbs = *(const LAS f32x4*)(SC + 768 + sl);
#pragma unroll
                    for (int j = 0; j < 4; ++j) { const int s_ = sl + j; float m = 0.f;
                        if (s_ <= ti) m += __expf(cft - cfs[j]) * dtf[j];
                        if (s_ >= ti) m += __expf(cbt - cbs[j]) * dtb[j];
                        x[4 * g4 + j] *= m; }
                }
            } else {
                const bool fwd = sb < w;
                const float fac = fwd ? __expf(cft - SC[512 + sb * 32 + 31]) : __expf(cbt - SC[768 + sb * 32]);
                const LAS float* E = SC + (fwd ? 1024 : 1280) + sb * 32 + 4 * hf;
#pragma unroll
                for (int g4 = 0; g4 < 4; ++g4) { const f32x4 e4 = *(const LAS f32x4*)(E + 8 * g4);
#pragma unroll
                    for (int j = 0; j < 4; ++j) x[4 * g4 + j] *= fac * e4[j]; }
            }
#pragma unroll
            for (int s2 = 0; s2 < 2; ++s2) {
                u32x4 pw; pw.x = cvt_pk_bf16(x[8 * s2], x[8 * s2 + 1]); pw.y = cvt_pk_bf16(x[8 * s2 + 2], x[8 * s2 + 3]); pw.z = cvt_pk_bf16(x[8 * s2 + 4], x[8 * s2 + 5]); pw.w = cvt_pk_bf16(x[8 * s2 + 6], x[8 * s2 + 7]);
                const bf16x8 pb_ = __builtin_bit_cast(bf16x8, pw);
                const LAS unsigned char* a0p = F.lds + SC_XT + r * SS_PT + (sb * 32 + 16 * s2 + 4 * hf) * 2; const LAS unsigned char* a1p = a0p + 32 * SS_PT;
                const u32x2 a00 = *(const LAS u32x2*)a0p, a01 = *(const LAS u32x2*)(a0p + 16), a10 = *(const LAS u32x2*)a1p, a11 = *(const LAS u32x2*)(a1p + 16);
                u32x4 a0w, a1w; a0w.x = a00.x; a0w.y = a00.y; a0w.z = a01.x; a0w.w = a01.y; a1w.x = a10.x; a1w.y = a10.y; a1w.z = a11.x; a1w.w = a11.y;
                y0 = MFMA32(__builtin_bit_cast(bf16x8, a0w), pb_, y0); y1 = MFMA32(__builtin_bit_cast(bf16x8, a1w), pb_, y1);
            }
        }
#pragma unroll
        for (int dir = 0; dir < 2; ++dir) {
            const float e = __expf(dir ? cbt : cft);
#pragma unroll
            for (int pt = 0; pt < 2; ++pt) {
                f32x16 yd;
#pragma unroll
                for (int i = 0; i < 16; ++i) yd[i] = 0.f;
#pragma unroll
                for (int ks = 0; ks < 8; ++ks) { const bf16x8 sa = *(const LAS bf16x8*)(F.lds + SC_ST + (dir * 64 + pt * 32 + r) * 272 + (ks * 16 + hf * 8) * 2); yd = MFMA32(sa, cf[ks], yd); }
                if (pt == 0) {
#pragma unroll
                    for (int i = 0; i < 16; ++i) y0[i] += e * yd[i];
                } else {
#pragma unroll
                    for (int i = 0; i < 16; ++i) y1[i] += e * yd[i];
                }
            }
        }
        const float Dk = F.in[19][h];
        bf16_t* zo = dry ? WSB(WS_HALO) + ((size_t)(u & 255) * 256 + ti) * 64 : zp; float ssq_ = 0.f;
#pragma unroll
        for (int g4 = 0; g4 < 4; ++g4) {
            const int p0 = 8 * g4 + 4 * hf;
            const u32x2 z0 = zv[2 * g4], z1 = zv[2 * g4 + 1];
            float xa[4], xb[4];
#pragma unroll
            for (int j = 0; j < 4; ++j) { xa[j] = bf2f(*(const LAS unsigned short*)(F.lds + SC_XT + (p0 + j) * SS_PT + ti * 2)); xb[j] = bf2f(*(const LAS unsigned short*)(F.lds + SC_XT + (32 + p0 + j) * SS_PT + ti * 2)); }
            float va[4], vb[4];
            va[0] = (y0[4 * g4] + Dk * xa[0]) * siluf_(lo_bf(z0.x)); va[1] = (y0[4 * g4 + 1] + Dk * xa[1]) * siluf_(hi_bf(z0.x));
            va[2] = (y0[4 * g4 + 2] + Dk * xa[2]) * siluf_(lo_bf(z0.y)); va[3] = (y0[4 * g4 + 3] + Dk * xa[3]) * siluf_(hi_bf(z0.y));
            vb[0] = (y1[4 * g4] + Dk * xb[0]) * siluf_(lo_bf(z1.x)); vb[1] = (y1[4 * g4 + 1] + Dk * xb[1]) * siluf_(hi_bf(z1.x));
            vb[2] = (y1[4 * g4 + 2] + Dk * xb[2]) * siluf_(lo_bf(z1.y)); vb[3] = (y1[4 * g4 + 3] + Dk * xb[3]) * siluf_(hi_bf(z1.y));
            ssq_ += (va[0] * va[0] + va[1] * va[1]) + (va[2] * va[2] + va[3] * va[3]) + (vb[0] * vb[0] + vb[1] * vb[1]) + (vb[2] * vb[2] + vb[3] * vb[3]);
            u32x2 o0, o1; o0.x = cvt_pk_bf16(va[0], va[1]); o0.y = cvt_pk_bf16(va[2], va[3]); o1.x = cvt_pk_bf16(vb[0], vb[1]); o1.y = cvt_pk_bf16(vb[2], vb[3]);
            *(u32x2*)(zo + p0) = o0; *(u32x2*)(zo + 32 + p0) = o1;
        }
        ssq_ += __shfl_xor(ssq_, 32);
        if (!dry && hf == 0) WSF(WS_SSQ)[(size_t)trow * 32 + h] = ssq_;
    }
}
__device__ __forceinline__ void phase_ssm_d(Frame& F) {
    bf16_t* P = WSB(WS_P);
    const int gw = F.bid * NWAVES + F.wave, NGW = F.G * NWAVES;
    for (int it = gw; it < MALL * 4; it += NGW) {
        const int row = it >> 2, g = it & 3; const int c = g * 512 + F.lane * 8;
        const u32x4 yv = *(const u32x4*)(P + (size_t)row * PLD + c);
        float y[8] = {lo_bf(yv.x), hi_bf(yv.x), lo_bf(yv.y), hi_bf(yv.y), lo_bf(yv.z), hi_bf(yv.z), lo_bf(yv.w), hi_bf(yv.w)}; float ss = 0.f;
#pragma unroll
        for (int j = 0; j < 8; ++j) ss += y[j] * y[j];
        ss = wave_sum(ss); const float rn = rsqrtf(ss * (1.0f / 512.0f) + EPS);
        u32x4 o; o.x = cvt_pk_bf16(y[0] * rn, y[1] * rn); o.y = cvt_pk_bf16(y[2] * rn, y[3] * rn); o.z = cvt_pk_bf16(y[4] * rn, y[5] * rn); o.w = cvt_pk_bf16(y[6] * rn, y[7] * rn);
        *(u32x4*)(P + (size_t)row * PLD + c) = o;
    }
}

template <int WIN> __device__ __forceinline__ void pool_unit(const bf16_t* XS, bf16_t* DL, const LAS float* rsd, int t0, int s0, int s1, int c) {
    constexpr int HB = WIN / 2, KLO = 8 - HB, KHI = 8 + 16 + HB - 1;
    unsigned raw[32];
#pragma unroll
    for (int k = KLO; k < KHI; ++k) { const int rr = t0 - 8 + k; const int rc = rr < s0 ? s0 : (rr >= s1 ? s1 - 1 : rr); raw[k] = *(const unsigned*)(XS + (size_t)rc * D + c); }
    float p0[33], p1[33], h0[32], h1[32];
    p0[KLO] = 0.f; p1[KLO] = 0.f;
#pragma unroll
    for (int k = KLO; k < KHI; ++k) { const float rr = rsd[k]; h0[k] = rr * lo_bf(raw[k]); h1[k] = rr * hi_bf(raw[k]); p0[k + 1] = p0[k] + h0[k]; p1[k + 1] = p1[k] + h1[k]; }
#pragma unroll
    for (int j = 0; j < 16; ++j) {
        const int t = t0 + j; int lo = t - HB, hi = t + WIN - HB; lo = lo < s0 ? s0 : lo; hi = hi > s1 ? s1 : hi;
        const float inv = 1.0f / (float)(hi - lo);
        const float a0 = (p0[8 + j + WIN - HB] - p0[8 + j - HB]) * inv - h0[8 + j], a1 = (p1[8 + j + WIN - HB] - p1[8 + j - HB]) * inv - h1[8 + j];
        *(unsigned*)(DL + (size_t)t * D + c) = cvt_pk_bf16(a0, a1);
    }
}
__device__ __forceinline__ void phase_pool_delta(Frame& F) {
    LAS float* rsd = (LAS float*)F.lds;
    const bf16_t* XS = WSB(WS_XSA); bf16_t* DL = WSB(WS_P);
    const int c = F.tid * 2, gi = F.tid >> 7;
    for (int u = F.bid; u < MALL / 16; u += F.G) {
        const int t0 = u * 16, s0 = (t0 >= NLAT) ? NLAT : 0, s1 = (t0 >= NLAT) ? MALL : NLAT;
        __syncthreads();
        if (F.tid < 32) { const int rr = t0 - 8 + F.tid; float v = 0.f;
            if (rr >= s0 && rr < s1 && rr >= NLAT) v = ctx_rstd(F, rr - NLAT);
            else if (rr >= s0 && rr < s1) { const float* sp = WSF(WS_SLOTS) + (size_t)rr * 16; const f32x4 a = *(const f32x4*)sp, b_ = *(const f32x4*)(sp + 4), c_ = *(const f32x4*)(sp + 8), d = *(const f32x4*)(sp + 12);
                const float t = ((a[0] + a[1]) + (a[2] + a[3])) + ((b_[0] + b_[1]) + (b_[2] + b_[3])) + ((c_[0] + c_[1]) + (c_[2] + c_[3])) + ((d[0] + d[1]) + (d[2] + d[3]));
                v = rsqrtf(t * (1.0f / 1024.0f) + EPS); }
            rsd[F.tid] = v; }
        __syncthreads();
        if (gi == 0) pool_unit<2>(XS, DL, rsd, t0, s0, s1, c); else if (gi == 1) pool_unit<4>(XS, DL, rsd, t0, s0, s1, c);
        else if (gi == 2) pool_unit<8>(XS, DL, rsd, t0, s0, s1, c); else pool_unit<16>(XS, DL, rsd, t0, s0, s1, c);
    }
}
__device__ __forceinline__ void phase_final(Frame& F) {
    const int gw = F.bid * NWAVES + F.wave, NGW = F.G * NWAVES;
    for (int row = gw; row < NLAT; row += NGW) {
        float t = (F.lane < 16) ? WSF(WS_SLOTS)[(size_t)row * 16 + F.lane] : 0.f; t = wave_sum(t);
        const float r = rsqrtf(t * (1.0f / 1024.0f) + EPS);
        float* xr = F.out + (size_t)row * D; const _Float16* xi = (const _Float16*)(F.ws + WS_XSB) + (size_t)row * D;
#pragma unroll
        for (int j = 0; j < 2; ++j) { const int k = j * 512 + F.lane * 8; const f32x8 x = __builtin_convertvector(*(const h16x8*)(xi + k), f32x8);
            const f32x4 w0 = *(const f32x4*)(F.in[9] + k), w1 = *(const f32x4*)(F.in[9] + k + 4);
            *(f32x4*)(xr + k) = (f32x4){x[0], x[1], x[2], x[3]} * r * w0; *(f32x4*)(xr + k + 4) = (f32x4){x[4], x[5], x[6], x[7]} * r * w1; }
    }
}

enum { PH_P0A = 0, PH_P0B, PH_L0_G1, PH_L0_MA, PH_L0_MB, PH_L0_MC, PH_L0_G2, PH_L0_G3, PH_L0_G4,
       PH_L1_G1, PH_L1_CV, PH_L1_MA, PH_L1_MB, PH_L1_MC, PH_L1_MD, PH_L1_G2, PH_L1_G3, PH_L1_G4,
       PH_L2_DELTA, PH_L2_G2, PH_L2_G3, PH_L2_G4,
       PH_L3_G1, PH_L3_ATT, PH_L3_G2, PH_L3_G3, PH_L3_G4, PH_FINAL, NPHASE };
__global__ void __launch_bounds__(NTHR, 2) fwd_kernel(Args args) {
    extern __shared__ __attribute__((aligned(16))) unsigned char lds_raw[];
    Frame F; F.lds = (LAS unsigned char*)lds_raw; F.tid = threadIdx.x; F.lane = F.tid & 63; F.wave = __builtin_amdgcn_readfirstlane(F.tid >> 6);
    F.G = gridDim.x; F.bid = blockIdx.x; F.vcu = (F.G % 8 == 0) ? (F.bid % 8) * (F.G / 8) + F.bid / 8 : F.bid; F.in = args.in; F.out = args.out; F.ws = args.ws;
    volatile LAS unsigned* MISC = (volatile LAS unsigned*)(F.lds + MISC_OFF);
    for (int u = F.tid; u < 128; u += NTHR) ((LAS unsigned*)(F.lds + MISC_OFF))[u] = 0u;
    __syncthreads();
    const int lo = args.ph_lo, hi = args.ph_hi;
#if MK_ONE_LAUNCH
    XcdBarrier bar = xcd_barrier_post((unsigned*)(F.ws + WS_CTL), MISC + 8);
    if (lo < 0) cg::this_grid().sync();
    int n_ts = 0;
#define STAMP() do { STAMPX(n_ts); ++n_ts; } while (0)
    STAMP();
#define SEAM() do { xcd_barrier(bar); STAMP(); } while (0)
#else
    (void)MISC;
#define SEAM() do { } while (0)
#endif
#define IN(k) (lo <= (k) && (k) < hi)
#ifndef PHASE_MASK
#define PHASE_MASK 0xFFFFFFFFull
#endif
#ifndef DUP_MASK
#define DUP_MASK 0ull
#endif
#define PH(k, ...) do { if constexpr (((PHASE_MASK) >> (k)) & 1ull) { if (IN(k)) { __VA_ARGS__; if constexpr (((DUP_MASK) >> (k)) & 1ull) { __syncthreads(); __VA_ARGS__; } if (IN((k) + 1)) SEAM(); } } } while (0)
#define PH_EMPTY(k) do { } while (0)
    LAS unsigned char* ring = F.lds;
    const int c_ = F.bid;
#define RUN_G1(k, epi, Wt, nN, CMODE, cpar) PH(k, { Gemm g{WSB(WS_XSA), Wt, D, D, D, 0}; StaticOrder S; S.init(64, nN, F.G, c_); const int heavy_ = (64 * (nN)) % F.G; if (heavy_ == 0) ctx_gemm<CMODE, 8>(F, cpar, 0); pg8::gemm_phase(ring, g, S, epi); if (heavy_ != 0) ctx_gemm<CMODE, 8>(F, cpar, heavy_); })
    const float* XF = (const float*)(F.ws + WS_XSB);
#define RUN_G2(k, layer, BH_, Aptr, lda_, K_, Wt_, apn_, ldb_, nMr_, blat_, bctx_, xsout_) PH(k, { \
        EpiResid<BH_, true> e{blat_, F.out, WSF(WS_GATE) + ((size_t)(layer) * 2 + 0) * 2 * 1024, WSF(WS_CS) + ((size_t)(layer) * 2 + 1) * 2 * 1024, xsout_, WSF(WS_SLOTS)}; \
        Gemm g{Aptr, Wt_, lda_, ldb_, K_, apn_, 1 + (layer)}; StaticOrder S; S.init(64, 4, F.G, c_); \
        if (F.G == 256) { EpiResidLds<BH_, true> el{e.base, e.out, e.gate, e.csn, e.xs, e.slots}; pg8::gemm_phase(ring, g, S, el); } else pg8::gemm_phase(ring, g, S, e); STAMPX(34 + 4 * (1 + (layer))); \
        if (nMr_ == 65) { CtxP cp{Aptr, lda_, apn_, Wt_, ldb_, K_, 32, nullptr, nullptr, 0, nullptr, nullptr, bctx_, WSF(WS_XCTX), WSF(WS_GATE) + ((size_t)(layer) * 2 + 0) * 2 * 1024, WSF(WS_CS) + ((size_t)(layer) * 2 + 1) * 2 * 1024, xsout_, (layer) == 0}; ctx_gemm<4, (K_) / 128>(F, cp, 0); } STAMPX(35 + 4 * (1 + (layer))); })
#define RUN_G3(k, layer, nMr_, xsin_) PH(k, { \
        EpiG1<3> e{WSF(WS_SLOTS), WSF(WS_BIAS3) + (size_t)(layer) * 2 * FH2, FH2, WSB(WS_P), nullptr, nullptr}; \
        Gemm g{xsin_, WSB(WS_W_FFNIN) + (size_t)(layer) * FH2 * D, D, D, D, 0}; StaticOrder S; S.init(64, FH2 / 256, F.G, c_); pg8::gemm_phase(ring, g, S, e); \
        if (nMr_ == 65) { CtxP cp{xsin_, D, 0, WSB(WS_W_FFNIN) + (size_t)(layer) * FH2 * D, D, D, FH / 32, WSF(WS_BIAS3) + (size_t)(layer) * 2 * FH2 + FH2, WSB(WS_P), FH, nullptr, nullptr, nullptr, nullptr, nullptr, nullptr, nullptr}; ctx_gemm<3, 8>(F, cp, (64 * (FH2 / 256)) % F.G); } })
#define RUN_G4(k, layer, OH_, outp_, nMr_) PH(k, { \
        EpiResid<true, OH_> e{F.out, outp_, WSF(WS_GATE) + ((size_t)(layer) * 2 + 1) * 2 * 1024, ((layer) < 3) ? WSF(WS_CS) + ((size_t)((layer) + 1) * 2 + 0) * 2 * 1024 : (const float*)nullptr, WSB(WS_XSA), WSF(WS_SLOTS)}; \
        Gemm g{WSB(WS_P), WSB(WS_W_FFNOUT) + (size_t)(layer) * D * FH, FH, FH, FH, 0, 5 + (layer)}; StaticOrder S; S.init(64, 4, F.G, c_); \
        if (F.G == 256) { EpiResidLds<true, OH_> el{e.base, e.out, e.gate, e.csn, e.xs, e.slots}; pg8::gemm_phase(ring, g, S, el); } else pg8::gemm_phase(ring, g, S, e); STAMPX(34 + 4 * (5 + (layer))); \
        if (nMr_ == 65) { CtxP cp{WSB(WS_P), FH, 0, WSB(WS_W_FFNOUT) + (size_t)(layer) * D * FH, FH, FH, 32, nullptr, nullptr, 0, nullptr, nullptr, WSF(WS_XCTX), WSF(WS_XCTX), WSF(WS_GATE) + ((size_t)(layer) * 2 + 1) * 2 * 1024, ((layer) < 3) ? WSF(WS_CS) + ((size_t)((layer) + 1) * 2 + 0) * 2 * 1024 : (const float*)nullptr, WSB(WS_XSA)}; ctx_gemm<4, FH / 128>(F, cp, 0); } STAMPX(35 + 4 * (5 + (layer))); })

    PH(PH_P0A, phase_p0a(F));
    PH(PH_P0B, phase_p0b(F));
    { EpiG1<0> e{WSF(WS_SLOTS), WSF(WS_BIAS1), FH2, WSB(WS_P), nullptr, nullptr}; CtxP cp{WSB(WS_XSA), D, 0, WSB(WS_W_HGIN), D, D, HG_N / 32, WSF(WS_BIAS1) + FH2, WSB(WS_P), PLD, nullptr, nullptr, nullptr, nullptr, nullptr, nullptr, nullptr}; RUN_G1(PH_L0_G1, e, WSB(WS_W_HGIN), HG_N / 256, 0, cp); }
    PH(PH_L0_MA, phase_hg_a(F));
    PH(PH_L0_MB, phase_hg_b(F));
    PH(PH_L0_MC, phase_hg_c(F));
    RUN_G2(PH_L0_G2, 0, false, WSB(WS_XSA), D, D, WSB(WS_W_HGOUT), 0, D, 65, F.in[0], F.in[2], WSB(WS_XSB));
    RUN_G3(PH_L0_G3, 0, 65, WSB(WS_XSB));
    RUN_G4(PH_L0_G4, 0, true, (void*)F.out, 65);
    { EpiG1<1> e{WSF(WS_SLOTS), WSF(WS_BIAS1) + (size_t)1 * 2 * FH2, FH2, WSB(WS_P), WSF(WS_DT), WSB(WS_HALO)}; CtxP cp{WSB(WS_XSA), D, 0, WSB(WS_W_SSMIN), D, D, SSM_NP / 32, WSF(WS_BIAS1) + (size_t)1 * 2 * FH2 + FH2, WSB(WS_P), PLD, WSF(WS_DT), WSB(WS_HALO), nullptr, nullptr, nullptr, nullptr, nullptr}; RUN_G1(PH_L1_G1, e, WSB(WS_W_SSMIN), SSM_NP / 256, 1, cp); }
    PH(PH_L1_CV, phase_ssm_conv(F); ssm_tables(F));
    PH(PH_L1_MA, phase_ssm_a(F));
    PH(PH_L1_MB, phase_ssm_b(F));
    PH(PH_L1_MC, phase_ssm_c(F));
    if (F.G != 256) PH(PH_L1_MD, phase_ssm_d(F));
    PH(PH_L1_G2, {
        const float* gate_ = WSF(WS_GATE) + ((size_t)1 * 2 + 0) * 2 * 1024; const float* cs_ = WSF(WS_CS) + ((size_t)1 * 2 + 1) * 2 * 1024;
        const bool fuse_ = (F.G == 256);
        Gemm g{WSB(WS_P), WSB(WS_W_SSMOUT), PLD, SSM_DI, SSM_DI, 0, 2}; StaticOrder S; S.init(64, 4, F.G, c_);
        if (fuse_) {
            pg8::Unit u0; S.next(0, u0);
            if (F.tid < 256) {
                const float* sp = WSF(WS_SSQ) + (size_t)(u0.pm * BM + F.tid) * 32; float rg[4];
                _Pragma("unroll") for (int gq = 0; gq < 4; ++gq) { const f32x4 a = *(const f32x4*)(sp + 8 * gq), b_ = *(const f32x4*)(sp + 8 * gq + 4);
                    rg[gq] = rsqrtf((((a[0] + a[1]) + (a[2] + a[3])) + ((b_[0] + b_[1]) + (b_[2] + b_[3]))) * (1.0f / 512.0f) + EPS); }
                *(LAS f32x4*)(F.lds + RQ_OFF + F.tid * 16) = (f32x4){rg[0] / rg[1], rg[1] / rg[2], rg[2] / rg[3], rg[3]};
            }
            __syncthreads();
            EpiResidLds<true, true, true> el{(const void*)F.out, (void*)F.out, gate_, cs_, WSB(WS_XSA), WSF(WS_SLOTS)}; pg8::gemm_phase(ring, g, S, el);
        } else { EpiResid<true, true> e{(const void*)F.out, (void*)F.out, gate_, cs_, WSB(WS_XSA), WSF(WS_SLOTS)}; pg8::gemm_phase(ring, g, S, e); }
        { CtxP cp{WSB(WS_P), PLD, 0, WSB(WS_W_SSMOUT), SSM_DI, SSM_DI, 32, nullptr, nullptr, 0, nullptr, nullptr, WSF(WS_XCTX), WSF(WS_XCTX), gate_, cs_, WSB(WS_XSA), 0, fuse_ ? WSF(WS_SSQ) : (const float*)nullptr}; ctx_gemm<4, SSM_DI / 128>(F, cp, 0); }
    });
    RUN_G3(PH_L1_G3, 1, 65, WSB(WS_XSA));
    RUN_G4(PH_L1_G4, 1, true, (void*)F.out, 65);
    PH(PH_L2_DELTA, phase_pool_delta(F));
    RUN_G2(PH_L2_G2, 2, true, WSB(WS_P), D, 256, WSB(WS_W_POOL), 256, 256, 65, F.out, WSF(WS_XCTX), WSB(WS_XSB));
    RUN_G3(PH_L2_G3, 2, 65, WSB(WS_XSB));
    RUN_G4(PH_L2_G4, 2, true, (void*)F.out, 65);
    { EpiQKV e{WSF(WS_SLOTS), WSF(WS_BIAS1) + (size_t)3 * 2 * FH2, FH2, WSB(WS_P), WSF(WS_ROPE)}; CtxP cp{WSB(WS_XSA), D, 0, WSB(WS_W_QKV), D, D, ATT_N / 32, WSF(WS_BIAS1) + (size_t)3 * 2 * FH2 + FH2, WSB(WS_P), QK_LD, nullptr, nullptr, nullptr, nullptr, nullptr, nullptr, nullptr}; RUN_G1(PH_L3_G1, e, WSB(WS_W_QKV), ATT_N / 256, 2, cp); }
    PH(PH_L3_ATT, phase_att(F));
    RUN_G2(PH_L3_G2, 3, true, WSB(WS_XSA), D, D, WSB(WS_W_ATTOUT), 0, D, 64, F.out, WSF(WS_XCTX), WSB(WS_XSB));
    RUN_G3(PH_L3_G3, 3, 64, WSB(WS_XSB));
    RUN_G4(PH_L3_G4, 3, true, (void*)(F.ws + WS_XSB), 64);
    PH(PH_FINAL, phase_final(F));
    if (PA_I >= 0 || PB_I >= 0) {
        __syncthreads();
        if (PB_I >= 0) { const float eb = (float)(g_ts[PB_J < 0 ? 0 : PB_J] - g_ts[PB_I < 0 ? 0 : PB_I]) * 1e-5f;
            if (F.bid == 0) for (int row = 1 + F.wave; row <= 1024; row += 8) { float* xr = F.out + (size_t)row * D;
                for (int j = 0; j < 16; ++j) xr[j * 64 + F.lane] += eb; } }
        if (PA_I >= 0 && F.bid == 0 && F.tid == 0) { __builtin_amdgcn_s_waitcnt(0); F.out[0] += (float)(g_ts[PA_J < 0 ? 0 : PA_J] - g_ts[PA_I < 0 ? 0 : PA_I]) * 2e-5f * PA_FINE; }
    }
#undef IN
#undef PH
#undef SEAM
}

extern "C" void kernel_launch(void* const* d_in, const int* in_sizes, int n_in, void* d_out, int out_size, void* d_ws, size_t ws_size, hipStream_t stream) {
    static int grid = 0;
    if (grid == 0) {
        if (n_in != 27 || out_size != NLAT * D || ws_size < WS_END) { fprintf(stderr, "kernel_launch: unexpected shapes (n_in %d out %d ws %zu need %zu)\n", n_in, out_size, ws_size, (size_t)WS_END); grid = -1; return; }
        int dev = 0, cus = 0, per_cu = 0;
        hipGetDevice(&dev); hipDeviceGetAttribute(&cus, hipDeviceAttributeMultiprocessorCount, dev);
        if (hipFuncSetAttribute((const void*)fwd_kernel, hipFuncAttributeMaxDynamicSharedMemorySize, LDS_BYTES) != hipSuccess) { fprintf(stderr, "hipFuncSetAttribute failed\n"); grid = -1; return; }
        hipOccupancyMaxActiveBlocksPerMultiprocessor(&per_cu, (const void*)fwd_kernel, NTHR, LDS_BYTES);
        (void)hipGetLastError();
        if (per_cu < 1) { fprintf(stderr, "occupancy query says %d\n", per_cu); grid = -1; return; }
        grid = cus;
    }
    if (grid < 0) return;
    hipMemsetAsync((char*)d_ws + WS_CTL, 0, CTL_BYTES, stream);
    Args a{};
    for (int i = 0; i < 27; ++i) a.in[i] = (const float*)d_in[i];
    a.out = (float*)d_out; a.ws = (unsigned char*)d_ws;
    a.ph_lo = 0; a.ph_hi = NPHASE;
    void* kargs[] = {&a};
    hipError_t e = hipLaunchCooperativeKernel((const void*)fwd_kernel, dim3(grid), dim3(NTHR), kargs, LDS_BYTES, stream);
    if (e != hipSuccess) fprintf(stderr, "cooperative launch failed: %s\n", hipGetErrorString(e));
}
```
